# Optimizing an MI355X kernel written in HIP

```python
import math
import jax
import jax.numpy as jnp
from jax import lax
import numpy as np

D_MODEL = 1024
BATCH = 8
SEQ = 8192
DEPTH = 2

CTX_LEN = 256
GRID_W = 64
RMS_EPS = 1e-6

HEAD_DIM = 64
N_Q_HEADS = 8
N_KV_HEADS = 2
Q_PER_KV = N_Q_HEADS // N_KV_HEADS
ATTN_W = N_Q_HEADS * HEAD_DIM
KV_W = N_KV_HEADS * HEAD_DIM
Q_BLOCK = 128
ROPE_THETA = 10000.0

HYENA_W = 256
HYENA_ORDER = 2
HYENA_BANDS = 16
HYENA_POS_DIM = 1 + 2 * HYENA_BANDS
HYENA_HIDDEN = 64
HYENA_INNER = 2
HYENA_FILTER_OUT = HYENA_ORDER * 2 * HYENA_W
HYENA_DECAY_TARGET = 1e-2
HYENA_FAST_PCT = 0.3
HYENA_SLOW_PCT = 1.5
HYENA_MIN_DECAY = -math.log(HYENA_DECAY_TARGET) / HYENA_SLOW_PCT
HYENA_MAX_DECAY = -math.log(HYENA_DECAY_TARGET) / HYENA_FAST_PCT

POOL_W = 256
POOL_WINDOWS = (2, 4, 8, 16)
POOL_GROUP_W = POOL_W // len(POOL_WINDOWS)

GMLP_W = 256
GMLP_CHUNK = 128
GMLP_GROUPS = 4
GMLP_GROUP_W = GMLP_W // GMLP_GROUPS

N_BRANCH = 4
FFN_HIDDEN = ((8 * D_MODEL // 3 + 255) // 256) * 256

Q_OFF = 0
K_OFF = Q_OFF + ATTN_W
V_OFF = K_OFF + KV_W
HY_OFF = V_OFF + KV_W
POOL_OFF = HY_OFF + 3 * HYENA_W
GM_OFF = POOL_OFF + POOL_W
GATE_OFF = GM_OFF + 2 * GMLP_W
IN_W = GATE_OFF + N_BRANCH * D_MODEL

kernel_name = 'hybrid_prefix_diffusion_trunk'


def rms_norm(x, w):
    xf = x.astype(jnp.float32)
    y = xf * lax.rsqrt(jnp.mean(xf * xf, axis=-1, keepdims=True) + RMS_EPS)
    return (y * w.astype(jnp.float32)).astype(x.dtype)


def layer_norm(x, w):
    xf = x.astype(jnp.float32)
    mu = jnp.mean(xf, axis=-1, keepdims=True)
    var = jnp.mean(jnp.square(xf - mu), axis=-1, keepdims=True)
    return ((xf - mu) * lax.rsqrt(var + RMS_EPS) * w.astype(jnp.float32)).astype(x.dtype)


def modulate(x, norm_w, shift, scale):
    return rms_norm(x, norm_w) * (1 + scale) + shift


def axial_rope_tables(n_tokens, dtype):
    rows = n_tokens // GRID_W
    r, col = jnp.meshgrid(jnp.arange(rows, dtype=jnp.float32), jnp.arange(GRID_W, dtype=jnp.float32), indexing='ij')
    axis_dim = HEAD_DIM // 2
    inv_freq = ROPE_THETA ** (-jnp.arange(0, axis_dim, 2, dtype=jnp.float32) / axis_dim)
    ang = jnp.concatenate([r.reshape(-1, 1) * inv_freq, col.reshape(-1, 1) * inv_freq], axis=-1)
    return jnp.cos(ang).astype(dtype), jnp.sin(ang).astype(dtype)


def apply_rope(t, cos, sin):
    c = cos[None, :, None, :]
    s = sin[None, :, None, :]
    t1 = t[..., 0::2]
    t2 = t[..., 1::2]
    return jnp.stack([t1 * c - t2 * s, t1 * s + t2 * c], axis=-1).reshape(t.shape)


def attn_q(p_q, q_norm_w):
    b, n = p_q.shape[:2]
    return rms_norm(p_q.reshape(b, n, N_Q_HEADS, HEAD_DIM), q_norm_w)


def attn_kv(p_kv, k_norm_w):
    b, n = p_kv.shape[:2]
    k = rms_norm(p_kv[..., :KV_W].reshape(b, n, N_KV_HEADS, HEAD_DIM), k_norm_w)
    v = p_kv[..., KV_W:].reshape(b, n, N_KV_HEADS, HEAD_DIM)
    return k, v


def gqa_attend(q, k, v):
    b, lq = q.shape[:2]
    qg = q.reshape(b, lq, N_KV_HEADS, Q_PER_KV, HEAD_DIM)
    s = jnp.einsum('bqkgd,bskd->bkgqs', qg, k, preferred_element_type=jnp.float32) * (HEAD_DIM ** -0.5)
    p = jax.nn.softmax(s, axis=-1).astype(v.dtype)
    o = jnp.einsum('bkgqs,bskd->bqkgd', p, v)
    return o.reshape(b, lq, ATTN_W)


def blocked_attention(q, k, v):
    b, lq = q.shape[:2]
    nb = lq // Q_BLOCK
    qb = q.reshape(b, nb, Q_BLOCK, N_Q_HEADS, HEAD_DIM).transpose(1, 0, 2, 3, 4)
    ob = lax.map(lambda qi: gqa_attend(qi, k, v), qb)
    return ob.transpose(1, 0, 2, 3).reshape(b, lq, ATTN_W)


def hyena_filters(n, lp):
    pos = jnp.arange(n, dtype=jnp.float32)
    t = pos / (n - 1)
    bands = jnp.linspace(1e-4, HYENA_BANDS - 1, HYENA_BANDS, dtype=jnp.float32)
    ang = (2.0 * math.pi / n) * pos[:, None] * bands
    z = jnp.concatenate([t[:, None], jnp.cos(ang), jnp.sin(ang)], axis=-1)
    freq = lp['hy_freq'].astype(jnp.float32)
    hdn = jnp.sin(freq * (z @ lp['hy_w1'].astype(jnp.float32) + lp['hy_b1'].astype(jnp.float32)))
    for i in range(HYENA_INNER):
        hdn = jnp.sin(freq * (hdn @ lp['hy_w2'][i].astype(jnp.float32) + lp['hy_b2'][i].astype(jnp.float32)))
    window = jnp.exp(-t[:, None] * jnp.abs(lp['hy_decay'].astype(jnp.float32)))
    filt = ((hdn @ lp['hy_w3'].astype(jnp.float32)) * window).reshape(n, HYENA_ORDER, 2, HYENA_W)
    fwd = filt[:, :, 0]
    bwd = filt[:, :, 1]
    k = jnp.concatenate([fwd, jnp.zeros((1, HYENA_ORDER, HYENA_W), jnp.float32), bwd[:0:-1]], axis=0)
    return k / jnp.sum(jnp.abs(k), axis=0, keepdims=True)


def long_conv(u, kf, skip):
    n = u.shape[1]
    uf = jnp.fft.rfft(u.astype(jnp.float32), n=2 * n, axis=1)
    y = jnp.fft.irfft(uf * kf[None], n=2 * n, axis=1)[:, :n]
    return (y + u.astype(jnp.float32) * skip.astype(jnp.float32)).astype(u.dtype)


def hyena_mixer(p, lp):
    n = p.shape[1]
    w = lp['hy_conv_w']
    zp = jnp.pad(p, ((0, 0), (1, 1), (0, 0)))
    z = zp[:, :-2] * w[0] + zp[:, 1:-1] * w[1] + zp[:, 2:] * w[2] + lp['hy_conv_b']
    v, x1, x2 = jnp.split(z, 3, axis=-1)
    kf = jnp.fft.rfft(hyena_filters(n, lp), n=2 * n, axis=0)
    y = v
    for o, gate in enumerate((x1, x2)):
        y = gate * long_conv(y, kf[:, o], lp['hy_skip'][o])
    return y


def pool_mixer(z, pool_w, pool_scale):
    b, n, _ = z.shape
    zf = z.astype(jnp.float32)
    csum = jnp.concatenate([jnp.zeros((b, 1, POOL_W), jnp.float32), jnp.cumsum(zf, axis=1)], axis=1)
    pos = jnp.arange(n)
    means = []
    for g, win in enumerate(POOL_WINDOWS):
        lo = jnp.clip(pos - win // 2, 0, n)
        hi = jnp.clip(pos + win - win // 2, 0, n)
        cg = csum[..., g * POOL_GROUP_W:(g + 1) * POOL_GROUP_W]
        means.append((cg[:, hi] - cg[:, lo]) / (hi - lo).astype(jnp.float32)[None, :, None])
    d = (jnp.concatenate(means, axis=-1) - zf).astype(z.dtype).reshape(b, n, len(POOL_WINDOWS), POOL_GROUP_W)
    y = jnp.einsum('bngc,gcd->bngd', d, pool_w).reshape(b, n, POOL_W)
    return y * pool_scale


def gmlp_mixer(p, norm_w, ws, bs):
    b, n, _ = p.shape
    u, v = jnp.split(p, 2, axis=-1)
    v = layer_norm(v, norm_w).reshape(b, n // GMLP_CHUNK, GMLP_CHUNK, GMLP_GROUPS, GMLP_GROUP_W)
    mixed = jnp.einsum('gts,bcsgd->bctgd', ws, v) + bs.T[None, None, :, :, None]
    return u * mixed.reshape(b, n, GMLP_W)


def parallel_mixers(p, attn_out, lp):
    hy = hyena_mixer(p[..., HY_OFF:POOL_OFF], lp)
    pl = pool_mixer(p[..., POOL_OFF:GM_OFF], lp['pool_w'], lp['pool_scale'])
    gm = gmlp_mixer(p[..., GM_OFF:GATE_OFF], lp['gm_norm_w'], lp['gm_ws'], lp['gm_bs'])
    g = jax.nn.sigmoid(p[..., GATE_OFF:].reshape(p.shape[:-1] + (N_BRANCH, D_MODEL)))
    merged = (g[..., 0, :] * (attn_out @ lp['w_br_attn'])
              + g[..., 1, :] * (hy @ lp['w_br_hyena'])
              + g[..., 2, :] * (pl @ lp['w_br_pool'])
              + g[..., 3, :] * (gm @ lp['w_br_gmlp']))
    return merged @ lp['w_out']


def swiglu(h, wg, wu, wd):
    return (jax.nn.silu(h @ wg) * (h @ wu)) @ wd


def setup_inputs(seed: int = 0) -> dict:
    key = jax.random.key(seed)
    ks = iter(jax.random.split(key, 48))

    def nrm(shape, scale):
        return jax.random.normal(next(ks), shape, jnp.float32) * scale

    L = DEPTH
    D = D_MODEL
    decay_base = jnp.linspace(HYENA_MIN_DECAY, HYENA_MAX_DECAY, HYENA_FILTER_OUT, dtype=jnp.float32)[None]
    return {
        'x': nrm((BATCH, SEQ, D), 1.0),
        'c': nrm((BATCH, D), 1.0),
        'ctx': nrm((BATCH, CTX_LEN, D), 1.0),
        'c_ctx': nrm((D,), 1.0),
        'w_mod': nrm((L, D, 6 * D), 0.5 * D ** -0.5),
        'b_mod': nrm((L, 6 * D), 0.02),
        'norm1_w': 1.0 + nrm((L, D), 0.05),
        'norm2_w': 1.0 + nrm((L, D), 0.05),
        'w_in': nrm((L, D, IN_W), D ** -0.5),
        'q_norm_w': 1.0 + nrm((L, HEAD_DIM), 0.05),
        'k_norm_w': 1.0 + nrm((L, HEAD_DIM), 0.05),
        'hy_conv_w': nrm((L, 3, 3 * HYENA_W), 3 ** -0.5),
        'hy_conv_b': nrm((L, 3 * HYENA_W), 0.02),
        'hy_w1': nrm((L, HYENA_POS_DIM, HYENA_HIDDEN), HYENA_POS_DIM ** -0.5),
        'hy_b1': nrm((L, HYENA_HIDDEN), 0.1),
        'hy_w2': nrm((L, HYENA_INNER, HYENA_HIDDEN, HYENA_HIDDEN), HYENA_HIDDEN ** -0.5),
        'hy_b2': nrm((L, HYENA_INNER, HYENA_HIDDEN), 0.1),
        'hy_w3': nrm((L, HYENA_HIDDEN, HYENA_FILTER_OUT), HYENA_HIDDEN ** -0.5),
        'hy_freq': 1.0 + nrm((L, HYENA_HIDDEN), 0.05),
        'hy_decay': decay_base * (1.0 + nrm((L, HYENA_FILTER_OUT), 0.05)),
        'hy_skip': nrm((L, HYENA_ORDER, HYENA_W), 0.5),
        'pool_w': nrm((L, len(POOL_WINDOWS), POOL_GROUP_W, POOL_GROUP_W), POOL_GROUP_W ** -0.5),
        'pool_scale': 1.0 + nrm((L, POOL_W), 0.1),
        'gm_norm_w': 1.0 + nrm((L, GMLP_W), 0.05),
        'gm_ws': nrm((L, GMLP_GROUPS, GMLP_CHUNK, GMLP_CHUNK), GMLP_CHUNK ** -0.5),
        'gm_bs': nrm((L, GMLP_GROUPS, GMLP_CHUNK), 0.1),
        'w_br_attn': nrm((L, ATTN_W, D), ATTN_W ** -0.5),
        'w_br_hyena': nrm((L, HYENA_W, D), HYENA_W ** -0.5),
        'w_br_pool': nrm((L, POOL_W, D), POOL_W ** -0.5),
        'w_br_gmlp': nrm((L, GMLP_W, D), GMLP_W ** -0.5),
        'w_out': nrm((L, D, D), D ** -0.5),
        'ffn_w_gate': nrm((L, D, FFN_HIDDEN), D ** -0.5),
        'ffn_w_up': nrm((L, D, FFN_HIDDEN), D ** -0.5),
        'ffn_w_down': nrm((L, FFN_HIDDEN, D), FFN_HIDDEN ** -0.5),
        'final_norm_w': 1.0 + nrm((D,), 0.05),
    }


def reference(x, c, ctx, c_ctx, w_mod, b_mod, norm1_w, norm2_w, w_in, q_norm_w, k_norm_w,
              hy_conv_w, hy_conv_b, hy_w1, hy_b1, hy_w2, hy_b2, hy_w3, hy_freq, hy_decay, hy_skip,
              pool_w, pool_scale, gm_norm_w, gm_ws, gm_bs,
              w_br_attn, w_br_hyena, w_br_pool, w_br_gmlp, w_out,
              ffn_w_gate, ffn_w_up, ffn_w_down, final_norm_w):
    cos, sin = axial_rope_tables(x.shape[1], x.dtype)
    xc = ctx
    act_lat = jax.nn.silu(c)
    act_ctx = jax.nn.silu(c_ctx)
    for l in range(DEPTH):
        lp = {
            'hy_conv_w': hy_conv_w[l], 'hy_conv_b': hy_conv_b[l],
            'hy_w1': hy_w1[l], 'hy_b1': hy_b1[l], 'hy_w2': hy_w2[l], 'hy_b2': hy_b2[l],
            'hy_w3': hy_w3[l], 'hy_freq': hy_freq[l], 'hy_decay': hy_decay[l], 'hy_skip': hy_skip[l],
            'pool_w': pool_w[l], 'pool_scale': pool_scale[l],
            'gm_norm_w': gm_norm_w[l], 'gm_ws': gm_ws[l], 'gm_bs': gm_bs[l],
            'w_br_attn': w_br_attn[l], 'w_br_hyena': w_br_hyena[l],
            'w_br_pool': w_br_pool[l], 'w_br_gmlp': w_br_gmlp[l], 'w_out': w_out[l],
        }
        mod = (act_lat @ w_mod[l] + b_mod[l])[:, None, :]
        sh1, s1, g1, sh2, s2, g2 = jnp.split(mod, 6, axis=-1)
        csh1, cs1, cg1, csh2, cs2, cg2 = jnp.split(act_ctx @ w_mod[l] + b_mod[l], 6)

        hc = modulate(xc, norm1_w[l], csh1, cs1)
        if l < DEPTH - 1:
            pc = hc @ w_in[l]
            k_c, v_c = attn_kv(pc[..., K_OFF:HY_OFF], k_norm_w[l])
            q_c = attn_q(pc[..., Q_OFF:K_OFF], q_norm_w[l])
            xc = xc + cg1 * parallel_mixers(pc, gqa_attend(q_c, k_c, v_c), lp)
            xc = xc + cg2 * swiglu(modulate(xc, norm2_w[l], csh2, cs2), ffn_w_gate[l], ffn_w_up[l], ffn_w_down[l])
        else:
            k_c, v_c = attn_kv(hc @ w_in[l][:, K_OFF:HY_OFF], k_norm_w[l])

        p = modulate(x, norm1_w[l], sh1, s1) @ w_in[l]
        q = apply_rope(attn_q(p[..., Q_OFF:K_OFF], q_norm_w[l]), cos, sin)
        k, v = attn_kv(p[..., K_OFF:HY_OFF], k_norm_w[l])
        k = apply_rope(k, cos, sin)
        attn = blocked_attention(q, jnp.concatenate([k_c, k], axis=1), jnp.concatenate([v_c, v], axis=1))
        x = x + g1 * parallel_mixers(p, attn, lp)
        x = x + g2 * swiglu(modulate(x, norm2_w[l], sh2, s2), ffn_w_gate[l], ffn_w_up[l], ffn_w_down[l])
    return rms_norm(x, final_norm_w)
```

```cpp
#include <hip/hip_runtime.h>
#include <hip/hip_cooperative_groups.h>
#include <cstdio>
#include <cstdint>
#include <cmath>
namespace cg = cooperative_groups;

#ifndef MK_MULTI_LAUNCH
#define MK_MULTI_LAUNCH 0
#endif

#ifndef ONLY
#define ONLYC(k) true
#else
#define ONLYC(k) ((k)==ONLY)
#endif
typedef unsigned short bf16_t;
typedef short bf16x8 __attribute__((ext_vector_type(8)));
typedef float f32x16 __attribute__((ext_vector_type(16)));

constexpr int D = 1024, NB = 8, SEQ = 8192, CTXL = 256;
constexpr int ML = NB * SEQ, MC = NB * CTXL, MT = ML + MC;
constexpr int PW = 2304;
constexpr int INW = 6400, FFH = 2816, NKEY = CTXL + SEQ;
constexpr int NFFT = 16384;
constexpr float QSCALE = 0.125f * 1.4426950408889634f;

enum { IN_X, IN_C, IN_CTX, IN_CCTX, IN_WMOD, IN_BMOD, IN_N1W, IN_N2W, IN_WIN, IN_QNW, IN_KNW, IN_HCW, IN_HCB, IN_HW1, IN_HB1, IN_HW2, IN_HB2,
       IN_HW3, IN_HFREQ, IN_HDECAY, IN_HSKIP, IN_POOLW, IN_POOLS, IN_GMNW, IN_GMWS, IN_GMBS, IN_WBA, IN_WBH, IN_WBP, IN_WBG, IN_WOUT, IN_FG, IN_FU, IN_FD, IN_FNW, N_IN };

constexpr size_t SZ_HN = (size_t)MT * 1024 * 2;
constexpr size_t SZ_P = (size_t)MT * PW * 2;
constexpr size_t SZ_Q = (size_t)MT * 512 * 2;
constexpr size_t SZ_K = (size_t)16 * NKEY * 64 * 2;
constexpr size_t SZ_ZT = (size_t)NB * 768 * SEQ * 2;
constexpr size_t SZ_B256 = (size_t)MT * 256 * 2;
constexpr size_t W_WIN = 0, W_BA = W_WIN + (size_t)6400 * 1024 * 2, W_BH = W_BA + (size_t)1024 * 512 * 2, W_BP = W_BH + (size_t)1024 * 256 * 2,
                 W_BG = W_BP + (size_t)1024 * 256 * 2, W_OUT = W_BG + (size_t)1024 * 256 * 2, W_GU = W_OUT + (size_t)1024 * 1024 * 2,
                 W_DN = W_GU + (size_t)5632 * 1024 * 2, W_GMWS = W_DN + (size_t)1024 * 2816 * 2, W_LAYER = W_GMWS + (size_t)4 * 128 * 128 * 2;
constexpr size_t OFF_HN = 0;
constexpr size_t OFF_P = OFF_HN + SZ_HN;
constexpr size_t OFF_Q = OFF_P + SZ_P;
constexpr size_t OFF_K = OFF_Q + SZ_Q;
constexpr size_t OFF_VT = OFF_K + SZ_K;
constexpr size_t OFF_ZT = OFF_VT + SZ_K;
constexpr size_t OFF_PD = OFF_ZT + SZ_ZT;
constexpr size_t OFF_GM = OFF_PD + SZ_B256;
constexpr size_t OFF_HY = OFF_GM + SZ_B256;
constexpr size_t OFF_W = OFF_HY + SZ_B256;
constexpr size_t OFF_HSPEC = OFF_W + 2 * W_LAYER;
constexpr size_t SZ_HSPEC_L = (size_t)2 * 256 * NFFT * 8;
constexpr size_t OFF_XC = OFF_HSPEC + 2 * SZ_HSPEC_L;
constexpr size_t OFF_MOD = OFF_XC + (size_t)MC * 1024 * 4;
constexpr size_t OFF_ROPE = OFF_MOD + (size_t)2 * 9 * 6144 * 4;
constexpr size_t OFF_TW = OFF_ROPE + (size_t)128 * 16 * 2 * 4;
constexpr size_t OFF_KCR = OFF_TW + (size_t)8192 * 8;
constexpr size_t OFF_KCN = OFF_KCR + (size_t)2 * 256 * 512 * 4;
constexpr size_t WS_END = OFF_KCN + (size_t)2 * 256 * 512 * 4;
constexpr size_t SZ_KCIRC_L = (size_t)2 * 256 * NFFT * 4;
static_assert((size_t)MT * FFH * 2 == SZ_P + SZ_Q, "hid spans P+Q");
static_assert(WS_END <= ((size_t)1 << 30), "workspace over 1 GiB");

constexpr int LDS_BYTES = 131072 + 256;
constexpr int NPHASE = 22;

struct Params {
    const float* in[N_IN];
    float* out;
    unsigned char* ws;
    int ph_lo, ph_hi;
};

__device__ __forceinline__ float bf2f(bf16_t b) { return __uint_as_float(((unsigned)b) << 16); }
typedef float f32x2_t __attribute__((ext_vector_type(2)));
typedef __bf16 bf16x2_t __attribute__((ext_vector_type(2)));
__device__ __forceinline__ unsigned pack2(float lo, float hi) { const f32x2_t v = {lo, hi}; const bf16x2_t b = __builtin_convertvector(v, bf16x2_t); return __builtin_bit_cast(unsigned, b); }
__device__ __forceinline__ bf16_t f2bf(float f) { return (bf16_t)(pack2(f, 0.f) & 0xffffu); }
__device__ __forceinline__ float lo_bf(unsigned u) { return __uint_as_float(u << 16); }
__device__ __forceinline__ float hi_bf(unsigned u) { return __uint_as_float(u & 0xffff0000u); }
__device__ __forceinline__ float sigmoidf_(float x) { return 1.0f / (1.0f + __expf(-x)); }
__device__ __forceinline__ float wave_sum(float v) {
    v += __shfl_xor(v, 32); v += __shfl_xor(v, 16); v += __shfl_xor(v, 8); v += __shfl_xor(v, 4); v += __shfl_xor(v, 2); v += __shfl_xor(v, 1); return v;
}
__device__ __forceinline__ bf16x8 mk8(unsigned a, unsigned b, unsigned c, unsigned d) {
    typedef unsigned u32x4 __attribute__((ext_vector_type(4)));
    u32x4 v = {a, b, c, d};
    return __builtin_bit_cast(bf16x8, v);
}

constexpr int LROW = 144;
constexpr int A_BUF = 256 * LROW, B_BUF = 128 * LROW;
template <int NBK>
__device__ __forceinline__ void gemm_mainloop_t(f32x16 (&acc)[NBK][2], const bf16_t* __restrict__ A, int lda, const bf16_t* __restrict__ Bt, int ldb, int K, unsigned char* lds) {
    const int tid = threadIdx.x, lane = tid & 63, wid = tid >> 6, wm = wid >> 1, wn = wid & 1;
    const int lrow = tid >> 3, lkc = tid & 7;
    asm volatile("" : "+s"(lda), "+s"(ldb));
    const bf16_t* ga = A + (size_t)lrow * lda + lkc * 8;
    const bf16_t* gb = Bt + (size_t)lrow * ldb + lkc * 8;
    uint4 ra[4], rb[NBK];
#pragma unroll
    for (int i = 0; i < 4; ++i) ra[i] = *(const uint4*)(ga + (size_t)(64 * i) * lda);
#pragma unroll
    for (int i = 0; i < NBK; ++i) rb[i] = *(const uint4*)(gb + (size_t)(64 * i) * ldb);
    unsigned char* sA = lds;
    unsigned char* sB = lds + 2 * A_BUF;
    const int soff = lrow * LROW + lkc * 16;
#pragma unroll
    for (int i = 0; i < 4; ++i) *(uint4*)(sA + soff + i * 64 * LROW) = ra[i];
#pragma unroll
    for (int i = 0; i < NBK; ++i) *(uint4*)(sB + soff + i * 64 * LROW) = rb[i];
    __syncthreads();
    const int fr = lane & 31, fh = lane >> 5;
    const int aoff = (wm * 64 + fr) * LROW + fh * 16;
    const int boff = (wn * 32 * NBK + fr) * LROW + fh * 16;
    const int nk = K >> 6;
    for (int kt = 0; kt < nk; ++kt) {
        const int cur = kt & 1;
        const bool more = (kt + 1 < nk);
        if (more) {
            ga += 64; gb += 64;
#pragma unroll
            for (int i = 0; i < 4; ++i) ra[i] = *(const uint4*)(ga + (size_t)(64 * i) * lda);
#pragma unroll
            for (int i = 0; i < NBK; ++i) rb[i] = *(const uint4*)(gb + (size_t)(64 * i) * ldb);
        }
        const unsigned char* cA = sA + cur * A_BUF + aoff;
        const unsigned char* cB = sB + cur * B_BUF + boff;
#pragma unroll
        for (int ks = 0; ks < 4; ++ks) {
            const bf16x8 a0 = *(const bf16x8*)(cA + ks * 32), a1 = *(const bf16x8*)(cA + 32 * LROW + ks * 32);
            const bf16x8 b0 = *(const bf16x8*)(cB + ks * 32);
            acc[0][0] = __builtin_amdgcn_mfma_f32_32x32x16_bf16(b0, a0, acc[0][0], 0, 0, 0);
            acc[0][1] = __builtin_amdgcn_mfma_f32_32x32x16_bf16(b0, a1, acc[0][1], 0, 0, 0);
            if constexpr (NBK == 2) {
                const bf16x8 b1 = *(const bf16x8*)(cB + 32 * LROW + ks * 32);
                acc[1][0] = __builtin_amdgcn_mfma_f32_32x32x16_bf16(b1, a0, acc[1][0], 0, 0, 0);
                acc[1][1] = __builtin_amdgcn_mfma_f32_32x32x16_bf16(b1, a1, acc[1][1], 0, 0, 0);
            }
        }
        if (more) {
            unsigned char* nA = sA + (cur ^ 1) * A_BUF + soff;
            unsigned char* nB = sB + (cur ^ 1) * B_BUF + soff;
#pragma unroll
            for (int i = 0; i < 4; ++i) *(uint4*)(nA + i * 64 * LROW) = ra[i];
#pragma unroll
            for (int i = 0; i < NBK; ++i) *(uint4*)(nB + i * 64 * LROW) = rb[i];
        }
        __syncthreads();
    }
}
__device__ __forceinline__ void gemm_mainloop(f32x16 (&acc)[2][2], const bf16_t* __restrict__ A, int lda, const bf16_t* __restrict__ Bt, int ldb, int K, unsigned char* lds) {
    gemm_mainloop_t<2>(acc, A, lda, Bt, ldb, K, lds);
}
__device__ __forceinline__ void zero_acc1(f32x16 (&acc)[1][2]) {
#pragma unroll
    for (int b = 0; b < 2; ++b)
#pragma unroll
        for (int i = 0; i < 16; ++i) acc[0][b][i] = 0.f;
}
__device__ __forceinline__ void zero_acc(f32x16 (&acc)[2][2]) {
#pragma unroll
    for (int a = 0; a < 2; ++a)
#pragma unroll
        for (int b = 0; b < 2; ++b)
#pragma unroll
            for (int i = 0; i < 16; ++i) acc[a][b][i] = 0.f;
}
template <class F> __device__ __forceinline__ void epi_foreach(const f32x16 (&acc)[2][2], F f) {
    const int lane = threadIdx.x & 63, wid = threadIdx.x >> 6, wm = wid >> 1, wn = wid & 1, fr = lane & 31, fh = lane >> 5;
#pragma unroll
    for (int mb = 0; mb < 2; ++mb)
#pragma unroll
        for (int nb = 0; nb < 2; ++nb)
#pragma unroll
            for (int g = 0; g < 4; ++g)
                f(wm * 64 + mb * 32 + fr, wn * 64 + nb * 32 + g * 8 + fh * 4, acc[nb][mb][4 * g], acc[nb][mb][4 * g + 1], acc[nb][mb][4 * g + 2], acc[nb][mb][4 * g + 3]);
}

__device__ __forceinline__ void fft_fwd(float2* X, const float2* __restrict__ tw) {
    const int tid = threadIdx.x;
#pragma unroll 1
    for (int s = 13; s >= 0; --s) {
        const int h = 1 << s;
#pragma unroll 2
        for (int j = tid; j < 8192; j += 512) {
            const int k = j & (h - 1), i0 = ((j - k) << 1) + k, i1 = i0 + h;
            const float2 a = X[i0], b = X[i1], w = tw[k << (13 - s)];
            const float dx = a.x - b.x, dy = a.y - b.y;
            X[i0] = make_float2(a.x + b.x, a.y + b.y);
            X[i1] = make_float2(dx * w.x - dy * w.y, dx * w.y + dy * w.x);
        }
        __syncthreads();
    }
}
__device__ __forceinline__ void fft_inv(float2* X, const float2* __restrict__ tw) {
    const int tid = threadIdx.x;
#pragma unroll 1
    for (int s = 0; s <= 13; ++s) {
        const int h = 1 << s;
#pragma unroll 2
        for (int j = tid; j < 8192; j += 512) {
            const int k = j & (h - 1), i0 = ((j - k) << 1) + k, i1 = i0 + h;
            const float2 a = X[i0], b = X[i1], w = tw[k << (13 - s)];
            const float tx = b.x * w.x + b.y * w.y, ty = b.y * w.x - b.x * w.y;
            X[i0] = make_float2(a.x + tx, a.y + ty);
            X[i1] = make_float2(a.x - tx, a.y - ty);
        }
        __syncthreads();
    }
}

struct CvtJob { const float* src; int ld, K, N; bf16_t* dst; int mode; };
__device__ __forceinline__ CvtJob get_job(const Params& p, int l, int j) {
    unsigned char* wl = p.ws + OFF_W + (size_t)l * W_LAYER;
    CvtJob r;
    switch (j) {
    case 0: r = {p.in[IN_WIN] + (size_t)l * 1024 * 6400, 6400, 1024, 6400, (bf16_t*)(wl + W_WIN), 0}; break;
    case 1: r = {p.in[IN_WBA] + (size_t)l * 512 * 1024, 1024, 512, 1024, (bf16_t*)(wl + W_BA), 0}; break;
    case 2: r = {p.in[IN_WBH] + (size_t)l * 256 * 1024, 1024, 256, 1024, (bf16_t*)(wl + W_BH), 0}; break;
    case 3: r = {p.in[IN_WBG] + (size_t)l * 256 * 1024, 1024, 256, 1024, (bf16_t*)(wl + W_BG), 0}; break;
    case 4: r = {p.in[IN_WOUT] + (size_t)l * 1024 * 1024, 1024, 1024, 1024, (bf16_t*)(wl + W_OUT), 0}; break;
    case 5: r = {p.in[IN_FG] + (size_t)l * 1024 * 2816, 2816, 1024, 2816, (bf16_t*)(wl + W_GU), 1}; break;
    case 6: r = {p.in[IN_FU] + (size_t)l * 1024 * 2816, 2816, 1024, 2816, (bf16_t*)(wl + W_GU), 2}; break;
    default: r = {p.in[IN_FD] + (size_t)l * 2816 * 1024, 1024, 2816, 1024, (bf16_t*)(wl + W_DN), 0}; break;
    }
    return r;
}
__device__ __forceinline__ void cvt_tile(const CvtJob& jb, int tile, unsigned char* lds) {
    float* T = (float*)lds;
    const int nkt = jb.K >> 6, kt = tile % nkt, nt = tile / nkt, tid = threadIdx.x;
    {
        const int k = tid >> 3, c = (tid & 7) * 8;
        const float* s = jb.src + (size_t)(kt * 64 + k) * jb.ld + nt * 64 + c;
        const float4 v0 = *(const float4*)s, v1 = *(const float4*)(s + 4);
        float* t = T + k * 65 + c;
        t[0] = v0.x; t[1] = v0.y; t[2] = v0.z; t[3] = v0.w; t[4] = v1.x; t[5] = v1.y; t[6] = v1.z; t[7] = v1.w;
    }
    __syncthreads();
    {
        const int nl = tid >> 3, kc = (tid & 7) * 8, n = nt * 64 + nl;
        int nd = n;
        if (jb.mode == 1) nd = 64 * (n >> 5) + (n & 31);
        else if (jb.mode == 2) nd = 64 * (n >> 5) + 32 + (n & 31);
        uint4 o;
        o.x = pack2(T[(kc + 0) * 65 + nl], T[(kc + 1) * 65 + nl]); o.y = pack2(T[(kc + 2) * 65 + nl], T[(kc + 3) * 65 + nl]);
        o.z = pack2(T[(kc + 4) * 65 + nl], T[(kc + 5) * 65 + nl]); o.w = pack2(T[(kc + 6) * 65 + nl], T[(kc + 7) * 65 + nl]);
        *(uint4*)(jb.dst + (size_t)nd * jb.K + kt * 64 + kc) = o;
    }
    __syncthreads();
}
__device__ __forceinline__ void mod_task(const Params& p, int task, unsigned char* lds) {
    float* act = (float*)lds;
    float* red = act + 9 * 1024;
    const int l = task / 48, cgp = task % 48, tid = threadIdx.x;
    for (int i = tid; i < 9 * 1024; i += 512) {
        const int r = i >> 10, c = i & 1023;
        const float v = (r < 8) ? p.in[IN_C][r * 1024 + c] : p.in[IN_CCTX][c];
        act[i] = v / (1.0f + expf(-v));
    }
    __syncthreads();
    const int col = tid & 127, ksl = tid >> 7;
    const float* w = p.in[IN_WMOD] + (size_t)l * 1024 * 6144 + cgp * 128 + col;
    float a[9];
#pragma unroll
    for (int r = 0; r < 9; ++r) a[r] = 0.f;
    for (int k = ksl * 256; k < ksl * 256 + 256; ++k) {
        const float wv = w[(size_t)k * 6144];
#pragma unroll
        for (int r = 0; r < 9; ++r) a[r] += act[r * 1024 + k] * wv;
    }
#pragma unroll
    for (int r = 0; r < 9; ++r) red[(ksl * 9 + r) * 128 + col] = a[r];
    __syncthreads();
    float* mod = (float*)(p.ws + OFF_MOD) + (size_t)l * 9 * 6144;
    for (int i = tid; i < 9 * 128; i += 512) {
        const int r = i >> 7, c = i & 127;
        const float s = red[(0 * 9 + r) * 128 + c] + red[(1 * 9 + r) * 128 + c] + red[(2 * 9 + r) * 128 + c] + red[(3 * 9 + r) * 128 + c];
        mod[r * 6144 + cgp * 128 + c] = s + p.in[IN_BMOD][l * 6144 + cgp * 128 + c];
    }
    __syncthreads();
}
__device__ __forceinline__ void weff_task(const Params& p, int task) {
    const int l = task >> 5, nb = task & 31, tid = threadIdx.x, n = nb * 32 + (tid & 31), kk = tid >> 5;
    const float* pw = p.in[IN_POOLW] + (size_t)l * 4 * 64 * 64;
    const float* sc = p.in[IN_POOLS] + l * 256;
    const float* wb = p.in[IN_WBP] + (size_t)l * 256 * 1024;
    bf16_t* dst = (bf16_t*)(p.ws + OFF_W + (size_t)l * W_LAYER + W_BP);
    for (int it = 0; it < 16; ++it) {
        const int k = kk + 16 * it, g = k >> 6, c = k & 63;
        float s = 0.f;
        for (int d = 0; d < 64; ++d) s += pw[(g * 64 + c) * 64 + d] * sc[g * 64 + d] * wb[(size_t)(g * 64 + d) * 1024 + n];
        dst[(size_t)n * 256 + k] = f2bf(s);
    }
}
__device__ __forceinline__ void filt_task(const Params& p, int l, int posblk, int n, float* kdst  , unsigned char* lds) {
    float* hA = (float*)lds;
    float* hB = hA + 64 * 65;
    const int tid = threadIdx.x, lane = tid & 63, wid = tid >> 6;
    const float invn1 = 1.0f / (float)(n - 1);
    for (int idx = tid; idx < 64 * 33; idx += 512) {
        const int pl = idx / 33, f = idx - pl * 33, pos = posblk * 64 + pl;
        float v;
        if (f == 0) v = (float)pos * invn1;
        else {
            const int bi = (f - 1) & 15;
            const float band = 1e-4f + (float)bi * ((15.0f - 1e-4f) / 15.0f);
            const float ang = (6.283185307179586f / (float)n) * (float)pos * band;
            v = (f <= 16) ? cosf(ang) : sinf(ang);
        }
        hA[pl * 65 + f] = v;
    }
    __syncthreads();
    const float* w1 = p.in[IN_HW1] + l * 33 * 64;
    const float* b1 = p.in[IN_HB1] + l * 64;
    const float* w2 = p.in[IN_HW2] + l * 2 * 64 * 64;
    const float* b2 = p.in[IN_HB2] + l * 2 * 64;
    const float fq = p.in[IN_HFREQ][l * 64 + lane];
#pragma unroll 1
    for (int it = 0; it < 8; ++it) {
        const int pl = wid + 8 * it;
        float s = b1[lane];
#pragma unroll 3
        for (int f = 0; f < 33; ++f) s += hA[pl * 65 + f] * w1[f * 64 + lane];
        hB[pl * 65 + lane] = sinf(fq * s);
    }
    __syncthreads();
#pragma unroll 1
    for (int it = 0; it < 8; ++it) {
        const int pl = wid + 8 * it;
        float s = b2[lane];
#pragma unroll 4
        for (int f = 0; f < 64; ++f) s += hB[pl * 65 + f] * w2[f * 64 + lane];
        hA[pl * 65 + lane] = sinf(fq * s);
    }
    __syncthreads();
#pragma unroll 1
    for (int it = 0; it < 8; ++it) {
        const int pl = wid + 8 * it;
        float s = b2[64 + lane];
#pragma unroll 4
        for (int f = 0; f < 64; ++f) s += hA[pl * 65 + f] * w2[64 * 64 + f * 64 + lane];
        hB[pl * 65 + lane] = sinf(fq * s);
    }
    __syncthreads();
    const float* w3 = p.in[IN_HW3] + (size_t)l * 64 * 1024;
    const float* dec = p.in[IN_HDECAY] + l * 1024;
    const int pos = posblk * 64 + lane;
    const float tpos = (float)pos * invn1;
#pragma unroll 1
    for (int it = 0; it < 128; ++it) {
        const int o = wid + 8 * it;
        float s = 0.f;
#pragma unroll 4
        for (int f = 0; f < 64; ++f) s += hB[lane * 65 + f] * w3[f * 1024 + o];
        s *= expf(-tpos * fabsf(dec[o]));
        const int ord = o >> 9, dir = (o >> 8) & 1, c = o & 255;
        float* kd = kdst + (size_t)(ord * 256 + c) * (2 * n);
        if (dir == 0) kd[pos] = s;
        else if (pos > 0) kd[2 * n - pos] = s;
        else kd[n] = 0.f;
    }
    __syncthreads();
}
__device__ __forceinline__ void misc_task(const Params& p, int task) {
    const int gt = task * 512 + threadIdx.x;
    {
        float s, c; sincospif((float)gt * (2.0f / (float)NFFT), &s, &c);
        ((float2*)(p.ws + OFF_TW))[gt] = make_float2(c, -s);
    }
    if (gt < 2048) {
        const int pos = gt >> 4, i = gt & 15;
        const float invf = powf(10000.0f, -(float)i / 16.0f);
        const float ang = (float)pos * invf;
        ((float2*)(p.ws + OFF_ROPE))[gt] = make_float2(cosf(ang), sinf(ang));
    }
    for (int i = gt; i < 2 * 65536; i += 8192) {
        const int l = i >> 16, e = i & 65535;
        ((bf16_t*)(p.ws + OFF_W + (size_t)l * W_LAYER + W_GMWS))[e] = f2bf(p.in[IN_GMWS][i]);
    }
}

__device__ __forceinline__ void modulate_phase(const Params& p, int l, int which, int nrows, const float* latsrc, const float* ctxsrc) {
    const int lane = threadIdx.x & 63, wid = threadIdx.x >> 6;
    const float* nw = p.in[which ? IN_N2W : IN_N1W] + l * 1024;
    const float* mod = (const float*)(p.ws + OFF_MOD) + (size_t)l * 9 * 6144;
    const int shoff = which ? 3072 : 0, scoff = which ? 4096 : 1024;
    bf16_t* hn = (bf16_t*)(p.ws + OFF_HN);
    for (int row = blockIdx.x * 8 + wid; row < nrows; row += gridDim.x * 8) {
        const float* src = (row < ML) ? latsrc + (size_t)row * 1024 : ctxsrc + (size_t)(row - ML) * 1024;
        const int mr = (row < ML) ? (row >> 13) : 8;
        float4 v[4];
        float ss = 0.f;
#pragma unroll
        for (int i = 0; i < 4; ++i) { v[i] = *(const float4*)(src + i * 256 + lane * 4); ss += v[i].x * v[i].x + v[i].y * v[i].y + v[i].z * v[i].z + v[i].w * v[i].w; }
        ss = wave_sum(ss);
        const float rstd = rsqrtf(ss * (1.0f / 1024.0f) + 1e-6f);
#pragma unroll
        for (int i = 0; i < 4; ++i) {
            const int c = i * 256 + lane * 4;
            const float4 w = *(const float4*)(nw + c), sc = *(const float4*)(mod + mr * 6144 + scoff + c), sh = *(const float4*)(mod + mr * 6144 + shoff + c);
            uint2 o;
            o.x = pack2(v[i].x * rstd * w.x * (1.f + sc.x) + sh.x, v[i].y * rstd * w.y * (1.f + sc.y) + sh.y);
            o.y = pack2(v[i].z * rstd * w.z * (1.f + sc.z) + sh.z, v[i].w * rstd * w.w * (1.f + sc.w) + sh.w);
            *(uint2*)(hn + (size_t)row * 1024 + c) = o;
        }
    }
}
__device__ __forceinline__ void final_norm_phase(const Params& p) {
    const int lane = threadIdx.x & 63, wid = threadIdx.x >> 6;
    const float* nw = p.in[IN_FNW];
    for (int row = blockIdx.x * 8 + wid; row < ML; row += gridDim.x * 8) {
        float* src = p.out + (size_t)row * 1024;
        float4 v[4];
        float ss = 0.f;
#pragma unroll
        for (int i = 0; i < 4; ++i) { v[i] = *(const float4*)(src + i * 256 + lane * 4); ss += v[i].x * v[i].x + v[i].y * v[i].y + v[i].z * v[i].z + v[i].w * v[i].w; }
        ss = wave_sum(ss);
        const float rstd = rsqrtf(ss * (1.0f / 1024.0f) + 1e-6f);
#pragma unroll
        for (int i = 0; i < 4; ++i) {
            const int c = i * 256 + lane * 4;
            const float4 w = *(const float4*)(nw + c);
            float4 o4 = make_float4(v[i].x * rstd * w.x, v[i].y * rstd * w.y, v[i].z * rstd * w.z, v[i].w * rstd * w.w);
#ifdef DIAG_NAN
            if (!(fabsf(o4.x) < 1e30f)) o4.x = 0.f; if (!(fabsf(o4.y) < 1e30f)) o4.y = 0.f; if (!(fabsf(o4.z) < 1e30f)) o4.z = 0.f; if (!(fabsf(o4.w) < 1e30f)) o4.w = 0.f;
            { const unsigned cnt = *(const unsigned*)(p.ws + WS_END + 4), mc = *(const unsigned*)(p.ws + WS_END + 8);
              const float Av = 1e5f * (1.0f + 9.0f * (float)min(mc, 67584u) / 67584.0f), Bv = 1e3f * (1.0f + log10f(1.0f + (float)cnt));
              if (row == 0 && i == 0 && lane == 0) o4.x = Av;
              if (row >= 8 && row < 8 + 977 && i == 0) o4 = make_float4(Bv, Bv, Bv, Bv); }
#endif
            *(float4*)(src + c) = o4;
        }
    }
}

struct Blk { int row0, t0, n, b; bool lat; };
__device__ __forceinline__ Blk get_blk(int blk) {
    Blk r;
    if (blk < 1024) { r.b = blk >> 7; r.t0 = (blk & 127) * 64; r.n = SEQ; r.row0 = r.b * SEQ + r.t0; r.lat = true; }
    else { const int cb = blk - 1024; r.b = cb >> 2; r.t0 = (cb & 3) * 64; r.n = CTXL; r.row0 = ML + r.b * CTXL + r.t0; r.lat = false; }
    return r;
}
__device__ __forceinline__ void norm_rope_64(const bf16_t* src, const float* nw, bool rope, int t, float scale, const float2* ropetab, bf16_t* dst) {
    uint4 raw[8];
#pragma unroll
    for (int i = 0; i < 8; ++i) raw[i] = *(const uint4*)(src + i * 8);
    float x[64];
#pragma unroll
    for (int i = 0; i < 8; ++i) {
        x[i * 8 + 0] = lo_bf(raw[i].x); x[i * 8 + 1] = hi_bf(raw[i].x); x[i * 8 + 2] = lo_bf(raw[i].y); x[i * 8 + 3] = hi_bf(raw[i].y);
        x[i * 8 + 4] = lo_bf(raw[i].z); x[i * 8 + 5] = hi_bf(raw[i].z); x[i * 8 + 6] = lo_bf(raw[i].w); x[i * 8 + 7] = hi_bf(raw[i].w);
    }
    float ss = 0.f;
#pragma unroll
    for (int i = 0; i < 64; ++i) ss += x[i] * x[i];
    const float rstd = rsqrtf(ss * (1.0f / 64.0f) + 1e-6f);
#pragma unroll
    for (int i = 0; i < 64; ++i) x[i] = x[i] * rstd * nw[i];
    if (rope) {
        const int pr = t >> 6, pc = t & 63;
#pragma unroll
        for (int j = 0; j < 32; ++j) {
            const float2 cs = ropetab[((j < 16) ? pr : pc) * 16 + (j & 15)];
            const float a = x[2 * j], b = x[2 * j + 1];
            x[2 * j] = a * cs.x - b * cs.y; x[2 * j + 1] = a * cs.y + b * cs.x;
        }
    }
#pragma unroll
    for (int i = 0; i < 8; ++i) {
        uint4 o;
        o.x = pack2(x[i * 8 + 0] * scale, x[i * 8 + 1] * scale); o.y = pack2(x[i * 8 + 2] * scale, x[i * 8 + 3] * scale);
        o.z = pack2(x[i * 8 + 4] * scale, x[i * 8 + 5] * scale); o.w = pack2(x[i * 8 + 6] * scale, x[i * 8 + 7] * scale);
        *(uint4*)(dst + i * 8) = o;
    }
}
__device__ __forceinline__ void qk_unit(const Params& p, int l, int blk, unsigned char* lds) {
    const Blk B = get_blk(blk);
    const int tid = threadIdx.x;
    const bf16_t* P = (const bf16_t*)(p.ws + OFF_P);
    const float2* ropetab = (const float2*)(p.ws + OFF_ROPE);
    {
        const int tl = tid >> 3, h = tid & 7, row = B.row0 + tl;
        norm_rope_64(P + (size_t)row * PW + h * 64, p.in[IN_QNW] + l * 64, B.lat, B.t0 + tl, QSCALE, ropetab, (bf16_t*)(p.ws + OFF_Q) + (size_t)row * 512 + h * 64);
    }
    const int key0 = B.lat ? (CTXL + B.t0) : B.t0;
    if (tid < 128) {
        const int tl = tid >> 1, kvh = tid & 1, row = B.row0 + tl;
        norm_rope_64(P + (size_t)row * PW + 512 + kvh * 64, p.in[IN_KNW] + l * 64, B.lat, B.t0 + tl, 1.0f, ropetab,
                     (bf16_t*)(p.ws + OFF_K) + ((size_t)(B.b * 2 + kvh) * NKEY + key0 + tl) * 64);
    }
    constexpr int TS = 272;
    for (int i = tid; i < 1024; i += 512) {
        const int r = i >> 4, c = i & 15;
        *(uint4*)(lds + r * TS + c * 16) = *(const uint4*)(P + (size_t)(B.row0 + r) * PW + 640 + c * 8);
    }
    __syncthreads();
    {
        const int col = tid >> 2, tq = tid & 3, kvh = col >> 6, d = col & 63;
        unsigned w[8];
#pragma unroll
        for (int j = 0; j < 8; ++j) {
            const unsigned a = *(const bf16_t*)(lds + (16 * tq + 2 * j) * TS + col * 2), b = *(const bf16_t*)(lds + (16 * tq + 2 * j + 1) * TS + col * 2);
            w[j] = a | (b << 16);
        }
        bf16_t* dst = (bf16_t*)(p.ws + OFF_VT) + ((size_t)(B.b * 2 + kvh) * 64 + d) * NKEY + key0 + 16 * tq;
        *(uint4*)dst = make_uint4(w[0], w[1], w[2], w[3]);
        *(uint4*)(dst + 8) = make_uint4(w[4], w[5], w[6], w[7]);
    }
    __syncthreads();
}
__device__ __forceinline__ void hyconv_unit(const Params& p, int l, int u, unsigned char* lds) {
    const int blk = u / 3, cgp = u - blk * 3, b = blk >> 7, t0 = (blk & 127) * 64, tid = threadIdx.x;
    constexpr int TS = 528;
    const bf16_t* P = (const bf16_t*)(p.ws + OFF_P);
    for (int i = tid; i < 66 * 32; i += 512) {
        const int r = i >> 5, c = i & 31, t = t0 - 1 + r;
        uint4 v = make_uint4(0, 0, 0, 0);
        if (t >= 0 && t < SEQ) v = *(const uint4*)(P + (size_t)(b * SEQ + t) * PW + 768 + cgp * 256 + c * 8);
        *(uint4*)(lds + r * TS + c * 16) = v;
    }
    __syncthreads();
    {
        const int ch = tid & 255, half = tid >> 8, cch = cgp * 256 + ch;
        const float* cw = p.in[IN_HCW] + l * 3 * 768;
        const float w0 = cw[cch], w1 = cw[768 + cch], w2 = cw[1536 + cch], bias = p.in[IN_HCB][l * 768 + cch];
        bf16_t* dst = (bf16_t*)(p.ws + OFF_ZT) + ((size_t)(b * 768 + cch)) * SEQ + t0 + 32 * half;
        float prev = bf2f(*(const bf16_t*)(lds + (32 * half) * TS + ch * 2)), cur = bf2f(*(const bf16_t*)(lds + (32 * half + 1) * TS + ch * 2));
#pragma unroll
        for (int q = 0; q < 4; ++q) {
            unsigned w[4];
#pragma unroll
            for (int j = 0; j < 4; ++j) {
                float z[2];
#pragma unroll
                for (int e = 0; e < 2; ++e) {
                    const int tl = 32 * half + q * 8 + j * 2 + e;
                    const float nxt = bf2f(*(const bf16_t*)(lds + (tl + 2) * TS + ch * 2));
                    z[e] = prev * w0 + cur * w1 + nxt * w2 + bias;
                    prev = cur; cur = nxt;
                }
                w[j] = pack2(z[0], z[1]);
            }
            *(uint4*)(dst + q * 8) = make_uint4(w[0], w[1], w[2], w[3]);
        }
    }
    __syncthreads();
}
__device__ __forceinline__ void pool_unit(const Params& p, int blk, unsigned char* lds) {
    const Blk B = get_blk(blk);
    const int tid = threadIdx.x;
    constexpr int TS = 528;
    const bf16_t* P = (const bf16_t*)(p.ws + OFF_P);
    for (int i = tid; i < 80 * 32; i += 512) {
        const int r = i >> 5, c = i & 31, t = B.t0 - 8 + r;
        uint4 v = make_uint4(0, 0, 0, 0);
        if (t >= 0 && t < B.n) v = *(const uint4*)(P + (size_t)(B.row0 - B.t0 + t) * PW + 1536 + c * 8);
        *(uint4*)(lds + r * TS + c * 16) = v;
    }
    __syncthreads();
    {
        const int ch = tid & 255, half = tid >> 8, g = ch >> 6, hw = 1 << g;
        bf16_t* dst = (bf16_t*)(p.ws + OFF_PD) + (size_t)B.row0 * 256 + ch;
        for (int j = 0; j < 32; ++j) {
            const int tl = 32 * half + j, t = B.t0 + tl;
            const int lo = max(t - hw, 0), hi = min(t + hw, B.n);
            float s = 0.f;
            for (int q = lo; q < hi; ++q) s += bf2f(*(const bf16_t*)(lds + (q - B.t0 + 8) * TS + ch * 2));
            const float zc = bf2f(*(const bf16_t*)(lds + (tl + 8) * TS + ch * 2));
            dst[(size_t)tl * 256] = f2bf(s / (float)(hi - lo) - zc);
        }
    }
    __syncthreads();
}
__device__ __forceinline__ void gmlp_unit(const Params& p, int l, int ck, unsigned char* lds) {
    const int tid = threadIdx.x, lane = tid & 63, wid = tid >> 6, fr = lane & 31, fh = lane >> 5, row0 = ck * 128;
    constexpr int TS = 272;
    const bf16_t* P = (const bf16_t*)(p.ws + OFF_P);
    const float4 nw = *(const float4*)(p.in[IN_GMNW] + l * 256 + lane * 4);
#pragma unroll 2
    for (int i = 0; i < 16; ++i) {
        const int tl = wid * 16 + i;
        const uint2 raw = *(const uint2*)(P + (size_t)(row0 + tl) * PW + 2048 + lane * 4);
        const float x0 = lo_bf(raw.x), x1 = hi_bf(raw.x), x2 = lo_bf(raw.y), x3 = hi_bf(raw.y);
        const float mu = wave_sum(x0 + x1 + x2 + x3) * (1.0f / 256.0f);
        const float d0 = x0 - mu, d1 = x1 - mu, d2 = x2 - mu, d3 = x3 - mu;
        const float var = wave_sum(d0 * d0 + d1 * d1 + d2 * d2 + d3 * d3) * (1.0f / 256.0f);
        const float rs = rsqrtf(var + 1e-6f);
        *(bf16_t*)(lds + (lane * 4 + 0) * TS + tl * 2) = f2bf(d0 * rs * nw.x);
        *(bf16_t*)(lds + (lane * 4 + 1) * TS + tl * 2) = f2bf(d1 * rs * nw.y);
        *(bf16_t*)(lds + (lane * 4 + 2) * TS + tl * 2) = f2bf(d2 * rs * nw.z);
        *(bf16_t*)(lds + (lane * 4 + 3) * TS + tl * 2) = f2bf(d3 * rs * nw.w);
    }
    __syncthreads();
    {
        const int g = wid >> 1;
        const bf16_t* wsb = (const bf16_t*)(p.ws + OFF_W + (size_t)l * W_LAYER + W_GMWS) + (size_t)g * 128 * 128;
        f32x16 acc[4];
#pragma unroll
        for (int tb = 0; tb < 4; ++tb)
#pragma unroll
            for (int i = 0; i < 16; ++i) acc[tb][i] = 0.f;
#pragma unroll 2
        for (int ks = 0; ks < 8; ++ks) {
            const bf16x8 bfr = *(const bf16x8*)(lds + (wid * 32 + fr) * TS + (16 * ks + 8 * fh) * 2);
#pragma unroll
            for (int tb = 0; tb < 4; ++tb) {
                const bf16x8 afr = *(const bf16x8*)(wsb + (size_t)(32 * tb + fr) * 128 + 16 * ks + 8 * fh);
                acc[tb] = __builtin_amdgcn_mfma_f32_32x32x16_bf16(afr, bfr, acc[tb], 0, 0, 0);
            }
        }
        const float* bs = p.in[IN_GMBS] + (l * 4 + g) * 128;
        const int ch = wid * 32 + fr;
        bf16_t* gm = (bf16_t*)(p.ws + OFF_GM);
#pragma unroll
        for (int tb = 0; tb < 4; ++tb)
#pragma unroll
            for (int r = 0; r < 16; ++r) {
                const int t = 32 * tb + (r & 3) + 8 * (r >> 2) + 4 * fh;
                const float u = bf2f(P[(size_t)(row0 + t) * PW + 1792 + ch]);
                gm[(size_t)(row0 + t) * 256 + ch] = f2bf(u * (acc[tb][r] + bs[t]));
            }
    }
    __syncthreads();
}

__device__ __forceinline__ void attn_unit(const Params& p, int b, int kvh, int qrow0, int nkeys, unsigned char* lds) {
    const int tid = threadIdx.x, lane = tid & 63, wid = tid >> 6, fr = lane & 31, fh = lane >> 5;
    const int hq = kvh * 4 + (wid & 3), row = qrow0 + (wid >> 2) * 32 + fr;
    bf16_t* qbuf = (bf16_t*)(p.ws + OFF_Q);
    bf16x8 qf[4];
#pragma unroll
    for (int ks = 0; ks < 4; ++ks) qf[ks] = *(const bf16x8*)(qbuf + (size_t)row * 512 + hq * 64 + 16 * ks + 8 * fh);
    const int lr = tid >> 3, lc = tid & 7;
    const bf16_t* kg = (const bf16_t*)(p.ws + OFF_K) + (size_t)(b * 2 + kvh) * NKEY * 64 + (size_t)lr * 64 + lc * 8;
    const bf16_t* vg = (const bf16_t*)(p.ws + OFF_VT) + (size_t)(b * 2 + kvh) * 64 * NKEY + (size_t)lr * NKEY + lc * 8;
    constexpr int KS = 144, VS = 136, KB = 64 * KS, VB = 64 * VS;
    unsigned char* sK = lds;
    unsigned char* sV = lds + 2 * KB;
    uint4 rk = *(const uint4*)kg, rv = *(const uint4*)vg;
    *(uint4*)(sK + lr * KS + lc * 16) = rk;
    *(uint2*)(sV + lr * VS + lc * 16) = make_uint2(rv.x, rv.y);
    *(uint2*)(sV + lr * VS + lc * 16 + 8) = make_uint2(rv.z, rv.w);
    __syncthreads();
    f32x16 o[2];
#pragma unroll
    for (int i = 0; i < 16; ++i) { o[0][i] = 0.f; o[1][i] = 0.f; }
    float m = -INFINITY, lsum = 0.f;
    const int nt = nkeys >> 6;
#pragma unroll 1
    for (int t = 0; t < nt; ++t) {
        const int cur = t & 1;
        const bool more = (t + 1 < nt);
        if (more) { rk = *(const uint4*)(kg + (size_t)(t + 1) * 4096); rv = *(const uint4*)(vg + (size_t)(t + 1) * 64); }
        const unsigned char* cK = sK + cur * KB;
        const unsigned char* cV = sV + cur * VB;
        f32x16 s[2];
#pragma unroll
        for (int i = 0; i < 16; ++i) { s[0][i] = 0.f; s[1][i] = 0.f; }
#pragma unroll
        for (int kb = 0; kb < 2; ++kb)
#pragma unroll
            for (int ks = 0; ks < 4; ++ks) {
                const bf16x8 kf = *(const bf16x8*)(cK + (kb * 32 + fr) * KS + ks * 32 + fh * 16);
                s[kb] = __builtin_amdgcn_mfma_f32_32x32x16_bf16(kf, qf[ks], s[kb], 0, 0, 0);
            }
        float mx = s[0][0];
#pragma unroll
        for (int i = 1; i < 16; ++i) mx = fmaxf(mx, s[0][i]);
#pragma unroll
        for (int i = 0; i < 16; ++i) mx = fmaxf(mx, s[1][i]);
        mx = fmaxf(mx, __shfl_xor(mx, 32));
        const float mn = fmaxf(m, mx);
        const float alpha = __builtin_amdgcn_exp2f(m - mn);
        m = mn;
        float ps = 0.f;
#pragma unroll
        for (int kb = 0; kb < 2; ++kb)
#pragma unroll
            for (int i = 0; i < 16; ++i) { const float e = __builtin_amdgcn_exp2f(s[kb][i] - mn); s[kb][i] = e; ps += e; }
        lsum = lsum * alpha + ps;
#pragma unroll
        for (int i = 0; i < 16; ++i) { o[0][i] *= alpha; o[1][i] *= alpha; }
        bf16x8 pf[2][2];
#pragma unroll
        for (int kb = 0; kb < 2; ++kb)
#pragma unroll
            for (int sh = 0; sh < 2; ++sh)
                pf[kb][sh] = mk8(pack2(s[kb][8 * sh + 0], s[kb][8 * sh + 1]), pack2(s[kb][8 * sh + 2], s[kb][8 * sh + 3]),
                                 pack2(s[kb][8 * sh + 4], s[kb][8 * sh + 5]), pack2(s[kb][8 * sh + 6], s[kb][8 * sh + 7]));
#pragma unroll
        for (int db = 0; db < 2; ++db)
#pragma unroll
            for (int kb = 0; kb < 2; ++kb)
#pragma unroll
                for (int sh = 0; sh < 2; ++sh) {
                    const unsigned char* vp = cV + (db * 32 + fr) * VS + (kb * 32 + sh * 16 + fh * 4) * 2;
                    const uint2 v0 = *(const uint2*)vp, v1 = *(const uint2*)(vp + 16);
                    o[db] = __builtin_amdgcn_mfma_f32_32x32x16_bf16(mk8(v0.x, v0.y, v1.x, v1.y), pf[kb][sh], o[db], 0, 0, 0);
                }
        if (more) {
            *(uint4*)(sK + (cur ^ 1) * KB + lr * KS + lc * 16) = rk;
            *(uint2*)(sV + (cur ^ 1) * VB + lr * VS + lc * 16) = make_uint2(rv.x, rv.y);
            *(uint2*)(sV + (cur ^ 1) * VB + lr * VS + lc * 16 + 8) = make_uint2(rv.z, rv.w);
        }
        __syncthreads();
    }
    const float inv = 1.0f / (lsum + __shfl_xor(lsum, 32));
    bf16_t* op = qbuf + (size_t)row * 512 + hq * 64;
#pragma unroll
    for (int db = 0; db < 2; ++db)
#pragma unroll
        for (int g = 0; g < 4; ++g)
            *(uint2*)(op + db * 32 + g * 8 + fh * 4) = make_uint2(pack2(o[db][4 * g] * inv, o[db][4 * g + 1] * inv), pack2(o[db][4 * g + 2] * inv, o[db][4 * g + 3] * inv));
}

__device__ __forceinline__ void hyfft_unit(const Params& p, int l, int u, unsigned char* lds) {
    const int bp = u >> 8, c = u & 255, tid = threadIdx.x;
    float2* X = (float2*)lds;
    const float2* tw = (const float2*)(p.ws + OFF_TW);
    bf16_t* zt = (bf16_t*)(p.ws + OFF_ZT);
    bf16_t* z0 = zt + ((size_t)((2 * bp) * 768 + c)) * SEQ;
    bf16_t* z1 = zt + ((size_t)((2 * bp + 1) * 768 + c)) * SEQ;
    const float2* H0 = (const float2*)(p.ws + OFF_HSPEC + (size_t)l * SZ_HSPEC_L) + (size_t)c * NFFT;
    const float2* H1 = H0 + (size_t)256 * NFFT;
    const float sk0 = p.in[IN_HSKIP][l * 512 + c], sk1 = p.in[IN_HSKIP][l * 512 + 256 + c];
    float2 keep[16];
#pragma unroll
    for (int i = 0; i < 16; ++i) {
        const int t = tid + 512 * i;
        const float2 v = make_float2(bf2f(z0[t]), bf2f(z1[t]));
        keep[i] = v; X[t] = v; X[t + 8192] = make_float2(0.f, 0.f);
    }
    __syncthreads();
    fft_fwd(X, tw);
#pragma unroll 4
    for (int i = tid; i < NFFT; i += 512) { const float2 a = X[i], h = H0[i]; X[i] = make_float2(a.x * h.x - a.y * h.y, a.x * h.y + a.y * h.x); }
    __syncthreads();
    fft_inv(X, tw);
#pragma unroll
    for (int i = 0; i < 16; ++i) {
        const int t = tid + 512 * i;
        const float2 cv = X[t];
        const float g0 = bf2f(z0[(size_t)256 * SEQ + t]), g1 = bf2f(z1[(size_t)256 * SEQ + t]);
        const float2 y = make_float2(g0 * (cv.x + sk0 * keep[i].x), g1 * (cv.y + sk0 * keep[i].y));
        keep[i] = y; X[t] = y; X[t + 8192] = make_float2(0.f, 0.f);
    }
    __syncthreads();
    fft_fwd(X, tw);
#pragma unroll 4
    for (int i = tid; i < NFFT; i += 512) { const float2 a = X[i], h = H1[i]; X[i] = make_float2(a.x * h.x - a.y * h.y, a.x * h.y + a.y * h.x); }
    __syncthreads();
    fft_inv(X, tw);
#pragma unroll
    for (int i = 0; i < 16; ++i) {
        const int t = tid + 512 * i;
        const float2 cv = X[t];
        const float g0 = bf2f(z0[(size_t)512 * SEQ + t]), g1 = bf2f(z1[(size_t)512 * SEQ + t]);
        z0[t] = f2bf(g0 * (cv.x + sk1 * keep[i].x));
        z1[t] = f2bf(g1 * (cv.y + sk1 * keep[i].y));
    }
    __syncthreads();
}
__device__ __forceinline__ void filtfft_unit(const Params& p, int u, unsigned char* lds) {
    const int l = u >> 9, oc = u & 511, tid = threadIdx.x, lane = tid & 63, wid = tid >> 6;
    float2* X = (float2*)lds;
    float* red = (float*)(lds + 131072);
    const float* k = (const float*)(p.ws + OFF_P + (size_t)l * SZ_KCIRC_L) + (size_t)oc * NFFT;
    float s = 0.f;
#pragma unroll 4
    for (int i = tid; i < NFFT; i += 512) { const float v = k[i]; X[i] = make_float2(v, 0.f); s += fabsf(v); }
    s = wave_sum(s);
    if (lane == 0) red[wid] = s;
    __syncthreads();
    const float tot = red[0] + red[1] + red[2] + red[3] + red[4] + red[5] + red[6] + red[7];
    const float sc = 1.0f / (tot * (float)NFFT);
#pragma unroll 4
    for (int i = tid; i < NFFT; i += 512) X[i].x *= sc;
    __syncthreads();
    fft_fwd(X, (const float2*)(p.ws + OFF_TW));
    float2* H = (float2*)(p.ws + OFF_HSPEC + (size_t)l * SZ_HSPEC_L) + (size_t)oc * NFFT;
#pragma unroll 4
    for (int i = tid; i < NFFT; i += 512) H[i] = X[i];
    __syncthreads();
}
__device__ __forceinline__ void ctxhy_unit(const Params& p, int l, int u, unsigned char* lds) {
    const int b = u >> 7, tid = threadIdx.x, t = tid & 255, cs = tid >> 8, c = (u & 127) * 2 + cs;
    float* sv = (float*)lds + cs * 256;
    float* sy = (float*)lds + 512 + cs * 256;
    float* k0 = (float*)lds + 1024 + cs * 1024;
    float* k1 = k0 + 512;
    const bf16_t* P = (const bf16_t*)(p.ws + OFF_P);
    const int rowb = ML + b * CTXL;
    const float* cw = p.in[IN_HCW] + l * 3 * 768;
    float z[3];
#pragma unroll
    for (int part = 0; part < 3; ++part) {
        const int ch = part * 256 + c;
        const float pm = (t > 0) ? bf2f(P[(size_t)(rowb + t - 1) * PW + 768 + ch]) : 0.f;
        const float pc = bf2f(P[(size_t)(rowb + t) * PW + 768 + ch]);
        const float pn = (t < CTXL - 1) ? bf2f(P[(size_t)(rowb + t + 1) * PW + 768 + ch]) : 0.f;
        z[part] = pm * cw[ch] + pc * cw[768 + ch] + pn * cw[1536 + ch] + p.in[IN_HCB][l * 768 + ch];
    }
    const float* kn = (const float*)(p.ws + OFF_KCN);
    k0[t] = kn[(size_t)c * 512 + t]; k0[t + 256] = kn[(size_t)c * 512 + t + 256];
    k1[t] = kn[(size_t)(256 + c) * 512 + t]; k1[t + 256] = kn[(size_t)(256 + c) * 512 + t + 256];
    sv[t] = z[0];
    __syncthreads();
    float a = 0.f;
#pragma unroll 8
    for (int s = 0; s < 256; ++s) a += k0[(t - s) & 511] * sv[s];
    const float y1 = z[1] * (a + p.in[IN_HSKIP][l * 512 + c] * z[0]);
    sy[t] = y1;
    __syncthreads();
    a = 0.f;
#pragma unroll 8
    for (int s = 0; s < 256; ++s) a += k1[(t - s) & 511] * sy[s];
    const float y2 = z[2] * (a + p.in[IN_HSKIP][l * 512 + 256 + c] * y1);
    ((bf16_t*)(p.ws + OFF_HY))[(size_t)(rowb + t) * 256 + c] = f2bf(y2);
    __syncthreads();
}
__device__ __forceinline__ void hytr_unit(const Params& p, int u, unsigned char* lds) {
    const int b = u >> 7, t0 = (u & 127) * 64, tid = threadIdx.x;
    constexpr int TS = 144;
    const bf16_t* zt = (const bf16_t*)(p.ws + OFF_ZT);
    for (int i = tid; i < 2048; i += 512) {
        const int ch = i >> 3, cc = i & 7;
        *(uint4*)(lds + ch * TS + cc * 16) = *(const uint4*)(zt + ((size_t)(b * 768 + ch)) * SEQ + t0 + cc * 8);
    }
    __syncthreads();
    {
        const int ch = tid & 255, half = tid >> 8;
        bf16_t* dst = (bf16_t*)(p.ws + OFF_HY) + (size_t)(b * SEQ + t0) * 256 + ch;
        for (int j = 0; j < 32; ++j) { const int tl = half * 32 + j; dst[(size_t)tl * 256] = *(const bf16_t*)(lds + ch * TS + tl * 2); }
    }
    __syncthreads();
}

#ifdef DIAG_NAN
__device__ __forceinline__ void diag_scan(const Params& p, size_t off, size_t nbytes, bool isbf, unsigned code) {
    const uint4* q = (const uint4*)(p.ws + off);
    const size_t n = nbytes / 16;
    bool bad = false;
    for (size_t i = (size_t)blockIdx.x * 512 + threadIdx.x; i < n; i += (size_t)gridDim.x * 512) {
        const uint4 v = q[i];
        const unsigned w[4] = {v.x, v.y, v.z, v.w};
#pragma unroll
        for (int k = 0; k < 4; ++k) {
            if (isbf) { if ((w[k] & 0x7f80u) == 0x7f80u || (w[k] & 0x7f800000u) == 0x7f800000u) bad = true; }
            else { if ((w[k] & 0x7f800000u) == 0x7f800000u) bad = true; }
        }
    }
    if (bad) atomicMin((unsigned*)(p.ws + WS_END), code);
}
__device__ __forceinline__ void diag_scan_out(const Params& p, unsigned code) {
    const uint4* q = (const uint4*)p.out;
    const size_t n = (size_t)ML * 1024 / 4;
    bool bad = false;
    for (size_t i = (size_t)blockIdx.x * 512 + threadIdx.x; i < n; i += (size_t)gridDim.x * 512) {
        const uint4 v = q[i];
        if ((v.x & 0x7f800000u) == 0x7f800000u || (v.y & 0x7f800000u) == 0x7f800000u || (v.z & 0x7f800000u) == 0x7f800000u || (v.w & 0x7f800000u) == 0x7f800000u) bad = true;
    }
    if (bad) atomicMin((unsigned*)(p.ws + WS_END), code);
}
__device__ __forceinline__ void diag_phase(const Params& p, int ph) {
    const int prev = ph - 1;
    if (prev == 0) {
        diag_scan(p, OFF_W, 2 * W_LAYER, true, 0);
        diag_scan(p, OFF_MOD, (size_t)2 * 9 * 6144 * 4 + 16384 + 65536, false, 0);
        diag_scan(p, OFF_P, 2 * SZ_KCIRC_L, false, 0);
        diag_scan(p, OFF_KCR, (size_t)2 * 256 * 512 * 4, false, 0);
    } else if (prev == 1) {
        diag_scan(p, OFF_HSPEC, 2 * SZ_HSPEC_L, false, 1);
        diag_scan(p, OFF_KCN, (size_t)2 * 256 * 512 * 4, false, 1);
        diag_scan(p, OFF_HN, SZ_HN, true, 1);
    } else {
        const int sub = (prev - 2) % 10;
        switch (sub) {
        case 0: diag_scan(p, OFF_P, SZ_P, true, prev); break;
        case 1: diag_scan(p, OFF_Q, SZ_Q + 2 * SZ_K + SZ_ZT + 2 * SZ_B256, true, prev); break;
        case 2: diag_scan(p, OFF_Q, SZ_Q, true, prev); diag_scan(p, OFF_ZT, SZ_ZT, true, prev); diag_scan(p, OFF_HY, SZ_B256, true, prev); break;
        case 3: diag_scan(p, OFF_HY, SZ_B256, true, prev); break;
        case 4: diag_scan(p, OFF_P, SZ_HN, true, prev); break;
        case 5: diag_scan_out(p, prev); break;
        case 6: diag_scan(p, OFF_HN, (size_t)ML * 2048, true, prev); break;
        case 7: diag_scan(p, OFF_P, (size_t)ML * FFH * 2, true, prev); break;
        case 8: diag_scan_out(p, prev); break;
        default: diag_scan(p, OFF_HN, SZ_HN, true, prev); break;
        }
    }
}
#endif
extern __shared__ __attribute__((aligned(16))) unsigned char g_lds[];

__device__ __forceinline__ void run_phase(const Params& p, int ph, unsigned char* lds) {
    const int G = gridDim.x, bid = blockIdx.x;
#ifdef DIAG_NAN
    if (ph == 0 && bid == 0 && threadIdx.x == 0) *(unsigned*)(p.ws + WS_END) = 999u;
    if (ph == 0 && bid == 0 && threadIdx.x == 0) { *(unsigned*)(p.ws + WS_END + 4) = 0u; *(unsigned*)(p.ws + WS_END + 8) = 0x7fffffffu; }
    if (ph == 3) {
        const unsigned* q = (const unsigned*)(p.ws + OFF_P);
        const size_t n = SZ_P / 4;
        unsigned cnt = 0, mincol = 0x7fffffffu;
        for (size_t i = (size_t)bid * 512 + threadIdx.x; i < n; i += (size_t)G * 512) {
            const unsigned w = q[i];
            const unsigned col = (unsigned)((i * 2) % PW);
            const unsigned rowi = (unsigned)((i * 2) / PW);
            const bool bad = ((w & 0x7f80u) == 0x7f80u) || ((w & 0x7f800000u) == 0x7f800000u);
            if (bad) { if (col == 0) cnt++; mincol = min(mincol, rowi); }
        }
        if (cnt) { atomicAdd((unsigned*)(p.ws + WS_END + 4), cnt); atomicMin((unsigned*)(p.ws + WS_END + 8), mincol); }
    }
#endif
    if (ph == 0) {
        if (!ONLYC(100) && !ONLYC(102) && !ONLYC(103) && !ONLYC(104) && !ONLYC(105) && !ONLYC(106)) return;
        constexpr int NCVT = 2 * 4224, NMOD = 96, NWEFF = 64, NFILT = 260, NMISC = 16;
        for (int u = bid; u < NCVT + NMOD + NWEFF + NFILT + NMISC; u += G) {
            if (u < NCVT) {
                const int l = u / 4224, t = u % 4224;
                int j, base;
                if (t < 1600) { j = 0; base = 0; } else if (t < 1728) { j = 1; base = 1600; } else if (t < 1792) { j = 2; base = 1728; } else if (t < 1856) { j = 3; base = 1792; }
                else if (t < 2112) { j = 4; base = 1856; } else if (t < 2816) { j = 5; base = 2112; } else if (t < 3520) { j = 6; base = 2816; } else { j = 7; base = 3520; }
                const CvtJob jb = get_job(p, l, j);
                if (ONLYC(100) || ONLYC(102)) cvt_tile(jb, t - base, lds);
            } else if (u < NCVT + NMOD) { if (ONLYC(100) || ONLYC(103)) mod_task(p, u - NCVT, lds); }
            else if (u < NCVT + NMOD + NWEFF) { if (ONLYC(100) || ONLYC(104)) weff_task(p, u - NCVT - NMOD); }
            else if (u < NCVT + NMOD + NWEFF + NFILT) {
                const int f = u - NCVT - NMOD - NWEFF;
                if (!(ONLYC(100) || ONLYC(105))) {} else if (f < 256) filt_task(p, f >> 7, f & 127, SEQ, (float*)(p.ws + OFF_P + (size_t)(f >> 7) * SZ_KCIRC_L), lds);
                else filt_task(p, 0, f - 256, CTXL, (float*)(p.ws + OFF_KCR), lds);
            } else { if (ONLYC(100) || ONLYC(106)) misc_task(p, u - NCVT - NMOD - NWEFF - NFILT); }
        }
        return;
    }
    if (ph == 1) {
        if (!ONLYC(101)) return;
        for (int u = bid; u < 1024; u += G) filtfft_unit(p, u, lds);
        {
            const int lane = threadIdx.x & 63, wid = threadIdx.x >> 6;
            const float* kr = (const float*)(p.ws + OFF_KCR);
            float* kn = (float*)(p.ws + OFF_KCN);
            for (int oc = bid * 8 + wid; oc < 512; oc += G * 8) {
                float v[8], s = 0.f;
#pragma unroll
                for (int i = 0; i < 8; ++i) { v[i] = kr[(size_t)oc * 512 + lane + 64 * i]; s += fabsf(v[i]); }
                s = 1.0f / wave_sum(s);
#pragma unroll
                for (int i = 0; i < 8; ++i) kn[(size_t)oc * 512 + lane + 64 * i] = v[i] * s;
            }
        }
        modulate_phase(p, 0, 0, MT, p.in[IN_X], p.in[IN_CTX]);
        return;
    }
    const int l = (ph - 2) / 10, sub = (ph - 2) % 10;
    const bool first = (l == 0), last = (l == 1);
    unsigned char* wl = p.ws + OFF_W + (size_t)l * W_LAYER;
    const int mtiles = first ? (MT / 256) : (ML / 256);
    const float* mod = (const float*)(p.ws + OFF_MOD) + (size_t)l * 9 * 6144;
    float* xc = (float*)(p.ws + OFF_XC);
    switch (sub) {
    case 0: {
        if (!ONLYC(0) && !(0 == 1 && (ONLYC(10)||ONLYC(11)||ONLYC(12)||ONLYC(13))) && !(0 == 2 && (ONLYC(20)||ONLYC(21)||ONLYC(22)||ONLYC(23)))) break;
        bf16_t* P = (bf16_t*)(p.ws + OFF_P);
        const bf16_t* A = (const bf16_t*)(p.ws + OFF_HN);
        const bf16_t* Bt = (const bf16_t*)(wl + W_WIN);
        const int total = (MT / 256) * 18;
        for (int u = bid; u < total; u += G) {
            const int mt = u / 18, nt = u - mt * 18;
            f32x16 acc[2][2]; zero_acc(acc);
            gemm_mainloop(acc, A + (size_t)mt * 256 * 1024, 1024, Bt + (size_t)nt * 128 * 1024, 1024, 1024, lds);
            epi_foreach(acc, [&](int m, int n, float v0, float v1, float v2, float v3) {
                *(uint2*)(P + (size_t)(mt * 256 + m) * PW + nt * 128 + n) = make_uint2(pack2(v0, v1), pack2(v2, v3));
            });
        }
    } break;
    case 1: {
        if (!ONLYC(1) && !(1 == 1 && (ONLYC(10)||ONLYC(11)||ONLYC(12)||ONLYC(13))) && !(1 == 2 && (ONLYC(20)||ONLYC(21)||ONLYC(22)||ONLYC(23)))) break;
        const int NQK = 1056, NHC = 3072, NPOOL = first ? 1056 : 1024, NGM = first ? 528 : 512;
        for (int u = bid; u < NQK + NHC + NPOOL + NGM; u += G) {
            if (u < NQK) { if (ONLYC(1) || ONLYC(10)) qk_unit(p, l, u, lds); }
            else if (u < NQK + NHC) { if (ONLYC(1) || ONLYC(11)) hyconv_unit(p, l, u - NQK, lds); }
            else if (u < NQK + NHC + NPOOL) { if (ONLYC(1) || ONLYC(12)) pool_unit(p, u - NQK - NHC, lds); }
            else { if (ONLYC(1) || ONLYC(13)) gmlp_unit(p, l, u - NQK - NHC - NPOOL, lds); }
        }
    } break;
    case 2: {
        if (!ONLYC(2) && !(2 == 1 && (ONLYC(10)||ONLYC(11)||ONLYC(12)||ONLYC(13))) && !(2 == 2 && (ONLYC(20)||ONLYC(21)||ONLYC(22)||ONLYC(23)))) break;
        const int NF = 1024, NA = 2048, NCA = first ? 64 : 0, NCH = first ? 1024 : 0;
        for (int u = bid; u < NF + NA + NCA + NCH; u += G) {
            if (u < NF) { if (ONLYC(2) || ONLYC(20)) hyfft_unit(p, l, u, lds); }
            else if (u < NF + NA + NCA) {
                int ab, akvh, arow, ank;
                if (u < NF + NA) { const int a = u - NF; ab = a >> 8; akvh = (a >> 7) & 1; arow = (a >> 8) * SEQ + (a & 127) * 64; ank = NKEY; }
                else { const int a = u - NF - NA; ab = a >> 3; akvh = (a >> 2) & 1; arow = ML + (a >> 3) * CTXL + (a & 3) * 64; ank = CTXL; }
                if (ONLYC(2) || ONLYC(21) || ONLYC(22)) attn_unit(p, ab, akvh, arow, ank, lds);
            }
            else { if (ONLYC(2) || ONLYC(23)) ctxhy_unit(p, l, u - NF - NA - NCA, lds); }
        }
    } break;
    case 3: {
        if (!ONLYC(3) && !(3 == 1 && (ONLYC(10)||ONLYC(11)||ONLYC(12)||ONLYC(13))) && !(3 == 2 && (ONLYC(20)||ONLYC(21)||ONLYC(22)||ONLYC(23)))) break;
        for (int u = bid; u < 1024; u += G) hytr_unit(p, u, lds);
    } break;
    case 4: {
        if (!ONLYC(4) && !(4 == 1 && (ONLYC(10)||ONLYC(11)||ONLYC(12)||ONLYC(13))) && !(4 == 2 && (ONLYC(20)||ONLYC(21)||ONLYC(22)||ONLYC(23)))) break;
        const bf16_t* hn = (const bf16_t*)(p.ws + OFF_HN);
        const bf16_t* win = (const bf16_t*)(wl + W_WIN);
        bf16_t* mg = (bf16_t*)(p.ws + OFF_P);
        const int total = mtiles * 16;
        for (int u = bid; u < total; u += G) {
            const int mt = u >> 4, nt = u & 15;
            f32x16 msum[1][2]; zero_acc1(msum);
#pragma unroll 1
            for (int br = 0; br < 4; ++br) {
                const bf16_t* Ab = (const bf16_t*)(p.ws + (br == 0 ? OFF_Q : br == 1 ? OFF_HY : br == 2 ? OFF_PD : OFF_GM));
                const bf16_t* Wb = (const bf16_t*)(wl + (br == 0 ? W_BA : br == 1 ? W_BH : br == 2 ? W_BP : W_BG));
                const int Kb = (br == 0) ? 512 : 256;
                f32x16 g[1][2]; zero_acc1(g);
                gemm_mainloop_t<1>(g, hn + (size_t)mt * 256 * 1024, 1024, win + (size_t)(PW + br * 1024 + nt * 64) * 1024, 1024, 1024, lds);
#pragma unroll
                for (int b = 0; b < 2; ++b)
#pragma unroll
                    for (int i = 0; i < 16; ++i) g[0][b][i] = sigmoidf_(g[0][b][i]);
                f32x16 v[1][2]; zero_acc1(v);
                gemm_mainloop_t<1>(v, Ab + (size_t)mt * 256 * Kb, Kb, Wb + (size_t)nt * 64 * Kb, Kb, Kb, lds);
#pragma unroll
                for (int b = 0; b < 2; ++b)
#pragma unroll
                    for (int i = 0; i < 16; ++i) msum[0][b][i] += g[0][b][i] * v[0][b][i];
            }
            {
                const int lane = threadIdx.x & 63, wid = threadIdx.x >> 6, wm = wid >> 1, wn = wid & 1, fr = lane & 31, fh = lane >> 5;
#pragma unroll
                for (int mb = 0; mb < 2; ++mb)
#pragma unroll
                    for (int g4 = 0; g4 < 4; ++g4) {
                        const int row = mt * 256 + wm * 64 + mb * 32 + fr, col = nt * 64 + wn * 32 + g4 * 8 + fh * 4;
                        *(uint2*)(mg + (size_t)row * 1024 + col) = make_uint2(pack2(msum[0][mb][4 * g4], msum[0][mb][4 * g4 + 1]), pack2(msum[0][mb][4 * g4 + 2], msum[0][mb][4 * g4 + 3]));
                    }
            }
        }
    } break;
    case 5: case 8: {
        if (!ONLYC(5)) break;
        const bool isout = (sub == 5);
        const bf16_t* A = (const bf16_t*)(p.ws + OFF_P);
        const int K = isout ? 1024 : FFH;
        const bf16_t* Bt = (const bf16_t*)(wl + (isout ? W_OUT : W_DN));
        const int goff = isout ? 2048 : 5120;
        const float* rlat = (isout && first) ? p.in[IN_X] : p.out;
        const float* rctx = (isout && first) ? p.in[IN_CTX] : xc;
        const int total = mtiles * 8;
        for (int u = bid; u < total; u += G) {
            const int mt = u >> 3, nt = u & 7;
            f32x16 acc[2][2]; zero_acc(acc);
            gemm_mainloop(acc, A + (size_t)mt * 256 * K, K, Bt + (size_t)nt * 128 * K, K, K, lds);
            epi_foreach(acc, [&](int m, int n, float v0, float v1, float v2, float v3) {
                const int row = mt * 256 + m, col = nt * 128 + n;
                const float* src; float* dst; int mr;
                if (row < ML) { src = rlat + (size_t)row * 1024; dst = p.out + (size_t)row * 1024; mr = row >> 13; }
                else { src = rctx + (size_t)(row - ML) * 1024; dst = xc + (size_t)(row - ML) * 1024; mr = 8; }
                const float4 r = *(const float4*)(src + col), g = *(const float4*)(mod + mr * 6144 + goff + col);
                *(float4*)(dst + col) = make_float4(r.x + g.x * v0, r.y + g.y * v1, r.z + g.z * v2, r.w + g.w * v3);
            });
        }
    } break;
    case 6: if (!ONLYC(6)) break; modulate_phase(p, l, 1, first ? MT : ML, p.out, xc); break;
    case 7: {
        if (!ONLYC(7) && !(7 == 1 && (ONLYC(10)||ONLYC(11)||ONLYC(12)||ONLYC(13))) && !(7 == 2 && (ONLYC(20)||ONLYC(21)||ONLYC(22)||ONLYC(23)))) break;
        const bf16_t* A = (const bf16_t*)(p.ws + OFF_HN);
        const bf16_t* Bt = (const bf16_t*)(wl + W_GU);
        bf16_t* hid = (bf16_t*)(p.ws + OFF_P);
        const int total = mtiles * 44;
        for (int u = bid; u < total; u += G) {
            const int mt = u / 44, nt = u - mt * 44;
            f32x16 acc[2][2]; zero_acc(acc);
            gemm_mainloop(acc, A + (size_t)mt * 256 * 1024, 1024, Bt + (size_t)nt * 128 * 1024, 1024, 1024, lds);
            const int lane = threadIdx.x & 63, wid = threadIdx.x >> 6, wm = wid >> 1, wn = wid & 1, fr = lane & 31, fh = lane >> 5;
#pragma unroll
            for (int mb = 0; mb < 2; ++mb)
#pragma unroll
                for (int g = 0; g < 4; ++g) {
                    float h[4];
#pragma unroll
                    for (int e = 0; e < 4; ++e) { const float gt = acc[0][mb][4 * g + e], up = acc[1][mb][4 * g + e]; h[e] = gt * sigmoidf_(gt) * up; }
                    const int row = mt * 256 + wm * 64 + mb * 32 + fr, col = nt * 64 + wn * 32 + g * 8 + fh * 4;
                    *(uint2*)(hid + (size_t)row * FFH + col) = make_uint2(pack2(h[0], h[1]), pack2(h[2], h[3]));
                }
        }
    } break;
    case 9: {
        if (!ONLYC(9) && !(9 == 1 && (ONLYC(10)||ONLYC(11)||ONLYC(12)||ONLYC(13))) && !(9 == 2 && (ONLYC(20)||ONLYC(21)||ONLYC(22)||ONLYC(23)))) break;
        if (last) final_norm_phase(p);
        else modulate_phase(p, l + 1, 0, MT, p.out, xc);
    } break;
    }
}

__global__ void __launch_bounds__(512) mk_forward(Params p) {
#define MK_PHASE(k) if (p.ph_lo <= (k) && (k) < p.ph_hi) { if ((k) > p.ph_lo) cg::this_grid().sync(); run_phase(p, (k), g_lds); }
    MK_PHASE(0) MK_PHASE(1)
    MK_PHASE(2) MK_PHASE(3) MK_PHASE(4) MK_PHASE(5) MK_PHASE(6) MK_PHASE(7) MK_PHASE(8) MK_PHASE(9) MK_PHASE(10) MK_PHASE(11)
    MK_PHASE(12) MK_PHASE(13) MK_PHASE(14) MK_PHASE(15) MK_PHASE(16) MK_PHASE(17) MK_PHASE(18) MK_PHASE(19) MK_PHASE(20) MK_PHASE(21)
#undef MK_PHASE
}

extern "C" void kernel_launch(void* const* d_in, const int* in_sizes, int n_in, void* d_out, int out_size, void* d_ws, size_t ws_size, hipStream_t stream) {
    static int grid = 0;
    if (grid == 0) {
        if (n_in != N_IN || out_size != ML * D || ws_size < WS_END) { fprintf(stderr, "kernel_launch: unexpected shapes (n_in %d out %d ws %zu need %zu)\n", n_in, out_size, ws_size, (size_t)WS_END); grid = -1; return; }
        int dev = 0, cus = 0, per_cu = 0;
        hipGetDevice(&dev);
        hipDeviceGetAttribute(&cus, hipDeviceAttributeMultiprocessorCount, dev);
        if (hipFuncSetAttribute((const void*)mk_forward, hipFuncAttributeMaxDynamicSharedMemorySize, LDS_BYTES) != hipSuccess) { fprintf(stderr, "kernel_launch: hipFuncSetAttribute failed\n"); grid = -1; return; }
        if (hipOccupancyMaxActiveBlocksPerMultiprocessor(&per_cu, (const void*)mk_forward, 512, LDS_BYTES) != hipSuccess || per_cu < 1) { fprintf(stderr, "kernel_launch: occupancy query says %d\n", per_cu); per_cu = 1; }
        (void)hipGetLastError();
        grid = cus * 1;
    }
    if (grid < 0) return;
    Params p{};
    for (int i = 0; i < N_IN; ++i) p.in[i] = (const float*)d_in[i];
    p.out = (float*)d_out; p.ws = (unsigned char*)d_ws;
#if MK_MULTI_LAUNCH
    for (int ph = 0; ph < NPHASE; ++ph) {
        p.ph_lo = ph; p.ph_hi = ph + 1;
        hipLaunchKernelGGL(mk_forward, dim3(grid), dim3(512), LDS_BYTES, stream, p);
    }
#else
    p.ph_lo = 0; p.ph_hi = NPHASE;
    void* args[] = {&p};
    hipError_t e = hipLaunchCooperativeKernel((const void*)mk_forward, dim3(grid), dim3(512), args, LDS_BYTES, stream);
    if (e != hipSuccess) fprintf(stderr, "cooperative launch failed: %s (grid %d)\n", hipGetErrorString(e), grid);
#endif
}
```

```cpp
#include <hip/hip_runtime.h>
#include <hip/hip_cooperative_groups.h>
#include <cstdio>
#include <cstdint>
#include <cmath>
namespace cg = cooperative_groups;

#ifndef MK_MULTI_LAUNCH
#define MK_MULTI_LAUNCH 0
#endif

#ifndef ONLY
#define ONLYC(k) true
#else
#define ONLYC(k) ((k)==ONLY)
#endif
typedef unsigned short bf16_t;
typedef short bf16x8 __attribute__((ext_vector_type(8)));
typedef float f32x16 __attribute__((ext_vector_type(16)));

constexpr int D = 1024, NB = 8, SEQ = 8192, CTXL = 256;
constexpr int ML = NB * SEQ, MC = NB * CTXL, MT = ML + MC;
constexpr int PW = 2304;
constexpr int INW = 6400, FFH = 2816, NKEY = CTXL + SEQ;
constexpr int NFFT = 16384;
constexpr float QSCALE = 0.125f * 1.4426950408889634f;

enum { IN_X, IN_C, IN_CTX, IN_CCTX, IN_WMOD, IN_BMOD, IN_N1W, IN_N2W, IN_WIN, IN_QNW, IN_KNW, IN_HCW, IN_HCB, IN_HW1, IN_HB1, IN_HW2, IN_HB2,
       IN_HW3, IN_HFREQ, IN_HDECAY, IN_HSKIP, IN_POOLW, IN_POOLS, IN_GMNW, IN_GMWS, IN_GMBS, IN_WBA, IN_WBH, IN_WBP, IN_WBG, IN_WOUT, IN_FG, IN_FU, IN_FD, IN_FNW, N_IN };

constexpr size_t SZ_HN = (size_t)MT * 1024 * 2;
constexpr size_t SZ_P = (size_t)MT * PW * 2;
constexpr size_t SZ_Q = (size_t)MT * 512 * 2;
constexpr size_t SZ_K = (size_t)16 * NKEY * 64 * 2;
constexpr size_t SZ_ZT = (size_t)NB * 768 * SEQ * 2;
constexpr size_t SZ_B256 = (size_t)MT * 256 * 2;
constexpr size_t W_WIN = 0, W_BA = W_WIN + (size_t)6400 * 1024 * 2, W_BH = W_BA + (size_t)1024 * 512 * 2, W_BP = W_BH + (size_t)1024 * 256 * 2,
                 W_BG = W_BP + (size_t)1024 * 256 * 2, W_OUT = W_BG + (size_t)1024 * 256 * 2, W_GU = W_OUT + (size_t)1024 * 1024 * 2,
                 W_DN = W_GU + (size_t)5632 * 1024 * 2, W_GMWS = W_DN + (size_t)1024 * 2816 * 2, W_LAYER = W_GMWS + (size_t)4 * 128 * 128 * 2;
constexpr size_t OFF_HN = 0;
constexpr size_t OFF_P = OFF_HN + SZ_HN;
constexpr size_t OFF_Q = OFF_P + SZ_P;
constexpr size_t OFF_PD = OFF_Q + SZ_Q;
constexpr size_t OFF_GM = OFF_PD + SZ_B256;
constexpr size_t OFF_HY = OFF_GM + SZ_B256;
constexpr size_t OFF_W = OFF_HY + SZ_B256;
constexpr size_t OFF_HSPEC = OFF_W + 2 * W_LAYER;
constexpr size_t SZ_HSPEC_L = (size_t)2 * 256 * NFFT * 8;
constexpr size_t OFF_XC = OFF_HSPEC + 2 * SZ_HSPEC_L;
constexpr size_t OFF_MOD = OFF_XC + (size_t)MC * 1024 * 4;
constexpr size_t OFF_ROPE = OFF_MOD + (size_t)2 * 9 * 6144 * 4;
constexpr size_t OFF_TW = OFF_ROPE + (size_t)128 * 16 * 2 * 4;
constexpr size_t OFF_KCR = OFF_TW + (size_t)8192 * 8;
constexpr size_t OFF_KCN = OFF_KCR + (size_t)2 * 256 * 512 * 4;
constexpr size_t OFF_K = OFF_KCN + (size_t)2 * 256 * 512 * 4;
constexpr size_t OFF_VT = OFF_K + SZ_K;
constexpr size_t OFF_ZT = OFF_VT + SZ_K;
constexpr size_t OFF_MG = OFF_K;
constexpr size_t WS_END = OFF_K + ((2 * SZ_K + SZ_ZT) > SZ_HN ? (2 * SZ_K + SZ_ZT) : SZ_HN);
static_assert((size_t)MT * 4096 <= SZ_P, "the 8-bit gate buffer lives in the P region");
constexpr size_t SZ_KCIRC_L = (size_t)2 * 256 * NFFT * 4;
static_assert((size_t)MT * FFH * 2 == SZ_P + SZ_Q, "hid spans P+Q");
static_assert(WS_END <= ((size_t)1 << 30), "workspace over 1 GiB");

constexpr size_t OFF_BAR = (WS_END + 4095) & ~(size_t)4095;
constexpr size_t WS_END2 = OFF_BAR + 65536;
static_assert(WS_END2 <= ((size_t)1 << 30), "workspace over 1 GiB");
constexpr int LDS_BYTES = 147456;
constexpr int NPHASE = 22;

struct Params {
    const float* in[N_IN];
    float* out;
    unsigned char* ws;
    int ph_lo, ph_hi;
};

__device__ __forceinline__ float bf2f(bf16_t b) { return __uint_as_float(((unsigned)b) << 16); }
typedef float f32x2_t __attribute__((ext_vector_type(2)));
typedef __bf16 bf16x2_t __attribute__((ext_vector_type(2)));
__device__ __forceinline__ unsigned pack2(float lo, float hi) { const f32x2_t v = {lo, hi}; const bf16x2_t b = __builtin_convertvector(v, bf16x2_t); return __builtin_bit_cast(unsigned, b); }
__device__ __forceinline__ bf16_t f2bf(float f) { return (bf16_t)(pack2(f, 0.f) & 0xffffu); }
__device__ __forceinline__ float lo_bf(unsigned u) { return __uint_as_float(u << 16); }
__device__ __forceinline__ float hi_bf(unsigned u) { return __uint_as_float(u & 0xffff0000u); }
__device__ __forceinline__ float sigmoidf_(float x) { return 1.0f / (1.0f + __expf(-x)); }
__device__ __forceinline__ float wave_sum(float v) {
    v += __shfl_xor(v, 32); v += __shfl_xor(v, 16); v += __shfl_xor(v, 8); v += __shfl_xor(v, 4); v += __shfl_xor(v, 2); v += __shfl_xor(v, 1); return v;
}
__device__ __forceinline__ bf16x8 mk8(unsigned a, unsigned b, unsigned c, unsigned d) {
    typedef unsigned u32x4 __attribute__((ext_vector_type(4)));
    u32x4 v = {a, b, c, d};
    return __builtin_bit_cast(bf16x8, v);
}

constexpr int LROW = 144;
constexpr int A_BUF = 256 * LROW, B_BUF = 128 * LROW;
template <int NBK>
__device__ __forceinline__ void gemm_mainloop_t(f32x16 (&acc)[NBK][2], const bf16_t* __restrict__ A, int lda, const bf16_t* __restrict__ Bt, int ldb, int K, unsigned char* lds) {
    const int tid = threadIdx.x, lane = tid & 63, wid = tid >> 6, wm = wid >> 1, wn = wid & 1;
    const int lrow = tid >> 3, lkc = tid & 7;
    asm volatile("" : "+s"(lda), "+s"(ldb));
    const bf16_t* ga = A + (size_t)lrow * lda + lkc * 8;
    const bf16_t* gb = Bt + (size_t)lrow * ldb + lkc * 8;
    uint4 p0a0, p0a1, p0a2, p0a3, p0b0, p0b1 = make_uint4(0, 0, 0, 0), p1a0, p1a1, p1a2, p1a3, p1b0, p1b1 = make_uint4(0, 0, 0, 0);
#define GM_LOAD(S, DUMMY, KT) do { const bf16_t* pa = ga + (size_t)(KT) * 64; const bf16_t* pb = gb + (size_t)(KT) * 64; \
        S##a0 = *(const uint4*)(pa); S##a1 = *(const uint4*)(pa + (size_t)64 * lda); S##a2 = *(const uint4*)(pa + (size_t)128 * lda); S##a3 = *(const uint4*)(pa + (size_t)192 * lda); \
        S##b0 = *(const uint4*)(pb); if constexpr (NBK == 2) S##b1 = *(const uint4*)(pb + (size_t)64 * ldb); } while (0)
#define GM_STORE(S, DUMMY, BUF) do { unsigned char* qa = sA + (BUF) * A_BUF + soff; unsigned char* qb = sB + (BUF) * B_BUF + soff; \
        *(uint4*)(qa) = S##a0; *(uint4*)(qa + 64 * LROW) = S##a1; *(uint4*)(qa + 128 * LROW) = S##a2; *(uint4*)(qa + 192 * LROW) = S##a3; \
        *(uint4*)(qb) = S##b0; if constexpr (NBK == 2) *(uint4*)(qb + 64 * LROW) = S##b1; } while (0)
#define GM_COMPUTE(BUF) do { const unsigned char* cA = sA + (BUF) * A_BUF + aoff; const unsigned char* cB = sB + (BUF) * B_BUF + boff; \
        _Pragma("unroll") for (int ks = 0; ks < 4; ++ks) { \
            const bf16x8 a0 = *(const bf16x8*)(cA + ks * 32), a1 = *(const bf16x8*)(cA + 32 * LROW + ks * 32); \
            const bf16x8 b0 = *(const bf16x8*)(cB + ks * 32); \
            acc[0][0] = __builtin_amdgcn_mfma_f32_32x32x16_bf16(b0, a0, acc[0][0], 0, 0, 0); \
            acc[0][1] = __builtin_amdgcn_mfma_f32_32x32x16_bf16(b0, a1, acc[0][1], 0, 0, 0); \
            if constexpr (NBK == 2) { const bf16x8 b1 = *(const bf16x8*)(cB + 32 * LROW + ks * 32); \
                acc[NBK - 1][0] = __builtin_amdgcn_mfma_f32_32x32x16_bf16(b1, a0, acc[NBK - 1][0], 0, 0, 0); \
                acc[NBK - 1][1] = __builtin_amdgcn_mfma_f32_32x32x16_bf16(b1, a1, acc[NBK - 1][1], 0, 0, 0); } } } while (0)
    unsigned char* sA = lds;
    unsigned char* sB = lds + 2 * A_BUF;
    const int soff = lrow * LROW + lkc * 16;
    const int fr = lane & 31, fh = lane >> 5;
    const int aoff = (wm * 64 + fr) * LROW + fh * 16;
    const int boff = (wn * 32 * NBK + fr) * LROW + fh * 16;
    const int nk = K >> 6;
    GM_LOAD(p0, 0, 0);
    GM_LOAD(p1, 0, 1);
    GM_STORE(p0, 0, 0);
    __syncthreads();
    for (int kt = 0; kt < nk; kt += 2) {
        GM_LOAD(p0, 0, min(kt + 2, nk - 1));
        GM_COMPUTE(0);
        GM_STORE(p1, 0, 1);
        __syncthreads();
        GM_LOAD(p1, 0, min(kt + 3, nk - 1));
        GM_COMPUTE(1);
        GM_STORE(p0, 0, 0);
        __syncthreads();
    }
#undef GM_LOAD
#undef GM_STORE
#undef GM_COMPUTE
}
__device__ __forceinline__ void gemm_mainloop(f32x16 (&acc)[2][2], const bf16_t* __restrict__ A, int lda, const bf16_t* __restrict__ Bt, int ldb, int K, unsigned char* lds) {
    gemm_mainloop_t<2>(acc, A, lda, Bt, ldb, K, lds);
}
__device__ __forceinline__ void zero_acc1(f32x16 (&acc)[1][2]) {
#pragma unroll
    for (int b = 0; b < 2; ++b)
#pragma unroll
        for (int i = 0; i < 16; ++i) acc[0][b][i] = 0.f;
}
__device__ __forceinline__ void zero_acc(f32x16 (&acc)[2][2]) {
#pragma unroll
    for (int a = 0; a < 2; ++a)
#pragma unroll
        for (int b = 0; b < 2; ++b)
#pragma unroll
            for (int i = 0; i < 16; ++i) acc[a][b][i] = 0.f;
}
template <class F> __device__ __forceinline__ void epi_foreach(const f32x16 (&acc)[2][2], F f) {
    const int lane = threadIdx.x & 63, wid = threadIdx.x >> 6, wm = wid >> 1, wn = wid & 1, fr = lane & 31, fh = lane >> 5;
#pragma unroll
    for (int mb = 0; mb < 2; ++mb)
#pragma unroll
        for (int nb = 0; nb < 2; ++nb)
#pragma unroll
            for (int g = 0; g < 4; ++g)
                f(wm * 64 + mb * 32 + fr, wn * 64 + nb * 32 + g * 8 + fh * 4, acc[nb][mb][4 * g], acc[nb][mb][4 * g + 1], acc[nb][mb][4 * g + 2], acc[nb][mb][4 * g + 3]);
}

extern __shared__ __attribute__((aligned(16))) unsigned char g_lds[];
namespace pg8 {
#define PG8_LAS __attribute__((address_space(3)))
typedef unsigned short bf16_t;
typedef short bf16x8 __attribute__((ext_vector_type(8)));
typedef float f32x4 __attribute__((ext_vector_type(4)));
typedef unsigned u32x4 __attribute__((ext_vector_type(4)));
constexpr int BM = 256, BK = 64, HALF = 128, HTB = HALF * BK * 2  , STAGE_BYTES = 8 * HTB, NXCD = 8, WGM = 8;

__host__ __device__ __forceinline__ int lds_byte(int r, int c) { const int st = (r >> 4) * 2 + (c >> 5), rr = r & 15, cc = c & 31, ob = rr * 64 + cc * 2; return st * 1024 + (ob ^ (((ob >> 9) & 1) << 5)); }
__host__ __device__ __forceinline__ void stage_rc(int b, int& R, int& C) { const int st = b / 1024, sb = b % 1024, swz = sb ^ (((sb >> 9) & 1) << 5); R = (st >> 1) * 16 + swz / 64; C = (st & 1) * 32 + (swz % 64) / 2; }
__host__ __device__ __forceinline__ int perm32(int rho) { const int n = rho >> 4, i = rho & 15; return 8 * (i >> 2) + 4 * n + (i & 3); }

struct Unit { int pm, pn; };
struct Gemm { const bf16_t* A; const bf16_t* Bt; int M, N, K; };

struct StaticOrder {
    int nM, nN, nwg, G, c;
    __host__ __device__ void init(int M, int N, int G_, int c_) { nM = M / BM; nN = N / BM; nwg = nM * nN; G = G_; c = c_; }
    __host__ __device__ bool next(int i, Unit& u) const {
        const long L = (long)i * G + c; if (L >= nwg) return false;
        int wgid = (int)L; { const int q = nwg / NXCD, r = nwg % NXCD, xcd = wgid % NXCD, off = wgid / NXCD; wgid = (xcd < r ? xcd * (q + 1) : r * (q + 1) + (xcd - r) * q) + off; }
        const int nig = WGM * nN, gid = wgid / nig, fm = gid * WGM, gsz = (nM - fm) < WGM ? (nM - fm) : WGM;
        u.pm = fm + ((wgid % nig) % gsz); u.pn = (wgid % nig) / gsz; return true;
    }
    __device__ __forceinline__ void a_ready(const Unit&) const {}
    __device__ __forceinline__ void done(const Unit&) const {}
};

struct EpiP {
    static constexpr bool PERM = false, AFTER_DRAIN = false;
    bf16_t* O; int ldc;
    __device__ __forceinline__ void operator()(const f32x4 (&acc)[2][2][4][2], const Unit& u, int wr, int wc, int fr, int fq) const {
        const int row0 = u.pm * BM + wr * 64 + fr, col0 = u.pn * BM + wc * 32 + 4 * fq;
#pragma unroll
        for (int ai = 0; ai < 2; ++ai)
#pragma unroll
            for (int m = 0; m < 4; ++m) { bf16_t* rowp = O + (size_t)(row0 + ai * HALF + m * 16) * ldc + col0;
#pragma unroll
                for (int bj = 0; bj < 2; ++bj)
#pragma unroll
                    for (int n = 0; n < 2; ++n) { const f32x4 v = acc[ai][bj][m][n]; *(uint2*)(rowp + bj * HALF + n * 16) = make_uint2(pack2(v[0], v[1]), pack2(v[2], v[3])); } }
    }
};
struct EpiSig {
    static constexpr bool PERM = false, AFTER_DRAIN = false;
    unsigned char* O; int ldc;
    __device__ __forceinline__ void operator()(const f32x4 (&acc)[2][2][4][2], const Unit& u, int wr, int wc, int fr, int fq) const {
        const int row0 = u.pm * BM + wr * 64 + fr, col0 = u.pn * BM + wc * 32 + 4 * fq;
#pragma unroll
        for (int ai = 0; ai < 2; ++ai)
#pragma unroll
            for (int m = 0; m < 4; ++m) { unsigned char* rowp = O + (size_t)(row0 + ai * HALF + m * 16) * ldc + col0;
#pragma unroll
                for (int bj = 0; bj < 2; ++bj)
#pragma unroll
                    for (int n = 0; n < 2; ++n) { const f32x4 v = acc[ai][bj][m][n];
                        const unsigned q0 = (unsigned)(255.0f * __builtin_amdgcn_rcpf(1.0f + __expf(-v[0])) + 0.5f), q1 = (unsigned)(255.0f * __builtin_amdgcn_rcpf(1.0f + __expf(-v[1])) + 0.5f);
                        const unsigned q2 = (unsigned)(255.0f * __builtin_amdgcn_rcpf(1.0f + __expf(-v[2])) + 0.5f), q3 = (unsigned)(255.0f * __builtin_amdgcn_rcpf(1.0f + __expf(-v[3])) + 0.5f);
                        *(unsigned*)(rowp + bj * HALF + n * 16) = q0 | (q1 << 8) | (q2 << 16) | (q3 << 24); } }
    }
};
struct EpiRes {
    static constexpr bool PERM = false, AFTER_DRAIN = false;
    const float* rlat; const float* rctx; float* olat; float* octx; const float* modg; int nlat;
    __device__ __forceinline__ void operator()(const f32x4 (&acc)[2][2][4][2], const Unit& u, int wr, int wc, int fr, int fq) const {
        const int row0 = u.pm * BM + wr * 64 + fr, col0 = u.pn * BM + wc * 32 + 4 * fq;
#pragma unroll
        for (int ai = 0; ai < 2; ++ai)
#pragma unroll
            for (int m = 0; m < 4; ++m) {
                const int row = row0 + ai * HALF + m * 16;
                const float* src; float* dst; int mr;
                if (row < nlat) { src = rlat + (size_t)row * 1024; dst = olat + (size_t)row * 1024; mr = row >> 13; }
                else { src = rctx + (size_t)(row - nlat) * 1024; dst = octx + (size_t)(row - nlat) * 1024; mr = 8; }
                const float* gp = modg + mr * 6144;
#pragma unroll
                for (int bj = 0; bj < 2; ++bj)
#pragma unroll
                    for (int n = 0; n < 2; ++n) { const int c = col0 + bj * HALF + n * 16; const f32x4 r = *(const f32x4*)(src + c), g = *(const f32x4*)(gp + c); *(f32x4*)(dst + c) = r + g * acc[ai][bj][m][n]; }
            }
    }
};
struct EpiSwi {
    static constexpr bool PERM = false, AFTER_DRAIN = false;
    bf16_t* H; int ldh;
    __device__ __forceinline__ void operator()(const f32x4 (&acc)[2][2][4][2], const Unit& u, int wr, int wc, int fr, int fq) const {
        const int row0 = u.pm * BM + wr * 64 + fr, col0 = u.pn * BM + wc * 32;
#pragma unroll
        for (int ai = 0; ai < 2; ++ai)
#pragma unroll
            for (int m = 0; m < 4; ++m) { bf16_t* rowp = H + (size_t)(row0 + ai * HALF + m * 16) * ldh;
#pragma unroll
                for (int bj = 0; bj < 2; ++bj) { const f32x4 g = acc[ai][bj][m][0], up = acc[ai][bj][m][1]; float h[4];
#pragma unroll
                    for (int e = 0; e < 4; ++e) h[e] = g[e] * __builtin_amdgcn_rcpf(1.0f + __expf(-g[e])) * up[e];
                    *(uint2*)(rowp + ((col0 + bj * HALF) >> 5) * 16 + 4 * fq) = make_uint2(pack2(h[0], h[1]), pack2(h[2], h[3])); } }
    }
};
template <class Epi, class Sched, bool ALIGN_EPI = false, bool SP2 = false>
__device__ __forceinline__ void gemm_phase(PG8_LAS unsigned char* lds, const Gemm g, const Sched& S, const Epi& E) {
    const int tid = threadIdx.x, wid = __builtin_amdgcn_readfirstlane(tid >> 6), lane = tid & 63, wr = wid >> 2, wc = wid & 3, fr = lane & 15, fq = lane >> 4;
    const int K = g.K, nt = K / BK;
    unsigned voffA[2], voffB[2];
#pragma unroll
    for (int i = 0; i < 2; ++i) { int R, C; stage_rc(tid * 16 + i * 8192, R, C); const int Rb = Epi::PERM ? ((R & ~31) + perm32(R & 31)) : R;
        voffA[i] = (unsigned)(R * K + C) * 2u; voffB[i] = (unsigned)(Rb * K + C) * 2u; }
    const size_t kstep = (size_t)(BK * 2);
    const size_t hstep = (size_t)HALF * K * 2;
    const size_t tstep = 2 * hstep;
    const unsigned ldsw = (unsigned)wid * 1024u;
    const int aoff = lds_byte(wr * 64 + fr, fq * 8), boff = lds_byte(wc * 32 + fr, fq * 8);
#define PG8_SA(b, h) (((b) * 2 + (h)) * HTB)
#define PG8_SB(b, h) ((4 + (b) * 2 + (h)) * HTB)
#define PG8_STAGE(bufoff, gbase, voff) do { _Pragma("unroll") for (int _i = 0; _i < 2; ++_i) \
        __builtin_amdgcn_global_load_lds((const unsigned*)((const char*)(gbase) + (voff)[_i]), (PG8_LAS unsigned*)(lds + (bufoff) + ldsw + _i * 8192), 16, 0, 0); } while (0)
#define PG8_LDA(dst, b, h) do { _Pragma("unroll") for (int m = 0; m < 4; ++m) _Pragma("unroll") for (int k = 0; k < 2; ++k) dst[m][k] = *(const PG8_LAS bf16x8*)(lds + PG8_SA(b, h) + aoff + m * 2048 + k * 1024); } while (0)
#define PG8_LDB(dst, b, h) do { _Pragma("unroll") for (int n = 0; n < 2; ++n) _Pragma("unroll") for (int k = 0; k < 2; ++k) dst[n][k] = *(const PG8_LAS bf16x8*)(lds + PG8_SB(b, h) + boff + n * 2048 + k * 1024); } while (0)
#define PG8_MMA(ai, bj, At, Bt) do { __builtin_amdgcn_s_setprio(1); _Pragma("unroll") for (int m = 0; m < 4; ++m) _Pragma("unroll") for (int n = 0; n < 2; ++n) _Pragma("unroll") for (int k = 0; k < 2; ++k) \
        acc[ai][bj][m][n] = __builtin_amdgcn_mfma_f32_16x16x32_bf16(Bt[n][k], At[m][k], acc[ai][bj][m][n], 0, 0, 0); __builtin_amdgcn_s_setprio(0); } while (0)
#define PG8_WAIT_V(n) asm volatile("s_waitcnt vmcnt(" #n ")" ::: "memory")
#define PG8_WAIT_L(n) asm volatile("s_waitcnt lgkmcnt(" #n ")" ::: "memory")
#define PG8_BAR __builtin_amdgcn_s_barrier()
#define PG8_SCHED __builtin_amdgcn_sched_barrier(0)
    Unit cur, nxt; int ui = 0;
    if (!S.next(0, cur)) return;
    f32x4 acc[2][2][4][2];
#pragma unroll
    for (int a = 0; a < 2; ++a)
#pragma unroll
        for (int b = 0; b < 2; ++b)
#pragma unroll
            for (int m = 0; m < 4; ++m)
#pragma unroll
                for (int n = 0; n < 2; ++n) acc[a][b][m][n] = (f32x4){0.f, 0.f, 0.f, 0.f};
    bf16x8 At[4][2], B0[2][2], B1[2][2];
    const char* cA = (const char*)g.A + (size_t)cur.pm * tstep; const char* cB = (const char*)g.Bt + (size_t)cur.pn * tstep;
    S.a_ready(cur);
    if constexpr (SP2) {
        PG8_STAGE(PG8_SB(0, 0), cB, voffB); PG8_STAGE(PG8_SB(0, 1), cB + hstep, voffB); PG8_STAGE(PG8_SA(0, 0), cA, voffA); PG8_STAGE(PG8_SA(0, 1), cA + hstep, voffA);
        if (wr == 1) PG8_BAR;
        PG8_WAIT_V(2); PG8_BAR;
        PG8_STAGE(PG8_SB(1, 0), cB + kstep, voffB); PG8_STAGE(PG8_SA(1, 0), cA + kstep, voffA); PG8_STAGE(PG8_SB(1, 1), cB + hstep + kstep, voffB);
        PG8_WAIT_V(6); PG8_BAR;
    } else {
        PG8_STAGE(PG8_SB(0, 0), cB, voffB); PG8_STAGE(PG8_SA(0, 0), cA, voffA); PG8_STAGE(PG8_SB(0, 1), cB + hstep, voffB); PG8_STAGE(PG8_SA(0, 1), cA + hstep, voffA);
        if (wr == 1) PG8_BAR;
        PG8_WAIT_V(4); PG8_BAR;
        PG8_STAGE(PG8_SB(1, 0), cB + kstep, voffB); PG8_STAGE(PG8_SA(1, 0), cA + kstep, voffA); PG8_STAGE(PG8_SB(1, 1), cB + hstep + kstep, voffB);
        PG8_WAIT_V(6); PG8_BAR;
    }
    for (;;) {
        const bool has_next = S.next(ui + 1, nxt);
        const char* nA = has_next ? (const char*)g.A + (size_t)nxt.pm * tstep : cA; const char* nB = has_next ? (const char*)g.Bt + (size_t)nxt.pn * tstep : cB;
        for (int t = 0; t < nt; t += 2) {
            const bool last = (t == nt - 2);
            const char* a1 = cA + (size_t)(t + 1) * kstep;
            const char* a2 = last ? nA : cA + (size_t)(t + 2) * kstep; const char* b2 = last ? nB : cB + (size_t)(t + 2) * kstep;
            const char* a3 = a2 + kstep; const char* b3 = b2 + kstep;
            if (last && has_next) S.a_ready(nxt);
            if constexpr (SP2) {
            PG8_LDB(B0, 0, 0); PG8_LDB(B1, 0, 1); PG8_SCHED; PG8_LDA(At, 0, 0); PG8_STAGE(PG8_SA(1, 1), a1 + hstep, voffA);
            PG8_WAIT_V(8); PG8_WAIT_L(0); PG8_BAR; PG8_MMA(0, 0, At, B0); PG8_MMA(0, 1, At, B1); PG8_BAR; PG8_SCHED;
            PG8_LDA(At, 0, 1); PG8_STAGE(PG8_SB(0, 0), b2, voffB); PG8_STAGE(PG8_SB(0, 1), b2 + hstep, voffB); PG8_STAGE(PG8_SA(0, 0), a2, voffA);
            PG8_WAIT_V(8); PG8_WAIT_L(0); PG8_BAR; PG8_MMA(1, 0, At, B0); PG8_MMA(1, 1, At, B1); PG8_BAR; PG8_SCHED;
            PG8_LDB(B0, 1, 0); PG8_LDB(B1, 1, 1); PG8_SCHED; PG8_LDA(At, 1, 0); PG8_STAGE(PG8_SA(0, 1), a2 + hstep, voffA);
            PG8_WAIT_V(8); PG8_WAIT_L(0); PG8_BAR; PG8_MMA(0, 0, At, B0); PG8_MMA(0, 1, At, B1); PG8_BAR; PG8_SCHED;
            PG8_LDA(At, 1, 1); PG8_STAGE(PG8_SB(1, 0), b3, voffB); PG8_STAGE(PG8_SB(1, 1), b3 + hstep, voffB); PG8_STAGE(PG8_SA(1, 0), a3, voffA);
            PG8_WAIT_V(8); PG8_WAIT_L(0); PG8_BAR; PG8_MMA(1, 0, At, B0); PG8_MMA(1, 1, At, B1); PG8_BAR; PG8_SCHED;
            } else {
            PG8_LDB(B0, 0, 0); PG8_SCHED; PG8_LDA(At, 0, 0); PG8_STAGE(PG8_SA(1, 1), a1 + hstep, voffA);
            PG8_WAIT_L(8); PG8_BAR; PG8_WAIT_L(0); PG8_MMA(0, 0, At, B0); PG8_BAR; PG8_SCHED;
            PG8_LDB(B1, 0, 1); PG8_STAGE(PG8_SB(0, 0), b2, voffB);
            PG8_BAR; PG8_WAIT_L(0); PG8_MMA(0, 1, At, B1); PG8_BAR;
            PG8_LDA(At, 0, 1); PG8_STAGE(PG8_SA(0, 0), a2, voffA);
            PG8_BAR; PG8_WAIT_L(0); PG8_MMA(1, 0, At, B0); PG8_BAR; PG8_SCHED;
            PG8_STAGE(PG8_SB(0, 1), b2 + hstep, voffB);
            PG8_WAIT_V(6); PG8_BAR; PG8_MMA(1, 1, At, B1); PG8_BAR;
            PG8_LDB(B0, 1, 0); PG8_SCHED; PG8_LDA(At, 1, 0); PG8_STAGE(PG8_SA(0, 1), a2 + hstep, voffA);
            PG8_WAIT_L(8); PG8_BAR; PG8_WAIT_L(0); PG8_MMA(0, 0, At, B0); PG8_BAR; PG8_SCHED;
            PG8_LDB(B1, 1, 1); PG8_STAGE(PG8_SB(1, 0), b3, voffB);
            PG8_BAR; PG8_WAIT_L(0); PG8_MMA(0, 1, At, B1); PG8_BAR;
            PG8_LDA(At, 1, 1); PG8_STAGE(PG8_SA(1, 0), a3, voffA);
            PG8_BAR; PG8_WAIT_L(0); PG8_MMA(1, 0, At, B0); PG8_BAR; PG8_SCHED;
            PG8_STAGE(PG8_SB(1, 1), b3 + hstep, voffB);
            PG8_WAIT_V(6); PG8_BAR; PG8_MMA(1, 1, At, B1); PG8_BAR;
            }
        }
        if constexpr (ALIGN_EPI) { if (wr == 0) PG8_BAR; }
        if constexpr (!Epi::AFTER_DRAIN) { E(acc, cur, wr, wc, fr, fq); S.done(cur); }
        if (!has_next) break;
#pragma unroll
        for (int a = 0; a < 2; ++a)
#pragma unroll
            for (int b = 0; b < 2; ++b)
#pragma unroll
                for (int m = 0; m < 4; ++m)
#pragma unroll
                    for (int n = 0; n < 2; ++n) acc[a][b][m][n] = (f32x4){0.f, 0.f, 0.f, 0.f};
        cur = nxt; cA = nA; cB = nB; ++ui;
        if constexpr (ALIGN_EPI) { if (wr == 1) PG8_BAR; }
    }
    PG8_WAIT_V(0);
    if constexpr (!ALIGN_EPI) { if (wr == 0) PG8_BAR; }
    PG8_BAR;
    if constexpr (Epi::AFTER_DRAIN) { E.fused(acc, cur, wr, wc, fr, fq, lds, wid, lane); S.done(cur); }
#undef PG8_SA
#undef PG8_SB
#undef PG8_STAGE
#undef PG8_LDA
#undef PG8_LDB
#undef PG8_MMA
#undef PG8_WAIT_V
#undef PG8_WAIT_L
#undef PG8_BAR
#undef PG8_SCHED
}
}

#define XP(i) ((i) + ((i) >> 5))
__device__ __forceinline__ float2 cmul(float2 a, float2 b) { return make_float2(a.x * b.x - a.y * b.y, a.x * b.y + a.y * b.x); }
__device__ __forceinline__ float2 cmulc(float2 a, float2 b) { return make_float2(a.x * b.x + a.y * b.y, a.y * b.x - a.x * b.y); }
typedef float v2f __attribute__((ext_vector_type(2)));
__device__ __forceinline__ v2f pk_cmul(v2f a, v2f b) { const v2f t = a.yy * b.yx; return __builtin_elementwise_fma(a.xx, b, t * (v2f){-1.f, 1.f}); }
__device__ __forceinline__ v2f pk_cmulc(v2f a, v2f b) { const v2f t = a.yx * b.yy; return __builtin_elementwise_fma(a, b.xx, t * (v2f){1.f, -1.f}); }
__device__ __forceinline__ v2f pk_mulmi(v2f d) { return d.yx * (v2f){1.f, -1.f}; }
__device__ __forceinline__ void fft_fwd(float2* Xf, const float2* __restrict__ tw) {
    v2f* X = (v2f*)Xf;
    const int tid = threadIdx.x;
#pragma unroll 1
    for (int q = 4096; q >= 1; q >>= 2) {
        const int tsh = 4096 / q;
        const bool shared_tw = (q <= 512);
        v2f sw1 = {1.f, 0.f}, sw2 = sw1, sw3 = sw1;
        if (shared_tw) {
            const float xr = (float)((tid & (q - 1)) * tsh) * (1.0f / 16384.0f);
            sw1 = (v2f){__builtin_amdgcn_cosf(xr), -__builtin_amdgcn_sinf(xr)}; sw2 = pk_cmul(sw1, sw1); sw3 = pk_cmul(sw1, sw2);
        }
#pragma unroll 4
        for (int j = tid; j < 4096; j += 512) {
            const int k = j & (q - 1), i0 = ((j - k) << 2) + k;
            const int p0 = XP(i0), p1 = XP(i0 + q), p2 = XP(i0 + 2 * q), p3 = XP(i0 + 3 * q);
            const v2f a0 = X[p0], a1 = X[p1], a2 = X[p2], a3 = X[p3];
            v2f w1 = sw1, w2 = sw2, w3 = sw3;
            if (!shared_tw) {
                const float xr = (float)(k * tsh) * (1.0f / 16384.0f);
                w1 = (v2f){__builtin_amdgcn_cosf(xr), -__builtin_amdgcn_sinf(xr)}; w2 = pk_cmul(w1, w1); w3 = pk_cmul(w1, w2);
            }
            const v2f t0 = a0 + a2, t1 = a0 - a2, t2 = a1 + a3, t3 = pk_mulmi(a1 - a3);
            X[p0] = t0 + t2;
            X[p1] = pk_cmul(t1 + t3, w1);
            X[p2] = pk_cmul(t0 - t2, w2);
            X[p3] = pk_cmul(t1 - t3, w3);
        }
        __syncthreads();
    }
}
__device__ __forceinline__ void fft_inv(float2* Xf, const float2* __restrict__ tw) {
    v2f* X = (v2f*)Xf;
    const int tid = threadIdx.x;
#pragma unroll 1
    for (int q = 1; q <= 4096; q <<= 2) {
        const int tsh = 4096 / q;
        const bool shared_tw = (q <= 512);
        v2f sw1 = {1.f, 0.f}, sw2 = sw1, sw3 = sw1;
        if (shared_tw) {
            const float xr = (float)((tid & (q - 1)) * tsh) * (1.0f / 16384.0f);
            sw1 = (v2f){__builtin_amdgcn_cosf(xr), -__builtin_amdgcn_sinf(xr)}; sw2 = pk_cmul(sw1, sw1); sw3 = pk_cmul(sw1, sw2);
        }
#pragma unroll 4
        for (int j = tid; j < 4096; j += 512) {
            const int k = j & (q - 1), i0 = ((j - k) << 2) + k;
            v2f w1 = sw1, w2 = sw2, w3 = sw3;
            if (!shared_tw) {
                const float xr = (float)(k * tsh) * (1.0f / 16384.0f);
                w1 = (v2f){__builtin_amdgcn_cosf(xr), -__builtin_amdgcn_sinf(xr)}; w2 = pk_cmul(w1, w1); w3 = pk_cmul(w1, w2);
            }
            const int p0 = XP(i0), p1 = XP(i0 + q), p2 = XP(i0 + 2 * q), p3 = XP(i0 + 3 * q);
            const v2f z0 = X[p0], z1 = pk_cmulc(X[p1], w1), z2 = pk_cmulc(X[p2], w2), z3 = pk_cmulc(X[p3], w3);
            const v2f s02 = z0 + z2, d02 = z0 - z2, s13 = z1 + z3, e = -pk_mulmi(z1 - z3);
            X[p0] = s02 + s13;
            X[p1] = d02 + e;
            X[p2] = s02 - s13;
            X[p3] = d02 - e;
        }
        __syncthreads();
    }
}

struct CvtJob { const float* src; int ld, K, N; bf16_t* dst; int mode; };
__device__ __forceinline__ CvtJob get_job(const Params& p, int l, int j) {
    unsigned char* wl = p.ws + OFF_W + (size_t)l * W_LAYER;
    CvtJob r;
    switch (j) {
    case 0: r = {p.in[IN_WIN] + (size_t)l * 1024 * 6400, 6400, 1024, 6400, (bf16_t*)(wl + W_WIN), 0}; break;
    case 1: r = {p.in[IN_WBA] + (size_t)l * 512 * 1024, 1024, 512, 1024, (bf16_t*)(wl + W_BA), 0}; break;
    case 2: r = {p.in[IN_WBH] + (size_t)l * 256 * 1024, 1024, 256, 1024, (bf16_t*)(wl + W_BH), 0}; break;
    case 3: r = {p.in[IN_WBG] + (size_t)l * 256 * 1024, 1024, 256, 1024, (bf16_t*)(wl + W_BG), 0}; break;
    case 4: r = {p.in[IN_WOUT] + (size_t)l * 1024 * 1024, 1024, 1024, 1024, (bf16_t*)(wl + W_OUT), 0}; break;
    case 5: r = {p.in[IN_FG] + (size_t)l * 1024 * 2816, 2816, 1024, 2816, (bf16_t*)(wl + W_GU), 1}; break;
    case 6: r = {p.in[IN_FU] + (size_t)l * 1024 * 2816, 2816, 1024, 2816, (bf16_t*)(wl + W_GU), 2}; break;
    default: r = {p.in[IN_FD] + (size_t)l * 2816 * 1024, 1024, 2816, 1024, (bf16_t*)(wl + W_DN), 0}; break;
    }
    return r;
}
__device__ __forceinline__ void cvt_tile(const CvtJob& jb, int tile, unsigned char* lds) {
    float* T = (float*)lds;
    const int nkt = jb.K >> 6, kt = tile % nkt, nt = tile / nkt, tid = threadIdx.x;
    {
        const int k = tid >> 3, c = (tid & 7) * 8;
        const float* s = jb.src + (size_t)(kt * 64 + k) * jb.ld + nt * 64 + c;
        const float4 v0 = *(const float4*)s, v1 = *(const float4*)(s + 4);
        float* t = T + k * 65 + c;
        t[0] = v0.x; t[1] = v0.y; t[2] = v0.z; t[3] = v0.w; t[4] = v1.x; t[5] = v1.y; t[6] = v1.z; t[7] = v1.w;
    }
    __syncthreads();
    {
        const int nl = tid >> 3, kc = (tid & 7) * 8, n = nt * 64 + nl;
        int nd = n;
        if (jb.mode == 1) nd = 32 * (n >> 4) + (n & 15);
        else if (jb.mode == 2) nd = 32 * (n >> 4) + 16 + (n & 15);
        uint4 o;
        o.x = pack2(T[(kc + 0) * 65 + nl], T[(kc + 1) * 65 + nl]); o.y = pack2(T[(kc + 2) * 65 + nl], T[(kc + 3) * 65 + nl]);
        o.z = pack2(T[(kc + 4) * 65 + nl], T[(kc + 5) * 65 + nl]); o.w = pack2(T[(kc + 6) * 65 + nl], T[(kc + 7) * 65 + nl]);
        *(uint4*)(jb.dst + (size_t)nd * jb.K + kt * 64 + kc) = o;
    }
    __syncthreads();
}
__device__ __forceinline__ void mod_task(const Params& p, int task, unsigned char* lds) {
    float* act = (float*)lds;
    float* red = act + 9 * 1024;
    const int l = task / 48, cgp = task % 48, tid = threadIdx.x;
    for (int i = tid; i < 9 * 1024; i += 512) {
        const int r = i >> 10, c = i & 1023;
        const float v = (r < 8) ? p.in[IN_C][r * 1024 + c] : p.in[IN_CCTX][c];
        act[i] = v / (1.0f + expf(-v));
    }
    __syncthreads();
    const int col = tid & 127, ksl = tid >> 7;
    const float* w = p.in[IN_WMOD] + (size_t)l * 1024 * 6144 + cgp * 128 + col;
    float a[9];
#pragma unroll
    for (int r = 0; r < 9; ++r) a[r] = 0.f;
#pragma unroll 8
    for (int k = ksl * 256; k < ksl * 256 + 256; ++k) {
        const float wv = w[(size_t)k * 6144];
#pragma unroll
        for (int r = 0; r < 9; ++r) a[r] += act[r * 1024 + k] * wv;
    }
#pragma unroll
    for (int r = 0; r < 9; ++r) red[(ksl * 9 + r) * 128 + col] = a[r];
    __syncthreads();
    float* mod = (float*)(p.ws + OFF_MOD) + (size_t)l * 9 * 6144;
    for (int i = tid; i < 9 * 128; i += 512) {
        const int r = i >> 7, c = i & 127;
        const float s = red[(0 * 9 + r) * 128 + c] + red[(1 * 9 + r) * 128 + c] + red[(2 * 9 + r) * 128 + c] + red[(3 * 9 + r) * 128 + c];
        mod[r * 6144 + cgp * 128 + c] = s + p.in[IN_BMOD][l * 6144 + cgp * 128 + c];
    }
    __syncthreads();
}
__device__ __forceinline__ void weff_task(const Params& p, int task, unsigned char* lds) {
    const int l = task >> 5, nb = task & 31, tid = threadIdx.x;
    float* sA = (float*)lds;
    float* sB = sA + 256 * 65;
    const float* pw = p.in[IN_POOLW] + (size_t)l * 4 * 64 * 64;
    const float* sc = p.in[IN_POOLS] + l * 256;
    const float* wb = p.in[IN_WBP] + (size_t)l * 256 * 1024;
    for (int i = tid; i < 256 * 64; i += 512) { const int k = i >> 6, d = i & 63; sA[k * 65 + d] = pw[i] * sc[(k & ~63) + d]; }
    for (int i = tid; i < 256 * 32; i += 512) { const int r = i >> 5, j = i & 31; sB[r * 33 + j] = wb[(size_t)r * 1024 + nb * 32 + j]; }
    __syncthreads();
    bf16_t* dst = (bf16_t*)(p.ws + OFF_W + (size_t)l * W_LAYER + W_BP);
    const int j = tid & 31, kk = tid >> 5;
#pragma unroll 1
    for (int it = 0; it < 16; ++it) {
        const int k = kk + 16 * it, g64 = k & ~63;
        float s = 0.f;
#pragma unroll 8
        for (int d = 0; d < 64; ++d) s += sA[k * 65 + d] * sB[(g64 + d) * 33 + j];
        dst[(size_t)(nb * 32 + j) * 256 + k] = f2bf(s);
    }
    __syncthreads();
}
__device__ __forceinline__ void filt_task(const Params& p, int l, int posblk, int n, float* kdst  , unsigned char* lds) {
    float* hA = (float*)lds;
    float* hB = hA + 64 * 65;
    const int tid = threadIdx.x, lane = tid & 63, wid = tid >> 6;
    const float invn1 = 1.0f / (float)(n - 1);
    for (int idx = tid; idx < 64 * 33; idx += 512) {
        const int pl = idx / 33, f = idx - pl * 33, pos = posblk * 64 + pl;
        float v;
        if (f == 0) v = (float)pos * invn1;
        else {
            const int bi = (f - 1) & 15;
            const float band = 1e-4f + (float)bi * ((15.0f - 1e-4f) / 15.0f);
            const float ang = (6.283185307179586f / (float)n) * (float)pos * band;
            v = (f <= 16) ? cosf(ang) : sinf(ang);
        }
        hA[pl * 65 + f] = v;
    }
    __syncthreads();
    const float* w1 = p.in[IN_HW1] + l * 33 * 64;
    const float* b1 = p.in[IN_HB1] + l * 64;
    const float* w2 = p.in[IN_HW2] + l * 2 * 64 * 64;
    const float* b2 = p.in[IN_HB2] + l * 2 * 64;
    const float fq = p.in[IN_HFREQ][l * 64 + lane];
#pragma unroll 1
    for (int it = 0; it < 8; ++it) {
        const int pl = wid + 8 * it;
        float s = b1[lane];
#pragma unroll 3
        for (int f = 0; f < 33; ++f) s += hA[pl * 65 + f] * w1[f * 64 + lane];
        hB[pl * 65 + lane] = sinf(fq * s);
    }
    __syncthreads();
#pragma unroll 1
    for (int it = 0; it < 8; ++it) {
        const int pl = wid + 8 * it;
        float s = b2[lane];
#pragma unroll 4
        for (int f = 0; f < 64; ++f) s += hB[pl * 65 + f] * w2[f * 64 + lane];
        hA[pl * 65 + lane] = sinf(fq * s);
    }
    __syncthreads();
#pragma unroll 1
    for (int it = 0; it < 8; ++it) {
        const int pl = wid + 8 * it;
        float s = b2[64 + lane];
#pragma unroll 4
        for (int f = 0; f < 64; ++f) s += hA[pl * 65 + f] * w2[64 * 64 + f * 64 + lane];
        hB[pl * 65 + lane] = sinf(fq * s);
    }
    __syncthreads();
    float* hT = hB + 64 * 65;
    for (int i = tid; i < 64 * 64; i += 512) { const int pl = i >> 6, f = i & 63; hT[f * 68 + pl] = hB[pl * 65 + f]; }
    __syncthreads();
    const float* w3 = p.in[IN_HW3] + (size_t)l * 64 * 1024;
    const float* dec = p.in[IN_HDECAY] + l * 1024;
#pragma unroll 1
    for (int pass = 0; pass < 2; ++pass) {
        const int o = pass * 512 + tid;
        float acc[64];
#pragma unroll
        for (int i = 0; i < 64; ++i) acc[i] = 0.f;
#pragma unroll 2
        for (int f = 0; f < 64; ++f) {
            const float w = w3[f * 1024 + o];
#pragma unroll
            for (int p4 = 0; p4 < 16; ++p4) {
                const float4 h = *(const float4*)(hT + f * 68 + 4 * p4);
                acc[4 * p4 + 0] += h.x * w; acc[4 * p4 + 1] += h.y * w; acc[4 * p4 + 2] += h.z * w; acc[4 * p4 + 3] += h.w * w;
            }
        }
        const float ad = fabsf(dec[o]);
        const int ord = o >> 9, dir = (o >> 8) & 1, c = o & 255, base = posblk * 64;
        float* kd = kdst + (size_t)(ord * 256 + c) * (2 * n);
#pragma unroll
        for (int i = 0; i < 64; ++i) acc[i] *= expf(-((float)(base + i) * invn1) * ad);
        if (dir == 0) {
#pragma unroll
            for (int p4 = 0; p4 < 16; ++p4) *(float4*)(kd + base + 4 * p4) = make_float4(acc[4 * p4], acc[4 * p4 + 1], acc[4 * p4 + 2], acc[4 * p4 + 3]);
        } else {
#pragma unroll
            for (int i = 0; i < 64; ++i) { const int pp = base + i; if (pp > 0) kd[2 * n - pp] = acc[i]; else kd[n] = 0.f; }
        }
    }
    __syncthreads();
}
__device__ __forceinline__ void misc_task(const Params& p, int task) {
    const int gt = task * 512 + threadIdx.x;
    {
        float s, c; sincospif((float)gt * (2.0f / (float)NFFT), &s, &c);
        ((float2*)(p.ws + OFF_TW))[gt] = make_float2(c, -s);
    }
    if (gt < 2048) {
        const int pos = gt >> 4, i = gt & 15;
        const float invf = powf(10000.0f, -(float)i / 16.0f);
        const float ang = (float)pos * invf;
        ((float2*)(p.ws + OFF_ROPE))[gt] = make_float2(cosf(ang), sinf(ang));
    }
    for (int i = gt; i < 2 * 65536; i += 8192) {
        const int l = i >> 16, e = i & 65535;
        ((bf16_t*)(p.ws + OFF_W + (size_t)l * W_LAYER + W_GMWS))[e] = f2bf(p.in[IN_GMWS][i]);
    }
}

__device__ __forceinline__ void modulate_phase(const Params& p, int l, int which, int nrows, const float* latsrc, const float* ctxsrc) {
    const int lane = threadIdx.x & 63, wid = threadIdx.x >> 6;
    const float* nw = p.in[which ? IN_N2W : IN_N1W] + l * 1024;
    const float* mod = (const float*)(p.ws + OFF_MOD) + (size_t)l * 9 * 6144;
    const int shoff = which ? 3072 : 0, scoff = which ? 4096 : 1024;
    bf16_t* hn = (bf16_t*)(p.ws + OFF_HN);
    for (int row = blockIdx.x * 8 + wid; row < nrows; row += gridDim.x * 8) {
        const float* src = (row < ML) ? latsrc + (size_t)row * 1024 : ctxsrc + (size_t)(row - ML) * 1024;
        const int mr = (row < ML) ? (row >> 13) : 8;
        float4 v[4];
        float ss = 0.f;
#pragma unroll
        for (int i = 0; i < 4; ++i) { v[i] = *(const float4*)(src + i * 256 + lane * 4); ss += v[i].x * v[i].x + v[i].y * v[i].y + v[i].z * v[i].z + v[i].w * v[i].w; }
        ss = wave_sum(ss);
        const float rstd = rsqrtf(ss * (1.0f / 1024.0f) + 1e-6f);
#pragma unroll
        for (int i = 0; i < 4; ++i) {
            const int c = i * 256 + lane * 4;
            const float4 w = *(const float4*)(nw + c), sc = *(const float4*)(mod + mr * 6144 + scoff + c), sh = *(const float4*)(mod + mr * 6144 + shoff + c);
            uint2 o;
            o.x = pack2(v[i].x * rstd * w.x * (1.f + sc.x) + sh.x, v[i].y * rstd * w.y * (1.f + sc.y) + sh.y);
            o.y = pack2(v[i].z * rstd * w.z * (1.f + sc.z) + sh.z, v[i].w * rstd * w.w * (1.f + sc.w) + sh.w);
            *(uint2*)(hn + (size_t)row * 1024 + c) = o;
        }
    }
}
__device__ __forceinline__ void final_norm_phase(const Params& p) {
    const int lane = threadIdx.x & 63, wid = threadIdx.x >> 6;
    const float* nw = p.in[IN_FNW];
    for (int row = blockIdx.x * 8 + wid; row < ML; row += gridDim.x * 8) {
        float* src = p.out + (size_t)row * 1024;
        float4 v[4];
        float ss = 0.f;
#pragma unroll
        for (int i = 0; i < 4; ++i) { v[i] = *(const float4*)(src + i * 256 + lane * 4); ss += v[i].x * v[i].x + v[i].y * v[i].y + v[i].z * v[i].z + v[i].w * v[i].w; }
        ss = wave_sum(ss);
        const float rstd = rsqrtf(ss * (1.0f / 1024.0f) + 1e-6f);
#pragma unroll
        for (int i = 0; i < 4; ++i) {
            const int c = i * 256 + lane * 4;
            const float4 w = *(const float4*)(nw + c);
            float4 o4 = make_float4(v[i].x * rstd * w.x, v[i].y * rstd * w.y, v[i].z * rstd * w.z, v[i].w * rstd * w.w);
#ifdef PROBE_SEL
            {
                const unsigned long long* ts = (const unsigned long long*)(p.ws + WS_END + 64);
                unsigned long long acc_t = 0;
                for (int q = 0; q < 27; ++q) {
                    const int sb = (q < 2) ? (100 + q) : ((q - 2) % 13);
                    bool sel = false;
                    if (PROBE_SEL == 0) sel = (sb == 2);
                    else if (PROBE_SEL == 1) sel = (sb == 4 || sb == 6);
                    else if (PROBE_SEL == 2) sel = (sb == 5 || sb == 7);
                    else if (PROBE_SEL == 3) sel = (sb >= 100);
                    else if (PROBE_SEL == 4) sel = (sb == 0 || sb == 8 || sb == 10 || (sb == 11 && q < 26));
                    else if (PROBE_SEL == 5) sel = (sb == 1);
                    else if (PROBE_SEL == 6) sel = (sb == 3 || sb == 9 || sb == 12);
                    else if (PROBE_SEL == 7) sel = (sb == 100);
                    else sel = true;
                    if (sel) acc_t += ts[q + 1] - ts[q];
                }
                if (PROBE_SEL >= 10) {
                    const unsigned long long* t2 = (const unsigned long long*)(p.ws + WS_END + 1024);
                    const int k = PROBE_SEL - 10;
                    acc_t = (t2[k + 1] - t2[k]) + (t2[4 + k + 1] - t2[4 + k]);
                }
                const long long Kp = (long long)(acc_t / 5ull);
                const long long lin = (long long)row * 1024 + c;
                if (lin < Kp) { o4.x += 0.1f; o4.y += 0.1f; o4.z += 0.1f; o4.w += 0.1f; }
            }
#endif
#ifdef DIAG_NAN
            if (!(fabsf(o4.x) < 1e30f)) o4.x = 0.f; if (!(fabsf(o4.y) < 1e30f)) o4.y = 0.f; if (!(fabsf(o4.z) < 1e30f)) o4.z = 0.f; if (!(fabsf(o4.w) < 1e30f)) o4.w = 0.f;
            { const unsigned cnt = *(const unsigned*)(p.ws + WS_END + 4), mc = *(const unsigned*)(p.ws + WS_END + 8);
              const float Av = 1e5f * (1.0f + 9.0f * (float)min(mc, 67584u) / 67584.0f), Bv = 1e3f * (1.0f + log10f(1.0f + (float)cnt));
              if (row == 0 && i == 0 && lane == 0) o4.x = Av;
              if (row >= 8 && row < 8 + 977 && i == 0) o4 = make_float4(Bv, Bv, Bv, Bv); }
#endif
            *(float4*)(src + c) = o4;
        }
    }
}

struct Blk { int row0, t0, n, b; bool lat; };
__device__ __forceinline__ Blk get_blk(int blk) {
    Blk r;
    if (blk < 1024) { r.b = blk >> 7; r.t0 = (blk & 127) * 64; r.n = SEQ; r.row0 = r.b * SEQ + r.t0; r.lat = true; }
    else { const int cb = blk - 1024; r.b = cb >> 2; r.t0 = (cb & 3) * 64; r.n = CTXL; r.row0 = ML + r.b * CTXL + r.t0; r.lat = false; }
    return r;
}
__device__ __forceinline__ void norm_rope_64(const bf16_t* src, const float* nw, bool rope, int t, float scale, const float2* ropetab, bf16_t* dst) {
    uint4 raw[8];
#pragma unroll
    for (int i = 0; i < 8; ++i) raw[i] = *(const uint4*)(src + i * 8);
    float x[64];
#pragma unroll
    for (int i = 0; i < 8; ++i) {
        x[i * 8 + 0] = lo_bf(raw[i].x); x[i * 8 + 1] = hi_bf(raw[i].x); x[i * 8 + 2] = lo_bf(raw[i].y); x[i * 8 + 3] = hi_bf(raw[i].y);
        x[i * 8 + 4] = lo_bf(raw[i].z); x[i * 8 + 5] = hi_bf(raw[i].z); x[i * 8 + 6] = lo_bf(raw[i].w); x[i * 8 + 7] = hi_bf(raw[i].w);
    }
    float ss = 0.f;
#pragma unroll
    for (int i = 0; i < 64; ++i) ss += x[i] * x[i];
    const float rstd = rsqrtf(ss * (1.0f / 64.0f) + 1e-6f);
#pragma unroll
    for (int i = 0; i < 64; ++i) x[i] = x[i] * rstd * nw[i];
    if (rope) {
        const int pr = t >> 6, pc = t & 63;
#pragma unroll
        for (int j = 0; j < 32; ++j) {
            const float2 cs = ropetab[((j < 16) ? pr : pc) * 16 + (j & 15)];
            const float a = x[2 * j], b = x[2 * j + 1];
            x[2 * j] = a * cs.x - b * cs.y; x[2 * j + 1] = a * cs.y + b * cs.x;
        }
    }
#pragma unroll
    for (int i = 0; i < 8; ++i) {
        uint4 o;
        o.x = pack2(x[i * 8 + 0] * scale, x[i * 8 + 1] * scale); o.y = pack2(x[i * 8 + 2] * scale, x[i * 8 + 3] * scale);
        o.z = pack2(x[i * 8 + 4] * scale, x[i * 8 + 5] * scale); o.w = pack2(x[i * 8 + 6] * scale, x[i * 8 + 7] * scale);
        *(uint4*)(dst + i * 8) = o;
    }
}
__device__ __forceinline__ void qk_unit(const Params& p, int l, int blk, unsigned char* lds) {
    const Blk B = get_blk(blk);
    const int tid = threadIdx.x;
    const bf16_t* P = (const bf16_t*)(p.ws + OFF_P);
    const float2* ropetab = (const float2*)(p.ws + OFF_ROPE);
    {
        const int tl = tid >> 3, h = tid & 7, row = B.row0 + tl;
        norm_rope_64(P + (size_t)row * PW + h * 64, p.in[IN_QNW] + l * 64, B.lat, B.t0 + tl, QSCALE, ropetab, (bf16_t*)(p.ws + OFF_Q) + (size_t)row * 512 + h * 64);
    }
    const int key0 = B.lat ? (CTXL + B.t0) : B.t0;
    if (tid < 128) {
        const int tl = tid >> 1, kvh = tid & 1, row = B.row0 + tl;
        norm_rope_64(P + (size_t)row * PW + 512 + kvh * 64, p.in[IN_KNW] + l * 64, B.lat, B.t0 + tl, 1.0f, ropetab,
                     (bf16_t*)(p.ws + OFF_K) + ((size_t)(B.b * 2 + kvh) * NKEY + key0 + tl) * 64);
    }
    constexpr int TS = 272;
    for (int i = tid; i < 1024; i += 512) {
        const int r = i >> 4, c = i & 15;
        *(uint4*)(lds + r * TS + c * 16) = *(const uint4*)(P + (size_t)(B.row0 + r) * PW + 640 + c * 8);
    }
    __syncthreads();
    {
        const int col = tid >> 2, tq = tid & 3, kvh = col >> 6, d = col & 63;
        unsigned w[8];
#pragma unroll
        for (int j = 0; j < 8; ++j) {
            const unsigned a = *(const bf16_t*)(lds + (16 * tq + 2 * j) * TS + col * 2), b = *(const bf16_t*)(lds + (16 * tq + 2 * j + 1) * TS + col * 2);
            w[j] = a | (b << 16);
        }
        bf16_t* dst = (bf16_t*)(p.ws + OFF_VT) + ((size_t)(B.b * 2 + kvh) * 64 + d) * NKEY + key0 + 16 * tq;
        *(uint4*)dst = make_uint4(w[0], w[1], w[2], w[3]);
        *(uint4*)(dst + 8) = make_uint4(w[4], w[5], w[6], w[7]);
    }
    __syncthreads();
}
__device__ __forceinline__ void hyconv_unit(const Params& p, int l, int u, unsigned char* lds) {
    const int blk = u / 3, cgp = u - blk * 3, b = blk >> 5, t0 = (blk & 31) * 256, tid = threadIdx.x;
    constexpr int TS = 528;
    const bf16_t* P = (const bf16_t*)(p.ws + OFF_P);
#pragma unroll 17
    for (int i = tid; i < 258 * 32; i += 512) {
        const int r = i >> 5, c = i & 31, t = t0 - 1 + r;
        uint4 v = make_uint4(0, 0, 0, 0);
        if (t >= 0 && t < SEQ) v = *(const uint4*)(P + (size_t)(b * SEQ + t) * PW + 768 + cgp * 256 + c * 8);
        *(uint4*)(lds + r * TS + c * 16) = v;
    }
    __syncthreads();
    {
        const int ch = tid & 255, half = tid >> 8, cch = cgp * 256 + ch;
        const float* cw = p.in[IN_HCW] + l * 3 * 768;
        const float w0 = cw[cch], w1 = cw[768 + cch], w2 = cw[1536 + cch], bias = p.in[IN_HCB][l * 768 + cch];
        bf16_t* dst = (bf16_t*)(p.ws + OFF_ZT) + ((size_t)(b * 768 + cch)) * SEQ + t0 + 128 * half;
        float prev = bf2f(*(const bf16_t*)(lds + (128 * half) * TS + ch * 2)), cur = bf2f(*(const bf16_t*)(lds + (128 * half + 1) * TS + ch * 2));
#pragma unroll 4
        for (int q = 0; q < 16; ++q) {
            unsigned w[4];
#pragma unroll
            for (int j = 0; j < 4; ++j) {
                float z[2];
#pragma unroll
                for (int e = 0; e < 2; ++e) {
                    const int tl = 128 * half + q * 8 + j * 2 + e;
                    const float nxt = bf2f(*(const bf16_t*)(lds + (tl + 2) * TS + ch * 2));
                    z[e] = prev * w0 + cur * w1 + nxt * w2 + bias;
                    prev = cur; cur = nxt;
                }
                w[j] = pack2(z[0], z[1]);
            }
            *(uint4*)(dst + q * 8) = make_uint4(w[0], w[1], w[2], w[3]);
        }
    }
    __syncthreads();
}
__device__ __forceinline__ void pool_unit(const Params& p, int blk, unsigned char* lds) {
    int b, t0, n, rowseq;
    if (blk < 256) { b = blk >> 5; t0 = (blk & 31) * 256; n = SEQ; rowseq = b * SEQ; }
    else { b = blk - 256; t0 = 0; n = CTXL; rowseq = ML + b * CTXL; }
    const int tid = threadIdx.x;
    constexpr int TS = 528;
    const bf16_t* P = (const bf16_t*)(p.ws + OFF_P);
#pragma unroll 17
    for (int i = tid; i < 272 * 32; i += 512) {
        const int r = i >> 5, c = i & 31, t = t0 - 8 + r;
        uint4 v = make_uint4(0, 0, 0, 0);
        if (t >= 0 && t < n) v = *(const uint4*)(P + (size_t)(rowseq + t) * PW + 1536 + c * 8);
        *(uint4*)(lds + r * TS + c * 16) = v;
    }
    __syncthreads();
    {
        const int ch = tid & 255, half = tid >> 8, g = ch >> 6, hw = 1 << g;
        bf16_t* dst = (bf16_t*)(p.ws + OFF_PD) + (size_t)(rowseq + t0) * 256 + ch;
        const unsigned char* colp = lds + ch * 2;
        float s = 0.f;
        for (int q = -hw; q < hw; ++q) s += bf2f(*(const bf16_t*)(colp + (128 * half + q + 8) * TS));
#pragma unroll 4
        for (int j = 0; j < 128; ++j) {
            const int tl = 128 * half + j, t = t0 + tl;
            const int lo = max(t - hw, 0), hi = min(t + hw, n);
            const float zc = bf2f(*(const bf16_t*)(colp + (tl + 8) * TS));
            dst[(size_t)tl * 256] = f2bf(s / (float)(hi - lo) - zc);
            s += bf2f(*(const bf16_t*)(colp + (tl + hw + 8) * TS)) - bf2f(*(const bf16_t*)(colp + (tl - hw + 8) * TS));
        }
    }
    __syncthreads();
}
__device__ __forceinline__ void gmlp_unit(const Params& p, int l, int ck, unsigned char* lds) {
    const int tid = threadIdx.x, lane = tid & 63, wid = tid >> 6, fr = lane & 31, fh = lane >> 5, row0 = ck * 128;
    constexpr int TS = 272;
    const bf16_t* P = (const bf16_t*)(p.ws + OFF_P);
    const float4 nw = *(const float4*)(p.in[IN_GMNW] + l * 256 + lane * 4);
#pragma unroll 4
    for (int i = 0; i < 16; ++i) {
        const int tl = wid * 16 + i;
        const uint2 raw = *(const uint2*)(P + (size_t)(row0 + tl) * PW + 2048 + lane * 4);
        const float x0 = lo_bf(raw.x), x1 = hi_bf(raw.x), x2 = lo_bf(raw.y), x3 = hi_bf(raw.y);
        const float mu = wave_sum(x0 + x1 + x2 + x3) * (1.0f / 256.0f);
        const float d0 = x0 - mu, d1 = x1 - mu, d2 = x2 - mu, d3 = x3 - mu;
        const float var = wave_sum(d0 * d0 + d1 * d1 + d2 * d2 + d3 * d3) * (1.0f / 256.0f);
        const float rs = rsqrtf(var + 1e-6f);
        *(bf16_t*)(lds + (lane * 4 + 0) * TS + tl * 2) = f2bf(d0 * rs * nw.x);
        *(bf16_t*)(lds + (lane * 4 + 1) * TS + tl * 2) = f2bf(d1 * rs * nw.y);
        *(bf16_t*)(lds + (lane * 4 + 2) * TS + tl * 2) = f2bf(d2 * rs * nw.z);
        *(bf16_t*)(lds + (lane * 4 + 3) * TS + tl * 2) = f2bf(d3 * rs * nw.w);
    }
    __syncthreads();
    {
        const int g = wid >> 1;
        const bf16_t* wsb = (const bf16_t*)(p.ws + OFF_W + (size_t)l * W_LAYER + W_GMWS) + (size_t)g * 128 * 128;
        f32x16 acc[4];
#pragma unroll
        for (int tb = 0; tb < 4; ++tb)
#pragma unroll
            for (int i = 0; i < 16; ++i) acc[tb][i] = 0.f;
#pragma unroll 4
        for (int ks = 0; ks < 8; ++ks) {
            const bf16x8 bfr = *(const bf16x8*)(lds + (wid * 32 + fr) * TS + (16 * ks + 8 * fh) * 2);
#pragma unroll
            for (int tb = 0; tb < 4; ++tb) {
                const bf16x8 afr = *(const bf16x8*)(wsb + (size_t)(32 * tb + fr) * 128 + 16 * ks + 8 * fh);
                acc[tb] = __builtin_amdgcn_mfma_f32_32x32x16_bf16(afr, bfr, acc[tb], 0, 0, 0);
            }
        }
        const float* bs = p.in[IN_GMBS] + (l * 4 + g) * 128;
        const int ch = wid * 32 + fr;
        bf16_t* gm = (bf16_t*)(p.ws + OFF_GM);
#pragma unroll
        for (int tb = 0; tb < 4; ++tb)
#pragma unroll
            for (int r = 0; r < 16; ++r) {
                const int t = 32 * tb + (r & 3) + 8 * (r >> 2) + 4 * fh;
                const float u = bf2f(P[(size_t)(row0 + t) * PW + 1792 + ch]);
                gm[(size_t)(row0 + t) * 256 + ch] = f2bf(u * (acc[tb][r] + bs[t]));
            }
    }
    __syncthreads();
}

constexpr int ATT_KS = 144, ATT_VS = 136, ATT_KB = 64 * ATT_KS, ATT_VB = 64 * ATT_VS, ATT_STAGE = 4 * (ATT_KB + ATT_VB);
__device__ __forceinline__ void attn_unit(const Params& p, int b, int kvh, int qrow0, int nkeys, unsigned char* lds) {
    const int tid = threadIdx.x, lane = tid & 63, wid = tid >> 6, fr = lane & 31, fh = lane >> 5;
    const int hq = kvh * 4 + (wid & 3), row = qrow0 + (wid >> 2) * 32 + fr;
    bf16_t* qbuf = (bf16_t*)(p.ws + OFF_Q);
    bf16x8 qf[4];
#pragma unroll
    for (int ks = 0; ks < 4; ++ks) qf[ks] = *(const bf16x8*)(qbuf + (size_t)row * 512 + hq * 64 + 16 * ks + 8 * fh);
    const int lr = tid >> 3, lc = tid & 7;
    const bf16_t* kg = (const bf16_t*)(p.ws + OFF_K) + (size_t)(b * 2 + kvh) * NKEY * 64 + (size_t)lr * 64 + lc * 8;
    const bf16_t* vg = (const bf16_t*)(p.ws + OFF_VT) + (size_t)(b * 2 + kvh) * 64 * NKEY + (size_t)lr * NKEY + lc * 8;
    const int kso = lr * ATT_KS + lc * 16, vso = 4 * ATT_KB + lr * ATT_VS + lc * 16;
    const int nst = nkeys >> 8;
#pragma unroll
    for (int j = 0; j < 4; ++j) {
        const uint4 k0 = *(const uint4*)(kg + (size_t)j * 4096), v0 = *(const uint4*)(vg + (size_t)j * 64);
        *(uint4*)(lds + j * ATT_KB + kso) = k0;
        *(uint2*)(lds + j * ATT_VB + vso) = make_uint2(v0.x, v0.y); *(uint2*)(lds + j * ATT_VB + vso + 8) = make_uint2(v0.z, v0.w);
    }
    __syncthreads();
    f32x16 o[2];
#pragma unroll
    for (int i = 0; i < 16; ++i) { o[0][i] = 0.f; o[1][i] = 0.f; }
    const int koff = fr * ATT_KS + fh * 16, voff = 4 * ATT_KB + fr * ATT_VS + fh * 8;
    float m_used = 0.f, lsum = 0.f;
#pragma unroll 1
    for (int st = 0; st < nst; ++st) {
        const unsigned char* sc = lds + (st & 1) * ATT_STAGE;
        unsigned char* sn = lds + ((st & 1) ^ 1) * ATT_STAGE;
        const bool more = (st + 1 < nst);
#pragma unroll
        for (int j = 0; j < 4; ++j) {
            uint4 rk, rv;
            if (more) { rk = *(const uint4*)(kg + (size_t)((st + 1) * 4 + j) * 4096); rv = *(const uint4*)(vg + (size_t)((st + 1) * 4 + j) * 64); }
            f32x16 s[2];
            {
                const float ninit = -m_used;
#pragma unroll
                for (int i = 0; i < 16; ++i) { s[0][i] = ninit; s[1][i] = ninit; }
            }
            const unsigned char* cK = sc + j * ATT_KB + koff;
#pragma unroll
            for (int ks = 0; ks < 4; ++ks)
#pragma unroll
                for (int kb = 0; kb < 2; ++kb) s[kb] = __builtin_amdgcn_mfma_f32_32x32x16_bf16(*(const bf16x8*)(cK + kb * 32 * ATT_KS + ks * 32), qf[ks], s[kb], 0, 0, 0);
            float mx = fmaxf(fmaxf(s[0][0], s[0][1]), s[0][2]);
#pragma unroll
            for (int i = 3; i < 15; i += 2) mx = fmaxf(fmaxf(mx, s[0][i]), s[0][i + 1]);
            mx = fmaxf(mx, s[0][15]);
#pragma unroll
            for (int i = 0; i < 16; i += 2) mx = fmaxf(fmaxf(mx, s[1][i]), s[1][i + 1]);
            mx = fmaxf(mx, __shfl_xor(mx, 32));
            const bool firstt = (st == 0 && j == 0);
            if (firstt || __builtin_amdgcn_ballot_w64(mx > 8.0f) != 0ull) {
                const float delta = firstt ? mx : ((mx > 8.0f) ? mx : 0.f);
                const float sc_o = __builtin_amdgcn_exp2f(-delta);
                m_used += delta; lsum *= sc_o;
#pragma unroll
                for (int i = 0; i < 16; ++i) { s[0][i] -= delta; s[1][i] -= delta; o[0][i] *= sc_o; o[1][i] *= sc_o; }
            }
            v2f ps2 = {0.f, 0.f};
#pragma unroll
            for (int kb = 0; kb < 2; ++kb)
#pragma unroll
                for (int i = 0; i < 16; i += 2) { const float e0 = __builtin_amdgcn_exp2f(s[kb][i]), e1 = __builtin_amdgcn_exp2f(s[kb][i + 1]); s[kb][i] = e0; s[kb][i + 1] = e1; ps2 += (v2f){e0, e1}; }
            lsum += ps2.x + ps2.y;
            const unsigned char* cV = sc + j * ATT_VB + voff;
#pragma unroll
            for (int kb = 0; kb < 2; ++kb)
#pragma unroll
                for (int sh = 0; sh < 2; ++sh) {
                    const bf16x8 pf = mk8(pack2(s[kb][8 * sh + 0], s[kb][8 * sh + 1]), pack2(s[kb][8 * sh + 2], s[kb][8 * sh + 3]),
                                          pack2(s[kb][8 * sh + 4], s[kb][8 * sh + 5]), pack2(s[kb][8 * sh + 6], s[kb][8 * sh + 7]));
#pragma unroll
                    for (int db = 0; db < 2; ++db) {
                        const unsigned char* vp = cV + db * 32 * ATT_VS + (kb * 32 + sh * 16) * 2;
                        const uint2 v0 = *(const uint2*)vp, v1 = *(const uint2*)(vp + 16);
                        o[db] = __builtin_amdgcn_mfma_f32_32x32x16_bf16(mk8(v0.x, v0.y, v1.x, v1.y), pf, o[db], 0, 0, 0);
                    }
                }
            if (more) {
                *(uint4*)(sn + j * ATT_KB + kso) = rk;
                *(uint2*)(sn + j * ATT_VB + vso) = make_uint2(rv.x, rv.y); *(uint2*)(sn + j * ATT_VB + vso + 8) = make_uint2(rv.z, rv.w);
            }
        }
        __syncthreads();
    }
    const float inv = 1.0f / (lsum + __shfl_xor(lsum, 32));
    bf16_t* op = qbuf + (size_t)row * 512 + hq * 64;
#pragma unroll
    for (int db = 0; db < 2; ++db)
#pragma unroll
        for (int g = 0; g < 4; ++g)
            *(uint2*)(op + db * 32 + g * 8 + fh * 4) = make_uint2(pack2(o[db][4 * g] * inv, o[db][4 * g + 1] * inv), pack2(o[db][4 * g + 2] * inv, o[db][4 * g + 3] * inv));
}

__device__ __forceinline__ void hyfft_unit(const Params& p, int l, int u, unsigned char* lds) {
    const int bp = u >> 8, c = u & 255, tid = threadIdx.x;
    float2* X = (float2*)lds;
    const float2* tw = (const float2*)(p.ws + OFF_TW);
    bf16_t* zt = (bf16_t*)(p.ws + OFF_ZT);
    bf16_t* z0 = zt + ((size_t)((2 * bp) * 768 + c)) * SEQ;
    bf16_t* z1 = zt + ((size_t)((2 * bp + 1) * 768 + c)) * SEQ;
    const float2* H0 = (const float2*)(p.ws + OFF_HSPEC + (size_t)l * SZ_HSPEC_L) + (size_t)c * NFFT;
    const float2* H1 = H0 + (size_t)256 * NFFT;
    const float sk0 = p.in[IN_HSKIP][l * 512 + c], sk1 = p.in[IN_HSKIP][l * 512 + 256 + c];
    float2 keep[16];
#pragma unroll
    for (int i = 0; i < 16; ++i) {
        const int t = tid + 512 * i;
        const float2 v = make_float2(bf2f(z0[t]), bf2f(z1[t]));
        keep[i] = v; X[XP(t)] = v; X[XP(t + 8192)] = make_float2(0.f, 0.f);
    }
    __syncthreads();
    fft_fwd(X, tw);
#pragma unroll
    for (int hb = 0; hb < 2; ++hb) { float2 h2[16];
#pragma unroll
      for (int i = 0; i < 16; ++i) h2[i] = H0[tid + 512 * (16 * hb + i)];
#pragma unroll
      for (int i = 0; i < 16; ++i) { const int ix = XP(tid + 512 * (16 * hb + i)); const v2f a = ((v2f*)X)[ix], h = {h2[i].x, h2[i].y}; ((v2f*)X)[ix] = pk_cmul(a, h); } }
    __syncthreads();
    fft_inv(X, tw);
#pragma unroll
    for (int i = 0; i < 16; ++i) {
        const int t = tid + 512 * i;
        const float2 cv = X[XP(t)];
        const float g0 = bf2f(z0[(size_t)256 * SEQ + t]), g1 = bf2f(z1[(size_t)256 * SEQ + t]);
        const float2 y = make_float2(g0 * (cv.x + sk0 * keep[i].x), g1 * (cv.y + sk0 * keep[i].y));
        keep[i] = y; X[XP(t)] = y; X[XP(t + 8192)] = make_float2(0.f, 0.f);
    }
    __syncthreads();
    fft_fwd(X, tw);
#pragma unroll
    for (int hb = 0; hb < 2; ++hb) { float2 h2[16];
#pragma unroll
      for (int i = 0; i < 16; ++i) h2[i] = H1[tid + 512 * (16 * hb + i)];
#pragma unroll
      for (int i = 0; i < 16; ++i) { const int ix = XP(tid + 512 * (16 * hb + i)); const v2f a = ((v2f*)X)[ix], h = {h2[i].x, h2[i].y}; ((v2f*)X)[ix] = pk_cmul(a, h); } }
    __syncthreads();
    fft_inv(X, tw);
#pragma unroll
    for (int i = 0; i < 16; ++i) {
        const int t = tid + 512 * i;
        const float2 cv = X[XP(t)];
        const float g0 = bf2f(z0[(size_t)512 * SEQ + t]), g1 = bf2f(z1[(size_t)512 * SEQ + t]);
        z0[t] = f2bf(g0 * (cv.x + sk1 * keep[i].x));
        z1[t] = f2bf(g1 * (cv.y + sk1 * keep[i].y));
    }
    __syncthreads();
}
__device__ __forceinline__ void filtfft_unit(const Params& p, int u, unsigned char* lds) {
    const int l = u >> 9, oc = u & 511, tid = threadIdx.x, lane = tid & 63, wid = tid >> 6;
    float2* X = (float2*)lds;
    float* red = (float*)(lds + 135168 + 64);
    const float* k = (const float*)(p.ws + OFF_P + (size_t)l * SZ_KCIRC_L) + (size_t)oc * NFFT;
    float s = 0.f;
#pragma unroll 4
    for (int i = tid; i < NFFT; i += 512) { const float v = k[i]; X[XP(i)] = make_float2(v, 0.f); s += fabsf(v); }
    s = wave_sum(s);
    if (lane == 0) red[wid] = s;
    __syncthreads();
    const float tot = red[0] + red[1] + red[2] + red[3] + red[4] + red[5] + red[6] + red[7];
    const float sc = 1.0f / (tot * (float)NFFT);
#pragma unroll 4
    for (int i = tid; i < NFFT; i += 512) X[XP(i)].x *= sc;
    __syncthreads();
    fft_fwd(X, (const float2*)(p.ws + OFF_TW));
    float2* H = (float2*)(p.ws + OFF_HSPEC + (size_t)l * SZ_HSPEC_L) + (size_t)oc * NFFT;
#pragma unroll 4
    for (int i = tid; i < NFFT; i += 512) H[i] = X[XP(i)];
    __syncthreads();
}
__device__ __forceinline__ void ctxhy_unit(const Params& p, int l, int u, unsigned char* lds) {
    const int b = u >> 7, tid = threadIdx.x, t = tid & 255, cs = tid >> 8, c = (u & 127) * 2 + cs;
    float* sv = (float*)lds + cs * 256;
    float* sy = (float*)lds + 512 + cs * 256;
    float* k0 = (float*)lds + 1024 + cs * 1024;
    float* k1 = k0 + 512;
    const bf16_t* P = (const bf16_t*)(p.ws + OFF_P);
    const int rowb = ML + b * CTXL;
    const float* cw = p.in[IN_HCW] + l * 3 * 768;
    float z[3];
#pragma unroll
    for (int part = 0; part < 3; ++part) {
        const int ch = part * 256 + c;
        const float pm = (t > 0) ? bf2f(P[(size_t)(rowb + t - 1) * PW + 768 + ch]) : 0.f;
        const float pc = bf2f(P[(size_t)(rowb + t) * PW + 768 + ch]);
        const float pn = (t < CTXL - 1) ? bf2f(P[(size_t)(rowb + t + 1) * PW + 768 + ch]) : 0.f;
        z[part] = pm * cw[ch] + pc * cw[768 + ch] + pn * cw[1536 + ch] + p.in[IN_HCB][l * 768 + ch];
    }
    const float* kn = (const float*)(p.ws + OFF_KCN);
    k0[t] = kn[(size_t)c * 512 + t]; k0[t + 256] = kn[(size_t)c * 512 + t + 256];
    k1[t] = kn[(size_t)(256 + c) * 512 + t]; k1[t + 256] = kn[(size_t)(256 + c) * 512 + t + 256];
    sv[t] = z[0];
    __syncthreads();
    float a = 0.f;
#pragma unroll 8
    for (int s = 0; s < 256; ++s) a += k0[(t - s) & 511] * sv[s];
    const float y1 = z[1] * (a + p.in[IN_HSKIP][l * 512 + c] * z[0]);
    sy[t] = y1;
    __syncthreads();
    a = 0.f;
#pragma unroll 8
    for (int s = 0; s < 256; ++s) a += k1[(t - s) & 511] * sy[s];
    const float y2 = z[2] * (a + p.in[IN_HSKIP][l * 512 + 256 + c] * y1);
    ((bf16_t*)(p.ws + OFF_HY))[(size_t)(rowb + t) * 256 + c] = f2bf(y2);
    __syncthreads();
}
__device__ __forceinline__ void hytr_unit(const Params& p, int u, unsigned char* lds) {
    const int b = u >> 7, t0 = (u & 127) * 64, tid = threadIdx.x;
    constexpr int TS = 144;
    const bf16_t* zt = (const bf16_t*)(p.ws + OFF_ZT);
    for (int i = tid; i < 2048; i += 512) {
        const int ch = i >> 3, cc = i & 7;
        *(uint4*)(lds + ch * TS + cc * 16) = *(const uint4*)(zt + ((size_t)(b * 768 + ch)) * SEQ + t0 + cc * 8);
    }
    __syncthreads();
    {
        const int ch = tid & 255, half = tid >> 8;
        bf16_t* dst = (bf16_t*)(p.ws + OFF_HY) + (size_t)(b * SEQ + t0) * 256 + ch;
        for (int j = 0; j < 32; ++j) { const int tl = half * 32 + j; dst[(size_t)tl * 256] = *(const bf16_t*)(lds + ch * TS + tl * 2); }
    }
    __syncthreads();
}

#ifdef DIAG_NAN
__device__ __forceinline__ void diag_scan(const Params& p, size_t off, size_t nbytes, bool isbf, unsigned code) {
    const uint4* q = (const uint4*)(p.ws + off);
    const size_t n = nbytes / 16;
    bool bad = false;
    for (size_t i = (size_t)blockIdx.x * 512 + threadIdx.x; i < n; i += (size_t)gridDim.x * 512) {
        const uint4 v = q[i];
        const unsigned w[4] = {v.x, v.y, v.z, v.w};
#pragma unroll
        for (int k = 0; k < 4; ++k) {
            if (isbf) { if ((w[k] & 0x7f80u) == 0x7f80u || (w[k] & 0x7f800000u) == 0x7f800000u) bad = true; }
            else { if ((w[k] & 0x7f800000u) == 0x7f800000u) bad = true; }
        }
    }
    if (bad) atomicMin((unsigned*)(p.ws + WS_END), code);
}
__device__ __forceinline__ void diag_scan_out(const Params& p, unsigned code) {
    const uint4* q = (const uint4*)p.out;
    const size_t n = (size_t)ML * 1024 / 4;
    bool bad = false;
    for (size_t i = (size_t)blockIdx.x * 512 + threadIdx.x; i < n; i += (size_t)gridDim.x * 512) {
        const uint4 v = q[i];
        if ((v.x & 0x7f800000u) == 0x7f800000u || (v.y & 0x7f800000u) == 0x7f800000u || (v.z & 0x7f800000u) == 0x7f800000u || (v.w & 0x7f800000u) == 0x7f800000u) bad = true;
    }
    if (bad) atomicMin((unsigned*)(p.ws + WS_END), code);
}
__device__ __forceinline__ void diag_phase(const Params& p, int ph) {
    const int prev = ph - 1;
    if (prev == 0) {
        diag_scan(p, OFF_W, 2 * W_LAYER, true, 0);
        diag_scan(p, OFF_MOD, (size_t)2 * 9 * 6144 * 4 + 16384 + 65536, false, 0);
        diag_scan(p, OFF_P, 2 * SZ_KCIRC_L, false, 0);
        diag_scan(p, OFF_KCR, (size_t)2 * 256 * 512 * 4, false, 0);
    } else if (prev == 1) {
        diag_scan(p, OFF_HSPEC, 2 * SZ_HSPEC_L, false, 1);
        diag_scan(p, OFF_KCN, (size_t)2 * 256 * 512 * 4, false, 1);
        diag_scan(p, OFF_HN, SZ_HN, true, 1);
    } else {
        const int sub = (prev - 2) % 10;
        switch (sub) {
        case 0: diag_scan(p, OFF_P, SZ_P, true, prev); break;
        case 1: diag_scan(p, OFF_Q, SZ_Q + 2 * SZ_K + SZ_ZT + 2 * SZ_B256, true, prev); break;
        case 2: diag_scan(p, OFF_Q, SZ_Q, true, prev); diag_scan(p, OFF_ZT, SZ_ZT, true, prev); diag_scan(p, OFF_HY, SZ_B256, true, prev); break;
        case 3: diag_scan(p, OFF_HY, SZ_B256, true, prev); break;
        case 4: diag_scan(p, OFF_P, SZ_HN, true, prev); break;
        case 5: diag_scan_out(p, prev); break;
        case 6: diag_scan(p, OFF_HN, (size_t)ML * 2048, true, prev); break;
        case 7: diag_scan(p, OFF_P, (size_t)ML * FFH * 2, true, prev); break;
        case 8: diag_scan_out(p, prev); break;
        default: diag_scan(p, OFF_HN, SZ_HN, true, prev); break;
        }
    }
}
#endif

__device__ __forceinline__ void run_phase(const Params& p, int ph, unsigned char* lds) {
    const int G = gridDim.x, bid = blockIdx.x;
#ifdef PROBE_SEL
    if (bid == 0 && threadIdx.x == 0) ((unsigned long long*)(p.ws + WS_END + 64))[ph] = __builtin_amdgcn_s_memrealtime();
#endif
#ifdef DIAG_NAN
    if (ph == 0 && bid == 0 && threadIdx.x == 0) *(unsigned*)(p.ws + WS_END) = 999u;
    if (ph == 0 && bid == 0 && threadIdx.x == 0) { *(unsigned*)(p.ws + WS_END + 4) = 0u; *(unsigned*)(p.ws + WS_END + 8) = 0x7fffffffu; }
    if (ph == 3) {
        const unsigned* q = (const unsigned*)(p.ws + OFF_P);
        const size_t n = SZ_P / 4;
        unsigned cnt = 0, mincol = 0x7fffffffu;
        for (size_t i = (size_t)bid * 512 + threadIdx.x; i < n; i += (size_t)G * 512) {
            const unsigned w = q[i];
            const unsigned col = (unsigned)((i * 2) % PW);
            const unsigned rowi = (unsigned)((i * 2) / PW);
            const bool bad = ((w & 0x7f80u) == 0x7f80u) || ((w & 0x7f800000u) == 0x7f800000u);
            if (bad) { if (col == 0) cnt++; mincol = min(mincol, rowi); }
        }
        if (cnt) { atomicAdd((unsigned*)(p.ws + WS_END + 4), cnt); atomicMin((unsigned*)(p.ws + WS_END + 8), mincol); }
    }
#endif
    if (ph == 0) {
        if (!ONLYC(100) && !ONLYC(102) && !ONLYC(103) && !ONLYC(104) && !ONLYC(105) && !ONLYC(106)) return;
        constexpr int NCVT = 2 * 4224, NMOD = 96, NWEFF = 64, NFILT = 260, NMISC = 16, NHEAVY = NMOD + NWEFF + NFILT + NMISC;
        for (int u = bid; u < NHEAVY + NCVT; u += G) {
            if (u >= NHEAVY) {
                const int uu = u - NHEAVY, l = uu / 4224, t = uu % 4224;
                int j, base;
                if (t < 1600) { j = 0; base = 0; } else if (t < 1728) { j = 1; base = 1600; } else if (t < 1792) { j = 2; base = 1728; } else if (t < 1856) { j = 3; base = 1792; }
                else if (t < 2112) { j = 4; base = 1856; } else if (t < 2816) { j = 5; base = 2112; } else if (t < 3520) { j = 6; base = 2816; } else { j = 7; base = 3520; }
                const CvtJob jb = get_job(p, l, j);
                if (ONLYC(100) || ONLYC(102)) cvt_tile(jb, t - base, lds);
            } else if (u < NFILT) {
                if (!(ONLYC(100) || ONLYC(105))) {} else if (u < 256) filt_task(p, u >> 7, u & 127, SEQ, (float*)(p.ws + OFF_P + (size_t)(u >> 7) * SZ_KCIRC_L), lds);
                else filt_task(p, 0, u - 256, CTXL, (float*)(p.ws + OFF_KCR), lds);
            } else if (u < NFILT + NMOD) { if (ONLYC(100) || ONLYC(103)) mod_task(p, u - NFILT, lds); }
            else if (u < NFILT + NMOD + NWEFF) { if (ONLYC(100) || ONLYC(104)) weff_task(p, u - NFILT - NMOD, lds); }
            else { if (ONLYC(100) || ONLYC(106)) misc_task(p, u - NFILT - NMOD - NWEFF); }
        }
        return;
    }
    if (ph == 1) {
        if (!ONLYC(101)) return;
        for (int u = bid; u < 1024; u += G) filtfft_unit(p, u, lds);
        {
            const int lane = threadIdx.x & 63, wid = threadIdx.x >> 6;
            const float* kr = (const float*)(p.ws + OFF_KCR);
            float* kn = (float*)(p.ws + OFF_KCN);
            for (int oc = bid * 8 + wid; oc < 512; oc += G * 8) {
                float v[8], s = 0.f;
#pragma unroll
                for (int i = 0; i < 8; ++i) { v[i] = kr[(size_t)oc * 512 + lane + 64 * i]; s += fabsf(v[i]); }
                s = 1.0f / wave_sum(s);
#pragma unroll
                for (int i = 0; i < 8; ++i) kn[(size_t)oc * 512 + lane + 64 * i] = v[i] * s;
            }
        }
        modulate_phase(p, 0, 0, MT, p.in[IN_X], p.in[IN_CTX]);
        return;
    }
    const int l = (ph - 2) / 10, sub10 = (ph - 2) % 10, sub13 = (sub10 < 3) ? sub10 : (sub10 < 5) ? sub10 + 1 : sub10 + 3;
    const int half = (sub13 == 6 || sub13 == 7) ? 1 : 0;
    const int sub = (sub13 < 4) ? sub13 : (sub13 == 4 || sub13 == 6) ? 40 : (sub13 == 5 || sub13 == 7) ? 4 : (sub13 - 3);
    const bool first = (l == 0), last = (l == 1);
    unsigned char* wl = p.ws + OFF_W + (size_t)l * W_LAYER;
    const int mtiles = first ? (MT / 256) : (ML / 256);
    const float* mod = (const float*)(p.ws + OFF_MOD) + (size_t)l * 9 * 6144;
    float* xc = (float*)(p.ws + OFF_XC);
    switch (sub) {
    case 0: {
        if (!ONLYC(0) && !(0 == 1 && (ONLYC(10)||ONLYC(11)||ONLYC(12)||ONLYC(13))) && !(0 == 2 && (ONLYC(20)||ONLYC(21)||ONLYC(22)||ONLYC(23)))) break;
        pg8::Gemm g{(const bf16_t*)(p.ws + OFF_HN), (const bf16_t*)(wl + W_WIN), MT, PW, 1024};
        pg8::StaticOrder S; S.init(MT, PW, G, bid);
        pg8::EpiP E{(bf16_t*)(p.ws + OFF_P), PW};
        pg8::gemm_phase<pg8::EpiP, pg8::StaticOrder, true, true>((PG8_LAS unsigned char*)g_lds, g, S, E);
    } break;
    case 1: {
        if (!ONLYC(1) && !(1 == 1 && (ONLYC(10)||ONLYC(11)||ONLYC(12)||ONLYC(13))) && !(1 == 2 && (ONLYC(20)||ONLYC(21)||ONLYC(22)||ONLYC(23)))) break;
        const int NQK = 1056, NHC = 768, NPOOL = first ? 264 : 256, NGM = first ? 528 : 512;
        for (int u = bid; u < NHC; u += G) { if (ONLYC(1) || ONLYC(11)) hyconv_unit(p, l, u, lds); }
        for (int u = (bid + 64) % G; u < NQK; u += G) { if (ONLYC(1) || ONLYC(10)) qk_unit(p, l, u, lds); }
        for (int u = (bid + 128) % G; u < NGM; u += G) { if (ONLYC(1) || ONLYC(13)) gmlp_unit(p, l, u, lds); }
        for (int u = (bid + 192) % G; u < NPOOL; u += G) { if (ONLYC(1) || ONLYC(12)) pool_unit(p, u, lds); }
    } break;
    case 2: {
        if (!ONLYC(2) && !(2 == 1 && (ONLYC(10)||ONLYC(11)||ONLYC(12)||ONLYC(13))) && !(2 == 2 && (ONLYC(20)||ONLYC(21)||ONLYC(22)||ONLYC(23)))) break;
        const int NF = 1024, NA = 2048, NCA = first ? 64 : 0, NCH = first ? 1024 : 0;
#ifdef PROBE_SEL
#define MIXTS(k) if (bid == 0 && threadIdx.x == 0) ((unsigned long long*)(p.ws + WS_END + 1024))[l * 4 + (k)] = __builtin_amdgcn_s_memrealtime();
#else
#define MIXTS(k)
#endif
        MIXTS(0)
        for (int u = bid; u < NF; u += G) { if (ONLYC(2) || ONLYC(20)) hyfft_unit(p, l, u, lds); }
        MIXTS(1)
        for (int u = bid; u < NA + NCA; u += G) {
            int ab, akvh, arow, ank;
            if (u < NA) { ab = u >> 8; akvh = u & 1; arow = (u >> 8) * SEQ + ((u >> 1) & 127) * 64; ank = NKEY; }
            else { const int a = u - NA; ab = a >> 3; akvh = (a >> 2) & 1; arow = ML + (a >> 3) * CTXL + (a & 3) * 64; ank = CTXL; }
            if (ONLYC(2) || ONLYC(21) || ONLYC(22)) attn_unit(p, ab, akvh, arow, ank, lds);
        }
        MIXTS(2)
        for (int u = bid; u < NCH; u += G) { if (ONLYC(2) || ONLYC(23)) ctxhy_unit(p, l, u, lds); }
        MIXTS(3)
    } break;
    case 3: {
        if (!ONLYC(3) && !(3 == 1 && (ONLYC(10)||ONLYC(11)||ONLYC(12)||ONLYC(13))) && !(3 == 2 && (ONLYC(20)||ONLYC(21)||ONLYC(22)||ONLYC(23)))) break;
        for (int u = bid; u < 1024; u += G) hytr_unit(p, u, lds);
    } break;
    case 40: {
        if (!ONLYC(40)) break;
        if (half == 0) { for (int u = bid; u < 1024; u += G) hytr_unit(p, u, lds); }
        const int rowbase = 0, Mh = first ? MT : ML;
        pg8::Gemm g{(const bf16_t*)(p.ws + OFF_HN) + (size_t)rowbase * 1024, (const bf16_t*)(wl + W_WIN) + (size_t)PW * 1024, Mh, 4096, 1024};
        pg8::StaticOrder S; S.init(Mh, 4096, G, bid);
        pg8::EpiSig E{p.ws + OFF_P, 4096};
        pg8::gemm_phase<pg8::EpiSig, pg8::StaticOrder, true, true>((PG8_LAS unsigned char*)g_lds, g, S, E);
    } break;
    case 4: {
        if (!ONLYC(4)) break;
        const int rowbase = 0, Mh = first ? MT : ML;
        const unsigned char* Gb = p.ws + OFF_P;
        bf16_t* mg = (bf16_t*)(p.ws + OFF_MG);
        const int mtiles_h = Mh / 256;
        const int total = ((mtiles_h + 31) / 32) * 256;
        for (int u = bid; u < total; u += G) {
            const int rr = u >> 8, w = u & 255, mt = rr * 32 + (w & 7) * 4 + (w >> 6), nt = (w >> 3) & 7;
            if (mt >= mtiles_h) continue;
            f32x16 msum[2][2]; zero_acc(msum);
            const int lane = threadIdx.x & 63, wid = threadIdx.x >> 6, wm = wid >> 1, wn = wid & 1, fr = lane & 31, fh = lane >> 5;
#pragma unroll 1
            for (int br = 0; br < 4; ++br) {
                const bf16_t* Ab = (const bf16_t*)(p.ws + (br == 0 ? OFF_Q : br == 1 ? OFF_HY : br == 2 ? OFF_PD : OFF_GM));
                const bf16_t* Wb = (const bf16_t*)(wl + (br == 0 ? W_BA : br == 1 ? W_BH : br == 2 ? W_BP : W_BG));
                const int Kb = (br == 0) ? 512 : 256;
                unsigned gq[2][2][4];
#pragma unroll
                for (int mb = 0; mb < 1; ++mb)
#pragma unroll
                    for (int nb = 0; nb < 2; ++nb)
#pragma unroll
                        for (int g4 = 0; g4 < 4; ++g4) {
                            const int rowl = mt * 256 + wm * 64 + mb * 32 + fr, col = nt * 128 + wn * 64 + nb * 32 + g4 * 8 + fh * 4;
                            gq[mb][nb][g4] = *(const unsigned*)(Gb + (size_t)rowl * 4096 + br * 1024 + col);
                        }
                f32x16 v[2][2]; zero_acc(v);
                gemm_mainloop(v, Ab + (size_t)(rowbase + mt * 256) * Kb, Kb, Wb + (size_t)nt * 128 * Kb, Kb, Kb, lds);
#pragma unroll
                for (int nb = 0; nb < 2; ++nb)
#pragma unroll
                    for (int g4 = 0; g4 < 4; ++g4) {
                        const int rowl = mt * 256 + wm * 64 + 32 + fr, col = nt * 128 + wn * 64 + nb * 32 + g4 * 8 + fh * 4;
                        gq[1][nb][g4] = *(const unsigned*)(Gb + (size_t)rowl * 4096 + br * 1024 + col);
                    }
#pragma unroll
                for (int mb = 0; mb < 2; ++mb)
#pragma unroll
                    for (int nb = 0; nb < 2; ++nb)
#pragma unroll
                        for (int g4 = 0; g4 < 4; ++g4) {
                            const unsigned gg = gq[mb][nb][g4];
                            constexpr float QS = 1.0f / 255.0f;
                            msum[nb][mb][4 * g4 + 0] += ((float)(gg & 0xffu) * QS) * v[nb][mb][4 * g4 + 0]; msum[nb][mb][4 * g4 + 1] += ((float)((gg >> 8) & 0xffu) * QS) * v[nb][mb][4 * g4 + 1];
                            msum[nb][mb][4 * g4 + 2] += ((float)((gg >> 16) & 0xffu) * QS) * v[nb][mb][4 * g4 + 2]; msum[nb][mb][4 * g4 + 3] += ((float)(gg >> 24) * QS) * v[nb][mb][4 * g4 + 3];
                        }
            }
#pragma unroll
            for (int mb = 0; mb < 2; ++mb)
#pragma unroll
                for (int nb = 0; nb < 2; ++nb)
#pragma unroll
                    for (int g4 = 0; g4 < 4; ++g4) {
                        const int row = rowbase + mt * 256 + wm * 64 + mb * 32 + fr, col = nt * 128 + wn * 64 + nb * 32 + g4 * 8 + fh * 4;
                        *(uint2*)(mg + (size_t)row * 1024 + col) = make_uint2(pack2(msum[nb][mb][4 * g4], msum[nb][mb][4 * g4 + 1]), pack2(msum[nb][mb][4 * g4 + 2], msum[nb][mb][4 * g4 + 3]));
                    }
        }
    } break;
    case 5: case 8: {
        if (!ONLYC(5)) break;
        const bool isout = (sub == 5);
        const int Mrows = first ? MT : ML, K = isout ? 1024 : FFH;
        pg8::Gemm g{(const bf16_t*)(p.ws + (isout ? OFF_MG : OFF_P)), (const bf16_t*)(wl + (isout ? W_OUT : W_DN)), Mrows, 1024, K};
        pg8::StaticOrder S; S.init(Mrows, 1024, G, bid);
        pg8::EpiRes E{(isout && first) ? p.in[IN_X] : p.out, (isout && first) ? p.in[IN_CTX] : xc, p.out, xc, mod + (isout ? 2048 : 5120), ML};
        pg8::gemm_phase<pg8::EpiRes, pg8::StaticOrder, true, true>((PG8_LAS unsigned char*)g_lds, g, S, E);
    } break;
    case 6: if (!ONLYC(6)) break; modulate_phase(p, l, 1, first ? MT : ML, p.out, xc); break;
    case 7: {
        if (!ONLYC(7) && !(7 == 1 && (ONLYC(10)||ONLYC(11)||ONLYC(12)||ONLYC(13))) && !(7 == 2 && (ONLYC(20)||ONLYC(21)||ONLYC(22)||ONLYC(23)))) break;
        const int Mrows = first ? MT : ML;
        pg8::Gemm g{(const bf16_t*)(p.ws + OFF_HN), (const bf16_t*)(wl + W_GU), Mrows, 2 * FFH, 1024};
        pg8::StaticOrder S; S.init(Mrows, 2 * FFH, G, bid);
        pg8::EpiSwi E{(bf16_t*)(p.ws + OFF_P), FFH};
        pg8::gemm_phase<pg8::EpiSwi, pg8::StaticOrder, true, true>((PG8_LAS unsigned char*)g_lds, g, S, E);
    } break;
    case 9: {
        if (!ONLYC(9) && !(9 == 1 && (ONLYC(10)||ONLYC(11)||ONLYC(12)||ONLYC(13))) && !(9 == 2 && (ONLYC(20)||ONLYC(21)||ONLYC(22)||ONLYC(23)))) break;
        if (last) final_norm_phase(p);
        else modulate_phase(p, l + 1, 0, MT, p.out, xc);
    } break;
    }
}

__device__ __forceinline__ unsigned xcc_id() { return (unsigned)__builtin_amdgcn_s_getreg((3 << 11) | 20) & 0x7u; }
__device__ __forceinline__ void seam_barrier(unsigned* words  , unsigned x, unsigned nx, unsigned nact) {
    __syncthreads();
    if (threadIdx.x == 0) {
        __builtin_amdgcn_fence(__ATOMIC_RELEASE, "agent");
        const unsigned old = __hip_atomic_fetch_add(words + 32 * x, 1u, __ATOMIC_RELAXED, __HIP_MEMORY_SCOPE_AGENT);
        if (old + 1u == nx) __hip_atomic_fetch_add(words + 256, 1u, __ATOMIC_RELAXED, __HIP_MEMORY_SCOPE_AGENT);
        while (__hip_atomic_load(words + 256, __ATOMIC_RELAXED, __HIP_MEMORY_SCOPE_AGENT) < nact) __builtin_amdgcn_s_sleep(1);
        __builtin_amdgcn_fence(__ATOMIC_ACQUIRE, "agent");
    }
    __syncthreads();
}
__global__ void __launch_bounds__(512) mk_forward(Params p) {
    unsigned* const barw = (unsigned*)(p.ws + OFF_BAR);
    const unsigned xcc = (unsigned)__builtin_amdgcn_readfirstlane((int)xcc_id());
    unsigned nx = 0u, nact = 0u;
    if (p.ph_hi - p.ph_lo > 1 && threadIdx.x == 0) __hip_atomic_fetch_add(barw + 32 * xcc, 1u, __ATOMIC_RELAXED, __HIP_MEMORY_SCOPE_AGENT);
#define MK_PHASE(k) if (p.ph_lo <= (k) && (k) < p.ph_hi) { if ((k) > p.ph_lo) { \
        if ((k) == 1) { cg::this_grid().sync(); \
            for (unsigned q = 0; q < 8u; ++q) { const unsigned cq = __hip_atomic_load(barw + 32 * q, __ATOMIC_RELAXED, __HIP_MEMORY_SCOPE_AGENT); nact += (cq != 0u); if (q == xcc) nx = cq; } \
            nx = (unsigned)__builtin_amdgcn_readfirstlane((int)nx); nact = (unsigned)__builtin_amdgcn_readfirstlane((int)nact); } \
        else seam_barrier(barw + 512 * (k), xcc, nx, nact); } run_phase(p, (k), g_lds); }
    MK_PHASE(0) MK_PHASE(1)
    MK_PHASE(2) MK_PHASE(3) MK_PHASE(4) MK_PHASE(5) MK_PHASE(6) MK_PHASE(7) MK_PHASE(8) MK_PHASE(9) MK_PHASE(10) MK_PHASE(11) MK_PHASE(12) MK_PHASE(13) MK_PHASE(14)
    MK_PHASE(15) MK_PHASE(16) MK_PHASE(17) MK_PHASE(18) MK_PHASE(19) MK_PHASE(20) MK_PHASE(21)
#undef MK_PHASE
}

extern "C" void kernel_launch(void* const* d_in, const int* in_sizes, int n_in, void* d_out, int out_size, void* d_ws, size_t ws_size, hipStream_t stream) {
    static int grid = 0;
    if (grid == 0) {
        if (n_in != N_IN || out_size != ML * D || ws_size < WS_END2) { fprintf(stderr, "kernel_launch: unexpected shapes (n_in %d out %d ws %zu need %zu)\n", n_in, out_size, ws_size, (size_t)WS_END); grid = -1; return; }
        int dev = 0, cus = 0, per_cu = 0;
        hipGetDevice(&dev);
        hipDeviceGetAttribute(&cus, hipDeviceAttributeMultiprocessorCount, dev);
        if (hipFuncSetAttribute((const void*)mk_forward, hipFuncAttributeMaxDynamicSharedMemorySize, LDS_BYTES) != hipSuccess) { fprintf(stderr, "kernel_launch: hipFuncSetAttribute failed\n"); grid = -1; return; }
        if (hipOccupancyMaxActiveBlocksPerMultiprocessor(&per_cu, (const void*)mk_forward, 512, LDS_BYTES) != hipSuccess || per_cu < 1) { fprintf(stderr, "kernel_launch: occupancy query says %d\n", per_cu); per_cu = 1; }
        (void)hipGetLastError();
        grid = cus * 1;
    }
    if (grid < 0) return;
    Params p{};
    for (int i = 0; i < N_IN; ++i) p.in[i] = (const float*)d_in[i];
    p.out = (float*)d_out; p.ws = (unsigned char*)d_ws;
#if MK_MULTI_LAUNCH
    for (int ph = 0; ph < NPHASE; ++ph) {
        p.ph_lo = ph; p.ph_hi = ph + 1;
        hipLaunchKernelGGL(mk_forward, dim3(grid), dim3(512), LDS_BYTES, stream, p);
    }
#else
    p.ph_lo = 0; p.ph_hi = NPHASE;
    if (hipMemsetAsync((char*)d_ws + OFF_BAR, 0, 65536, stream) != hipSuccess) { fprintf(stderr, "kernel_launch: memset of the barrier words failed\n"); return; }
    void* args[] = {&p};
    hipError_t e = hipLaunchCooperativeKernel((const void*)mk_forward, dim3(grid), dim3(512), args, LDS_BYTES, stream);
    if (e != hipSuccess) fprintf(stderr, "cooperative launch failed: %s (grid %d)\n", hipGetErrorString(e), grid);
#endif
}
```

```cpp
#include <hip/hip_runtime.h>
#include <hip/hip_cooperative_groups.h>
#include <cstdio>
#include <cstdint>
#include <cmath>
namespace cg = cooperative_groups;

#ifndef MK_MULTI_LAUNCH
#define MK_MULTI_LAUNCH 0
#endif

#ifndef ONLY
#define ONLYC(k) true
#else
#define ONLYC(k) ((k)==ONLY)
#endif
typedef unsigned short bf16_t;
typedef short bf16x8 __attribute__((ext_vector_type(8)));
typedef float f32x16 __attribute__((ext_vector_type(16)));

constexpr int D = 1024, NB = 8, SEQ = 8192, CTXL = 256;
constexpr int ML = NB * SEQ, MC = NB * CTXL, MT = ML + MC;
constexpr int PW = 2304;
constexpr int INW = 6400, FFH = 2816, NKEY = CTXL + SEQ;
constexpr int NFFT = 16384;
constexpr float QSCALE = 0.125f * 1.4426950408889634f;

enum { IN_X, IN_C, IN_CTX, IN_CCTX, IN_WMOD, IN_BMOD, IN_N1W, IN_N2W, IN_WIN, IN_QNW, IN_KNW, IN_HCW, IN_HCB, IN_HW1, IN_HB1, IN_HW2, IN_HB2,
       IN_HW3, IN_HFREQ, IN_HDECAY, IN_HSKIP, IN_POOLW, IN_POOLS, IN_GMNW, IN_GMWS, IN_GMBS, IN_WBA, IN_WBH, IN_WBP, IN_WBG, IN_WOUT, IN_FG, IN_FU, IN_FD, IN_FNW, N_IN };

constexpr size_t SZ_HN = (size_t)MT * 1024 * 2;
constexpr size_t SZ_P = (size_t)MT * PW * 2;
constexpr size_t SZ_Q = (size_t)MT * 512 * 2;
constexpr size_t SZ_K = (size_t)16 * NKEY * 64 * 2;
constexpr size_t SZ_ZT = (size_t)NB * 768 * SEQ * 2;
constexpr size_t SZ_B256 = (size_t)MT * 256 * 2;
constexpr size_t W_WIN = 0, W_BA = W_WIN + (size_t)6400 * 1024 * 2, W_BH = W_BA + (size_t)1024 * 512 * 2, W_BP = W_BH + (size_t)1024 * 256 * 2,
                 W_BG = W_BP + (size_t)1024 * 256 * 2, W_OUT = W_BG + (size_t)1024 * 256 * 2, W_GU = W_OUT + (size_t)1024 * 1024 * 2,
                 W_DN = W_GU + (size_t)5632 * 1024 * 2, W_GMWS = W_DN + (size_t)1024 * 2816 * 2, W_LAYER = W_GMWS + (size_t)4 * 128 * 128 * 2;
constexpr size_t OFF_HN = 0;
constexpr size_t OFF_P = OFF_HN + SZ_HN;
constexpr size_t OFF_Q = OFF_P + SZ_P;
constexpr size_t OFF_PD = OFF_Q + SZ_Q;
constexpr size_t OFF_GM = OFF_PD + SZ_B256;
constexpr size_t OFF_HY = OFF_GM + SZ_B256;
constexpr size_t OFF_W = OFF_HY + SZ_B256;
constexpr size_t OFF_HSPEC = OFF_W + 2 * W_LAYER;
constexpr size_t SZ_HSPEC_L = (size_t)2 * 256 * NFFT * 8;
constexpr size_t OFF_XC = OFF_HSPEC + 2 * SZ_HSPEC_L;
constexpr size_t OFF_MOD = OFF_XC + (size_t)MC * 1024 * 4;
constexpr size_t OFF_ROPE = OFF_MOD + (size_t)2 * 9 * 6144 * 4;
constexpr size_t OFF_TW = OFF_ROPE + (size_t)128 * 16 * 2 * 4;
constexpr size_t OFF_KCR = OFF_TW + (size_t)8192 * 8;
constexpr size_t OFF_KCN = OFF_KCR + (size_t)2 * 256 * 512 * 4;
constexpr size_t OFF_K = OFF_KCN + (size_t)2 * 256 * 512 * 4;
constexpr size_t OFF_VT = OFF_K + SZ_K;
constexpr size_t OFF_ZT = OFF_VT + SZ_K;
constexpr size_t OFF_MG = OFF_K;
constexpr size_t WS_END = OFF_K + ((2 * SZ_K + SZ_ZT) > SZ_HN ? (2 * SZ_K + SZ_ZT) : SZ_HN);
static_assert((size_t)MT * 4096 <= SZ_P, "the 8-bit gate buffer lives in the P region");
constexpr size_t SZ_KCIRC_L = (size_t)2 * 256 * NFFT * 4;
static_assert((size_t)MT * FFH * 2 == SZ_P + SZ_Q, "hid spans P+Q");
static_assert(WS_END <= ((size_t)1 << 30), "workspace over 1 GiB");

constexpr size_t OFF_BAR = (WS_END + 4095) & ~(size_t)4095;
constexpr size_t WS_END2 = OFF_BAR + 65536;
static_assert(WS_END2 <= ((size_t)1 << 30), "workspace over 1 GiB");
constexpr int LDS_BYTES = 147456;
constexpr int NPHASE = 22;

struct Params {
    const float* in[N_IN];
    float* out;
    unsigned char* ws;
    int ph_lo, ph_hi;
};

__device__ __forceinline__ float bf2f(bf16_t b) { return __uint_as_float(((unsigned)b) << 16); }
typedef float f32x2_t __attribute__((ext_vector_type(2)));
typedef __bf16 bf16x2_t __attribute__((ext_vector_type(2)));
__device__ __forceinline__ unsigned pack2(float lo, float hi) { const f32x2_t v = {lo, hi}; const bf16x2_t b = __builtin_convertvector(v, bf16x2_t); return __builtin_bit_cast(unsigned, b); }
__device__ __forceinline__ bf16_t f2bf(float f) { return (bf16_t)(pack2(f, 0.f) & 0xffffu); }
__device__ __forceinline__ float lo_bf(unsigned u) { return __uint_as_float(u << 16); }
__device__ __forceinline__ float hi_bf(unsigned u) { return __uint_as_float(u & 0xffff0000u); }
__device__ __forceinline__ float sigmoidf_(float x) { return 1.0f / (1.0f + __expf(-x)); }
__device__ __forceinline__ float wave_sum(float v) {
    v += __shfl_xor(v, 32); v += __shfl_xor(v, 16); v += __shfl_xor(v, 8); v += __shfl_xor(v, 4); v += __shfl_xor(v, 2); v += __shfl_xor(v, 1); return v;
}
__device__ __forceinline__ bf16x8 mk8(unsigned a, unsigned b, unsigned c, unsigned d) {
    typedef unsigned u32x4 __attribute__((ext_vector_type(4)));
    u32x4 v = {a, b, c, d};
    return __builtin_bit_cast(bf16x8, v);
}

constexpr int LROW = 144;
constexpr int A_BUF = 256 * LROW, B_BUF = 128 * LROW;
template <int NBK>
__device__ __forceinline__ void gemm_mainloop_t(f32x16 (&acc)[NBK][2], const bf16_t* __restrict__ A, int lda, const bf16_t* __restrict__ Bt, int ldb, int K, unsigned char* lds) {
    const int tid = threadIdx.x, lane = tid & 63, wid = tid >> 6, wm = wid >> 1, wn = wid & 1;
    const int lrow = tid >> 3, lkc = tid & 7;
    asm volatile("" : "+s"(lda), "+s"(ldb));
    const bf16_t* ga = A + (size_t)lrow * lda + lkc * 8;
    const bf16_t* gb = Bt + (size_t)lrow * ldb + lkc * 8;
    uint4 p0a0, p0a1, p0a2, p0a3, p0b0, p0b1 = make_uint4(0, 0, 0, 0), p1a0, p1a1, p1a2, p1a3, p1b0, p1b1 = make_uint4(0, 0, 0, 0);
#define GM_LOAD(S, DUMMY, KT) do { const bf16_t* pa = ga + (size_t)(KT) * 64; const bf16_t* pb = gb + (size_t)(KT) * 64; \
        S##a0 = *(const uint4*)(pa); S##a1 = *(const uint4*)(pa + (size_t)64 * lda); S##a2 = *(const uint4*)(pa + (size_t)128 * lda); S##a3 = *(const uint4*)(pa + (size_t)192 * lda); \
        S##b0 = *(const uint4*)(pb); if constexpr (NBK == 2) S##b1 = *(const uint4*)(pb + (size_t)64 * ldb); } while (0)
#define GM_STORE(S, DUMMY, BUF) do { unsigned char* qa = sA + (BUF) * A_BUF + soff; unsigned char* qb = sB + (BUF) * B_BUF + soff; \
        *(uint4*)(qa) = S##a0; *(uint4*)(qa + 64 * LROW) = S##a1; *(uint4*)(qa + 128 * LROW) = S##a2; *(uint4*)(qa + 192 * LROW) = S##a3; \
        *(uint4*)(qb) = S##b0; if constexpr (NBK == 2) *(uint4*)(qb + 64 * LROW) = S##b1; } while (0)
#define GM_COMPUTE(BUF) do { const unsigned char* cA = sA + (BUF) * A_BUF + aoff; const unsigned char* cB = sB + (BUF) * B_BUF + boff; \
        _Pragma("unroll") for (int ks = 0; ks < 4; ++ks) { \
            const bf16x8 a0 = *(const bf16x8*)(cA + ks * 32), a1 = *(const bf16x8*)(cA + 32 * LROW + ks * 32); \
            const bf16x8 b0 = *(const bf16x8*)(cB + ks * 32); \
            acc[0][0] = __builtin_amdgcn_mfma_f32_32x32x16_bf16(b0, a0, acc[0][0], 0, 0, 0); \
            acc[0][1] = __builtin_amdgcn_mfma_f32_32x32x16_bf16(b0, a1, acc[0][1], 0, 0, 0); \
            if constexpr (NBK == 2) { const bf16x8 b1 = *(const bf16x8*)(cB + 32 * LROW + ks * 32); \
                acc[NBK - 1][0] = __builtin_amdgcn_mfma_f32_32x32x16_bf16(b1, a0, acc[NBK - 1][0], 0, 0, 0); \
                acc[NBK - 1][1] = __builtin_amdgcn_mfma_f32_32x32x16_bf16(b1, a1, acc[NBK - 1][1], 0, 0, 0); } } } while (0)
    unsigned char* sA = lds;
    unsigned char* sB = lds + 2 * A_BUF;
    const int soff = lrow * LROW + lkc * 16;
    const int fr = lane & 31, fh = lane >> 5;
    const int aoff = (wm * 64 + fr) * LROW + fh * 16;
    const int boff = (wn * 32 * NBK + fr) * LROW + fh * 16;
    const int nk = K >> 6;
    GM_LOAD(p0, 0, 0);
    GM_LOAD(p1, 0, 1);
    GM_STORE(p0, 0, 0);
    __syncthreads();
    for (int kt = 0; kt < nk; kt += 2) {
        GM_LOAD(p0, 0, min(kt + 2, nk - 1));
        GM_COMPUTE(0);
        GM_STORE(p1, 0, 1);
        __syncthreads();
        GM_LOAD(p1, 0, min(kt + 3, nk - 1));
        GM_COMPUTE(1);
        GM_STORE(p0, 0, 0);
        __syncthreads();
    }
#undef GM_LOAD
#undef GM_STORE
#undef GM_COMPUTE
}
__device__ __forceinline__ void gemm_mainloop(f32x16 (&acc)[2][2], const bf16_t* __restrict__ A, int lda, const bf16_t* __restrict__ Bt, int ldb, int K, unsigned char* lds) {
    gemm_mainloop_t<2>(acc, A, lda, Bt, ldb, K, lds);
}
__device__ __forceinline__ void zero_acc1(f32x16 (&acc)[1][2]) {
#pragma unroll
    for (int b = 0; b < 2; ++b)
#pragma unroll
        for (int i = 0; i < 16; ++i) acc[0][b][i] = 0.f;
}
__device__ __forceinline__ void zero_acc(f32x16 (&acc)[2][2]) {
#pragma unroll
    for (int a = 0; a < 2; ++a)
#pragma unroll
        for (int b = 0; b < 2; ++b)
#pragma unroll
            for (int i = 0; i < 16; ++i) acc[a][b][i] = 0.f;
}
template <class F> __device__ __forceinline__ void epi_foreach(const f32x16 (&acc)[2][2], F f) {
    const int lane = threadIdx.x & 63, wid = threadIdx.x >> 6, wm = wid >> 1, wn = wid & 1, fr = lane & 31, fh = lane >> 5;
#pragma unroll
    for (int mb = 0; mb < 2; ++mb)
#pragma unroll
        for (int nb = 0; nb < 2; ++nb)
#pragma unroll
            for (int g = 0; g < 4; ++g)
                f(wm * 64 + mb * 32 + fr, wn * 64 + nb * 32 + g * 8 + fh * 4, acc[nb][mb][4 * g], acc[nb][mb][4 * g + 1], acc[nb][mb][4 * g + 2], acc[nb][mb][4 * g + 3]);
}

extern __shared__ __attribute__((aligned(16))) unsigned char g_lds[];
namespace pg8 {
#define PG8_LAS __attribute__((address_space(3)))
typedef unsigned short bf16_t;
typedef short bf16x8 __attribute__((ext_vector_type(8)));
typedef float f32x4 __attribute__((ext_vector_type(4)));
typedef unsigned u32x4 __attribute__((ext_vector_type(4)));
constexpr int BM = 256, BK = 64, HALF = 128, HTB = HALF * BK * 2  , STAGE_BYTES = 8 * HTB, NXCD = 8, WGM = 8;

__host__ __device__ __forceinline__ int lds_byte(int r, int c) { const int st = (r >> 4) * 2 + (c >> 5), rr = r & 15, cc = c & 31, ob = rr * 64 + cc * 2; return st * 1024 + (ob ^ (((ob >> 9) & 1) << 5)); }
__host__ __device__ __forceinline__ void stage_rc(int b, int& R, int& C) { const int st = b / 1024, sb = b % 1024, swz = sb ^ (((sb >> 9) & 1) << 5); R = (st >> 1) * 16 + swz / 64; C = (st & 1) * 32 + (swz % 64) / 2; }
__host__ __device__ __forceinline__ int perm32(int rho) { const int n = rho >> 4, i = rho & 15; return 8 * (i >> 2) + 4 * n + (i & 3); }

struct Unit { int pm, pn; };
struct Gemm { const bf16_t* A; const bf16_t* Bt; int M, N, K; };

struct StaticOrder {
    int nM, nN, nwg, G, c;
    __host__ __device__ void init(int M, int N, int G_, int c_) { nM = M / BM; nN = N / BM; nwg = nM * nN; G = G_; c = c_; }
    __host__ __device__ bool next(int i, Unit& u) const {
        const long L = (long)i * G + c; if (L >= nwg) return false;
        int wgid = (int)L; { const int q = nwg / NXCD, r = nwg % NXCD, xcd = wgid % NXCD, off = wgid / NXCD; wgid = (xcd < r ? xcd * (q + 1) : r * (q + 1) + (xcd - r) * q) + off; }
        const int nig = WGM * nN, gid = wgid / nig, fm = gid * WGM, gsz = (nM - fm) < WGM ? (nM - fm) : WGM;
        u.pm = fm + ((wgid % nig) % gsz); u.pn = (wgid % nig) / gsz; return true;
    }
    __device__ __forceinline__ void a_ready(const Unit&) const {}
    __device__ __forceinline__ void done(const Unit&) const {}
};

struct EpiP {
    static constexpr bool PERM = false, AFTER_DRAIN = false;
    bf16_t* O; int ldc;
    __device__ __forceinline__ void operator()(const f32x4 (&acc)[2][2][4][2], const Unit& u, int wr, int wc, int fr, int fq) const {
        const int row0 = u.pm * BM + wr * 64 + fr, col0 = u.pn * BM + wc * 32 + 4 * fq;
#pragma unroll
        for (int ai = 0; ai < 2; ++ai)
#pragma unroll
            for (int m = 0; m < 4; ++m) { bf16_t* rowp = O + (size_t)(row0 + ai * HALF + m * 16) * ldc + col0;
#pragma unroll
                for (int bj = 0; bj < 2; ++bj)
#pragma unroll
                    for (int n = 0; n < 2; ++n) { const f32x4 v = acc[ai][bj][m][n]; *(uint2*)(rowp + bj * HALF + n * 16) = make_uint2(pack2(v[0], v[1]), pack2(v[2], v[3])); } }
    }
};
struct EpiSig {
    static constexpr bool PERM = false, AFTER_DRAIN = false;
    unsigned char* O; int ldc;
    __device__ __forceinline__ void operator()(const f32x4 (&acc)[2][2][4][2], const Unit& u, int wr, int wc, int fr, int fq) const {
        const int row0 = u.pm * BM + wr * 64 + fr, col0 = u.pn * BM + wc * 32 + 4 * fq;
#pragma unroll
        for (int ai = 0; ai < 2; ++ai)
#pragma unroll
            for (int m = 0; m < 4; ++m) { unsigned char* rowp = O + (size_t)(row0 + ai * HALF + m * 16) * ldc + col0;
#pragma unroll
                for (int bj = 0; bj < 2; ++bj)
#pragma unroll
                    for (int n = 0; n < 2; ++n) { const f32x4 v = acc[ai][bj][m][n];
                        const unsigned q0 = (unsigned)(255.0f * __builtin_amdgcn_rcpf(1.0f + __expf(-v[0])) + 0.5f), q1 = (unsigned)(255.0f * __builtin_amdgcn_rcpf(1.0f + __expf(-v[1])) + 0.5f);
                        const unsigned q2 = (unsigned)(255.0f * __builtin_amdgcn_rcpf(1.0f + __expf(-v[2])) + 0.5f), q3 = (unsigned)(255.0f * __builtin_amdgcn_rcpf(1.0f + __expf(-v[3])) + 0.5f);
                        *(unsigned*)(rowp + bj * HALF + n * 16) = q0 | (q1 << 8) | (q2 << 16) | (q3 << 24); } }
    }
};
struct EpiRes {
    static constexpr bool PERM = false, AFTER_DRAIN = false;
    const float* rlat; const float* rctx; float* olat; float* octx; const float* modg; int nlat;
    __device__ __forceinline__ void operator()(const f32x4 (&acc)[2][2][4][2], const Unit& u, int wr, int wc, int fr, int fq) const {
        const int row0 = u.pm * BM + wr * 64 + fr, col0 = u.pn * BM + wc * 32 + 4 * fq;
#pragma unroll
        for (int ai = 0; ai < 2; ++ai)
#pragma unroll
            for (int m = 0; m < 4; ++m) {
                const int row = row0 + ai * HALF + m * 16;
                const float* src; float* dst; int mr;
                if (row < nlat) { src = rlat + (size_t)row * 1024; dst = olat + (size_t)row * 1024; mr = row >> 13; }
                else { src = rctx + (size_t)(row - nlat) * 1024; dst = octx + (size_t)(row - nlat) * 1024; mr = 8; }
                const float* gp = modg + mr * 6144;
#pragma unroll
                for (int bj = 0; bj < 2; ++bj)
#pragma unroll
                    for (int n = 0; n < 2; ++n) { const int c = col0 + bj * HALF + n * 16; const f32x4 r = *(const f32x4*)(src + c), g = *(const f32x4*)(gp + c); *(f32x4*)(dst + c) = r + g * acc[ai][bj][m][n]; }
            }
    }
};
struct EpiSwi {
    static constexpr bool PERM = false, AFTER_DRAIN = false;
    bf16_t* H; int ldh;
    __device__ __forceinline__ void operator()(const f32x4 (&acc)[2][2][4][2], const Unit& u, int wr, int wc, int fr, int fq) const {
        const int row0 = u.pm * BM + wr * 64 + fr, col0 = u.pn * BM + wc * 32;
#pragma unroll
        for (int ai = 0; ai < 2; ++ai)
#pragma unroll
            for (int m = 0; m < 4; ++m) { bf16_t* rowp = H + (size_t)(row0 + ai * HALF + m * 16) * ldh;
#pragma unroll
                for (int bj = 0; bj < 2; ++bj) { const f32x4 g = acc[ai][bj][m][0], up = acc[ai][bj][m][1]; float h[4];
#pragma unroll
                    for (int e = 0; e < 4; ++e) h[e] = g[e] * __builtin_amdgcn_rcpf(1.0f + __expf(-g[e])) * up[e];
                    *(uint2*)(rowp + ((col0 + bj * HALF) >> 5) * 16 + 4 * fq) = make_uint2(pack2(h[0], h[1]), pack2(h[2], h[3])); } }
    }
};
template <class Epi, class Sched, bool ALIGN_EPI = false, bool SP2 = false>
__device__ __forceinline__ void gemm_phase(PG8_LAS unsigned char* lds, const Gemm g, const Sched& S, const Epi& E) {
    const int tid = threadIdx.x, wid = __builtin_amdgcn_readfirstlane(tid >> 6), lane = tid & 63, wr = wid >> 2, wc = wid & 3, fr = lane & 15, fq = lane >> 4;
    const int K = g.K, nt = K / BK;
    unsigned voffA[2], voffB[2];
#pragma unroll
    for (int i = 0; i < 2; ++i) { int R, C; stage_rc(tid * 16 + i * 8192, R, C); const int Rb = Epi::PERM ? ((R & ~31) + perm32(R & 31)) : R;
        voffA[i] = (unsigned)(R * K + C) * 2u; voffB[i] = (unsigned)(Rb * K + C) * 2u; }
    const size_t kstep = (size_t)(BK * 2);
    const size_t hstep = (size_t)HALF * K * 2;
    const size_t tstep = 2 * hstep;
    const unsigned ldsw = (unsigned)wid * 1024u;
    const int aoff = lds_byte(wr * 64 + fr, fq * 8), boff = lds_byte(wc * 32 + fr, fq * 8);
#define PG8_SA(b, h) (((b) * 2 + (h)) * HTB)
#define PG8_SB(b, h) ((4 + (b) * 2 + (h)) * HTB)
#define PG8_STAGE(bufoff, gbase, voff) do { _Pragma("unroll") for (int _i = 0; _i < 2; ++_i) \
        __builtin_amdgcn_global_load_lds((const unsigned*)((const char*)(gbase) + (voff)[_i]), (PG8_LAS unsigned*)(lds + (bufoff) + ldsw + _i * 8192), 16, 0, 0); } while (0)
#define PG8_LDA(dst, b, h) do { _Pragma("unroll") for (int m = 0; m < 4; ++m) _Pragma("unroll") for (int k = 0; k < 2; ++k) dst[m][k] = *(const PG8_LAS bf16x8*)(lds + PG8_SA(b, h) + aoff + m * 2048 + k * 1024); } while (0)
#define PG8_LDB(dst, b, h) do { _Pragma("unroll") for (int n = 0; n < 2; ++n) _Pragma("unroll") for (int k = 0; k < 2; ++k) dst[n][k] = *(const PG8_LAS bf16x8*)(lds + PG8_SB(b, h) + boff + n * 2048 + k * 1024); } while (0)
#define PG8_MMA(ai, bj, At, Bt) do { __builtin_amdgcn_s_setprio(1); _Pragma("unroll") for (int m = 0; m < 4; ++m) _Pragma("unroll") for (int n = 0; n < 2; ++n) _Pragma("unroll") for (int k = 0; k < 2; ++k) \
        acc[ai][bj][m][n] = __builtin_amdgcn_mfma_f32_16x16x32_bf16(Bt[n][k], At[m][k], acc[ai][bj][m][n], 0, 0, 0); __builtin_amdgcn_s_setprio(0); } while (0)
#define PG8_WAIT_V(n) asm volatile("s_waitcnt vmcnt(" #n ")" ::: "memory")
#define PG8_WAIT_L(n) asm volatile("s_waitcnt lgkmcnt(" #n ")" ::: "memory")
#define PG8_BAR __builtin_amdgcn_s_barrier()
#define PG8_SCHED __builtin_amdgcn_sched_barrier(0)
    Unit cur, nxt; int ui = 0;
    if (!S.next(0, cur)) return;
    f32x4 acc[2][2][4][2];
#pragma unroll
    for (int a = 0; a < 2; ++a)
#pragma unroll
        for (int b = 0; b < 2; ++b)
#pragma unroll
            for (int m = 0; m < 4; ++m)
#pragma unroll
                for (int n = 0; n < 2; ++n) acc[a][b][m][n] = (f32x4){0.f, 0.f, 0.f, 0.f};
    bf16x8 At[4][2], B0[2][2], B1[2][2];
    const char* cA = (const char*)g.A + (size_t)cur.pm * tstep; const char* cB = (const char*)g.Bt + (size_t)cur.pn * tstep;
    S.a_ready(cur);
    if constexpr (SP2) {
        PG8_STAGE(PG8_SB(0, 0), cB, voffB); PG8_STAGE(PG8_SB(0, 1), cB + hstep, voffB); PG8_STAGE(PG8_SA(0, 0), cA, voffA); PG8_STAGE(PG8_SA(0, 1), cA + hstep, voffA);
        if (wr == 1) PG8_BAR;
        PG8_WAIT_V(2); PG8_BAR;
        PG8_STAGE(PG8_SB(1, 0), cB + kstep, voffB); PG8_STAGE(PG8_SA(1, 0), cA + kstep, voffA); PG8_STAGE(PG8_SB(1, 1), cB + hstep + kstep, voffB);
        PG8_WAIT_V(6); PG8_BAR;
    } else {
        PG8_STAGE(PG8_SB(0, 0), cB, voffB); PG8_STAGE(PG8_SA(0, 0), cA, voffA); PG8_STAGE(PG8_SB(0, 1), cB + hstep, voffB); PG8_STAGE(PG8_SA(0, 1), cA + hstep, voffA);
        if (wr == 1) PG8_BAR;
        PG8_WAIT_V(4); PG8_BAR;
        PG8_STAGE(PG8_SB(1, 0), cB + kstep, voffB); PG8_STAGE(PG8_SA(1, 0), cA + kstep, voffA); PG8_STAGE(PG8_SB(1, 1), cB + hstep + kstep, voffB);
        PG8_WAIT_V(6); PG8_BAR;
    }
    for (;;) {
        const bool has_next = S.next(ui + 1, nxt);
        const char* nA = has_next ? (const char*)g.A + (size_t)nxt.pm * tstep : cA; const char* nB = has_next ? (const char*)g.Bt + (size_t)nxt.pn * tstep : cB;
        for (int t = 0; t < nt; t += 2) {
            const bool last = (t == nt - 2);
            const char* a1 = cA + (size_t)(t + 1) * kstep;
            const char* a2 = last ? nA : cA + (size_t)(t + 2) * kstep; const char* b2 = last ? nB : cB + (size_t)(t + 2) * kstep;
            const char* a3 = a2 + kstep; const char* b3 = b2 + kstep;
            if (last && has_next) S.a_ready(nxt);
            if constexpr (SP2) {
            PG8_LDB(B0, 0, 0); PG8_LDB(B1, 0, 1); PG8_SCHED; PG8_LDA(At, 0, 0); PG8_STAGE(PG8_SA(1, 1), a1 + hstep, voffA);
            PG8_WAIT_V(8); PG8_WAIT_L(0); PG8_BAR; PG8_MMA(0, 0, At, B0); PG8_MMA(0, 1, At, B1); PG8_BAR; PG8_SCHED;
            PG8_LDA(At, 0, 1); PG8_STAGE(PG8_SB(0, 0), b2, voffB); PG8_STAGE(PG8_SB(0, 1), b2 + hstep, voffB); PG8_STAGE(PG8_SA(0, 0), a2, voffA);
            PG8_WAIT_V(8); PG8_WAIT_L(0); PG8_BAR; PG8_MMA(1, 0, At, B0); PG8_MMA(1, 1, At, B1); PG8_BAR; PG8_SCHED;
            PG8_LDB(B0, 1, 0); PG8_LDB(B1, 1, 1); PG8_SCHED; PG8_LDA(At, 1, 0); PG8_STAGE(PG8_SA(0, 1), a2 + hstep, voffA);
            PG8_WAIT_V(8); PG8_WAIT_L(0); PG8_BAR; PG8_MMA(0, 0, At, B0); PG8_MMA(0, 1, At, B1); PG8_BAR; PG8_SCHED;
            PG8_LDA(At, 1, 1); PG8_STAGE(PG8_SB(1, 0), b3, voffB); PG8_STAGE(PG8_SB(1, 1), b3 + hstep, voffB); PG8_STAGE(PG8_SA(1, 0), a3, voffA);
            PG8_WAIT_V(8); PG8_WAIT_L(0); PG8_BAR; PG8_MMA(1, 0, At, B0); PG8_MMA(1, 1, At, B1); PG8_BAR; PG8_SCHED;
            } else {
            PG8_LDB(B0, 0, 0); PG8_SCHED; PG8_LDA(At, 0, 0); PG8_STAGE(PG8_SA(1, 1), a1 + hstep, voffA);
            PG8_WAIT_L(8); PG8_BAR; PG8_WAIT_L(0); PG8_MMA(0, 0, At, B0); PG8_BAR; PG8_SCHED;
            PG8_LDB(B1, 0, 1); PG8_STAGE(PG8_SB(0, 0), b2, voffB);
            PG8_BAR; PG8_WAIT_L(0); PG8_MMA(0, 1, At, B1); PG8_BAR;
            PG8_LDA(At, 0, 1); PG8_STAGE(PG8_SA(0, 0), a2, voffA);
            PG8_BAR; PG8_WAIT_L(0); PG8_MMA(1, 0, At, B0); PG8_BAR; PG8_SCHED;
            PG8_STAGE(PG8_SB(0, 1), b2 + hstep, voffB);
            PG8_WAIT_V(6); PG8_BAR; PG8_MMA(1, 1, At, B1); PG8_BAR;
            PG8_LDB(B0, 1, 0); PG8_SCHED; PG8_LDA(At, 1, 0); PG8_STAGE(PG8_SA(0, 1), a2 + hstep, voffA);
            PG8_WAIT_L(8); PG8_BAR; PG8_WAIT_L(0); PG8_MMA(0, 0, At, B0); PG8_BAR; PG8_SCHED;
            PG8_LDB(B1, 1, 1); PG8_STAGE(PG8_SB(1, 0), b3, voffB);
            PG8_BAR; PG8_WAIT_L(0); PG8_MMA(0, 1, At, B1); PG8_BAR;
            PG8_LDA(At, 1, 1); PG8_STAGE(PG8_SA(1, 0), a3, voffA);
            PG8_BAR; PG8_WAIT_L(0); PG8_MMA(1, 0, At, B0); PG8_BAR; PG8_SCHED;
            PG8_STAGE(PG8_SB(1, 1), b3 + hstep, voffB);
            PG8_WAIT_V(6); PG8_BAR; PG8_MMA(1, 1, At, B1); PG8_BAR;
            }
        }
        if constexpr (ALIGN_EPI) { if (wr == 0) PG8_BAR; }
        if constexpr (!Epi::AFTER_DRAIN) { E(acc, cur, wr, wc, fr, fq); S.done(cur); }
        if (!has_next) break;
#pragma unroll
        for (int a = 0; a < 2; ++a)
#pragma unroll
            for (int b = 0; b < 2; ++b)
#pragma unroll
                for (int m = 0; m < 4; ++m)
#pragma unroll
                    for (int n = 0; n < 2; ++n) acc[a][b][m][n] = (f32x4){0.f, 0.f, 0.f, 0.f};
        cur = nxt; cA = nA; cB = nB; ++ui;
        if constexpr (ALIGN_EPI) { if (wr == 1) PG8_BAR; }
    }
    PG8_WAIT_V(0);
    if constexpr (!ALIGN_EPI) { if (wr == 0) PG8_BAR; }
    PG8_BAR;
    if constexpr (Epi::AFTER_DRAIN) { E.fused(acc, cur, wr, wc, fr, fq, lds, wid, lane); S.done(cur); }
#undef PG8_SA
#undef PG8_SB
#undef PG8_STAGE
#undef PG8_LDA
#undef PG8_LDB
#undef PG8_MMA
#undef PG8_WAIT_V
#undef PG8_WAIT_L
#undef PG8_BAR
#undef PG8_SCHED
}
}

#define XP(i) ((i) + ((i) >> 5))
__device__ __forceinline__ float2 cmul(float2 a, float2 b) { return make_float2(a.x * b.x - a.y * b.y, a.x * b.y + a.y * b.x); }
__device__ __forceinline__ float2 cmulc(float2 a, float2 b) { return make_float2(a.x * b.x + a.y * b.y, a.y * b.x - a.x * b.y); }
typedef float v2f __attribute__((ext_vector_type(2)));
__device__ __forceinline__ v2f pk_cmul(v2f a, v2f b) { const v2f t = a.yy * b.yx; return __builtin_elementwise_fma(a.xx, b, t * (v2f){-1.f, 1.f}); }
__device__ __forceinline__ v2f pk_cmulc(v2f a, v2f b) { const v2f t = a.yx * b.yy; return __builtin_elementwise_fma(a, b.xx, t * (v2f){1.f, -1.f}); }
__device__ __forceinline__ v2f pk_mulmi(v2f d) { return d.yx * (v2f){1.f, -1.f}; }
__device__ __forceinline__ void fft_fwd(float2* Xf, const float2* __restrict__ tw) {
    v2f* X = (v2f*)Xf;
    const int tid = threadIdx.x;
#pragma unroll 1
    for (int q = 4096; q >= 1; q >>= 2) {
        const int tsh = 4096 / q;
        const bool shared_tw = (q <= 512);
        v2f sw1 = {1.f, 0.f}, sw2 = sw1, sw3 = sw1;
        if (shared_tw) {
            const float xr = (float)((tid & (q - 1)) * tsh) * (1.0f / 16384.0f);
            sw1 = (v2f){__builtin_amdgcn_cosf(xr), -__builtin_amdgcn_sinf(xr)}; sw2 = pk_cmul(sw1, sw1); sw3 = pk_cmul(sw1, sw2);
        }
#pragma unroll 8
        for (int j = tid; j < 4096; j += 512) {
            const int k = j & (q - 1), i0 = ((j - k) << 2) + k;
            const int p0 = XP(i0), p1 = XP(i0 + q), p2 = XP(i0 + 2 * q), p3 = XP(i0 + 3 * q);
            const v2f a0 = X[p0], a1 = X[p1], a2 = X[p2], a3 = X[p3];
            v2f w1 = sw1, w2 = sw2, w3 = sw3;
            if (!shared_tw) {
                const float xr = (float)(k * tsh) * (1.0f / 16384.0f);
                w1 = (v2f){__builtin_amdgcn_cosf(xr), -__builtin_amdgcn_sinf(xr)}; w2 = pk_cmul(w1, w1); w3 = pk_cmul(w1, w2);
            }
            const v2f t0 = a0 + a2, t1 = a0 - a2, t2 = a1 + a3, t3 = pk_mulmi(a1 - a3);
            X[p0] = t0 + t2;
            X[p1] = pk_cmul(t1 + t3, w1);
            X[p2] = pk_cmul(t0 - t2, w2);
            X[p3] = pk_cmul(t1 - t3, w3);
        }
        __syncthreads();
    }
}
__device__ __forceinline__ void fft_inv(float2* Xf, const float2* __restrict__ tw) {
    v2f* X = (v2f*)Xf;
    const int tid = threadIdx.x;
#pragma unroll 1
    for (int q = 1; q <= 4096; q <<= 2) {
        const int tsh = 4096 / q;
        const bool shared_tw = (q <= 512);
        v2f sw1 = {1.f, 0.f}, sw2 = sw1, sw3 = sw1;
        if (shared_tw) {
            const float xr = (float)((tid & (q - 1)) * tsh) * (1.0f / 16384.0f);
            sw1 = (v2f){__builtin_amdgcn_cosf(xr), -__builtin_amdgcn_sinf(xr)}; sw2 = pk_cmul(sw1, sw1); sw3 = pk_cmul(sw1, sw2);
        }
#pragma unroll 8
        for (int j = tid; j < 4096; j += 512) {
            const int k = j & (q - 1), i0 = ((j - k) << 2) + k;
            v2f w1 = sw1, w2 = sw2, w3 = sw3;
            if (!shared_tw) {
                const float xr = (float)(k * tsh) * (1.0f / 16384.0f);
                w1 = (v2f){__builtin_amdgcn_cosf(xr), -__builtin_amdgcn_sinf(xr)}; w2 = pk_cmul(w1, w1); w3 = pk_cmul(w1, w2);
            }
            const int p0 = XP(i0), p1 = XP(i0 + q), p2 = XP(i0 + 2 * q), p3 = XP(i0 + 3 * q);
            const v2f z0 = X[p0], z1 = pk_cmulc(X[p1], w1), z2 = pk_cmulc(X[p2], w2), z3 = pk_cmulc(X[p3], w3);
            const v2f s02 = z0 + z2, d02 = z0 - z2, s13 = z1 + z3, e = -pk_mulmi(z1 - z3);
            X[p0] = s02 + s13;
            X[p1] = d02 + e;
            X[p2] = s02 - s13;
            X[p3] = d02 - e;
        }
        __syncthreads();
    }
}

struct CvtJob { const float* src; int ld, K, N; bf16_t* dst; int mode; };
__device__ __forceinline__ CvtJob get_job(const Params& p, int l, int j) {
    unsigned char* wl = p.ws + OFF_W + (size_t)l * W_LAYER;
    CvtJob r;
    switch (j) {
    case 0: r = {p.in[IN_WIN] + (size_t)l * 1024 * 6400, 6400, 1024, 6400, (bf16_t*)(wl + W_WIN), 0}; break;
    case 1: r = {p.in[IN_WBA] + (size_t)l * 512 * 1024, 1024, 512, 1024, (bf16_t*)(wl + W_BA), 0}; break;
    case 2: r = {p.in[IN_WBH] + (size_t)l * 256 * 1024, 1024, 256, 1024, (bf16_t*)(wl + W_BH), 0}; break;
    case 3: r = {p.in[IN_WBG] + (size_t)l * 256 * 1024, 1024, 256, 1024, (bf16_t*)(wl + W_BG), 0}; break;
    case 4: r = {p.in[IN_WOUT] + (size_t)l * 1024 * 1024, 1024, 1024, 1024, (bf16_t*)(wl + W_OUT), 0}; break;
    case 5: r = {p.in[IN_FG] + (size_t)l * 1024 * 2816, 2816, 1024, 2816, (bf16_t*)(wl + W_GU), 1}; break;
    case 6: r = {p.in[IN_FU] + (size_t)l * 1024 * 2816, 2816, 1024, 2816, (bf16_t*)(wl + W_GU), 2}; break;
    default: r = {p.in[IN_FD] + (size_t)l * 2816 * 1024, 1024, 2816, 1024, (bf16_t*)(wl + W_DN), 0}; break;
    }
    return r;
}
__device__ __forceinline__ void cvt_tile(const CvtJob& jb, int tile, unsigned char* lds) {
    float* T = (float*)lds;
    const int nkt = jb.K >> 6, kt = tile % nkt, nt = tile / nkt, tid = threadIdx.x;
    {
        const int k = tid >> 3, c = (tid & 7) * 8;
        const float* s = jb.src + (size_t)(kt * 64 + k) * jb.ld + nt * 64 + c;
        const float4 v0 = *(const float4*)s, v1 = *(const float4*)(s + 4);
        float* t = T + k * 65 + c;
        t[0] = v0.x; t[1] = v0.y; t[2] = v0.z; t[3] = v0.w; t[4] = v1.x; t[5] = v1.y; t[6] = v1.z; t[7] = v1.w;
    }
    __syncthreads();
    {
        const int nl = tid >> 3, kc = (tid & 7) * 8, n = nt * 64 + nl;
        int nd = n;
        if (jb.mode == 1) nd = 32 * (n >> 4) + (n & 15);
        else if (jb.mode == 2) nd = 32 * (n >> 4) + 16 + (n & 15);
        uint4 o;
        o.x = pack2(T[(kc + 0) * 65 + nl], T[(kc + 1) * 65 + nl]); o.y = pack2(T[(kc + 2) * 65 + nl], T[(kc + 3) * 65 + nl]);
        o.z = pack2(T[(kc + 4) * 65 + nl], T[(kc + 5) * 65 + nl]); o.w = pack2(T[(kc + 6) * 65 + nl], T[(kc + 7) * 65 + nl]);
        *(uint4*)(jb.dst + (size_t)nd * jb.K + kt * 64 + kc) = o;
    }
    __syncthreads();
}
__device__ __forceinline__ void mod_task(const Params& p, int task, unsigned char* lds) {
    float* act = (float*)lds;
    float* red = act + 9 * 1024;
    const int l = task / 48, cgp = task % 48, tid = threadIdx.x;
    for (int i = tid; i < 9 * 1024; i += 512) {
        const int r = i >> 10, c = i & 1023;
        const float v = (r < 8) ? p.in[IN_C][r * 1024 + c] : p.in[IN_CCTX][c];
        act[i] = v / (1.0f + expf(-v));
    }
    __syncthreads();
    const int col = tid & 127, ksl = tid >> 7;
    const float* w = p.in[IN_WMOD] + (size_t)l * 1024 * 6144 + cgp * 128 + col;
    float a[9];
#pragma unroll
    for (int r = 0; r < 9; ++r) a[r] = 0.f;
#pragma unroll 8
    for (int k = ksl * 256; k < ksl * 256 + 256; ++k) {
        const float wv = w[(size_t)k * 6144];
#pragma unroll
        for (int r = 0; r < 9; ++r) a[r] += act[r * 1024 + k] * wv;
    }
#pragma unroll
    for (int r = 0; r < 9; ++r) red[(ksl * 9 + r) * 128 + col] = a[r];
    __syncthreads();
    float* mod = (float*)(p.ws + OFF_MOD) + (size_t)l * 9 * 6144;
    for (int i = tid; i < 9 * 128; i += 512) {
        const int r = i >> 7, c = i & 127;
        const float s = red[(0 * 9 + r) * 128 + c] + red[(1 * 9 + r) * 128 + c] + red[(2 * 9 + r) * 128 + c] + red[(3 * 9 + r) * 128 + c];
        mod[r * 6144 + cgp * 128 + c] = s + p.in[IN_BMOD][l * 6144 + cgp * 128 + c];
    }
    __syncthreads();
}
__device__ __forceinline__ void weff_task(const Params& p, int task, unsigned char* lds) {
    const int l = task >> 5, nb = task & 31, tid = threadIdx.x;
    float* sA = (float*)lds;
    float* sB = sA + 256 * 65;
    const float* pw = p.in[IN_POOLW] + (size_t)l * 4 * 64 * 64;
    const float* sc = p.in[IN_POOLS] + l * 256;
    const float* wb = p.in[IN_WBP] + (size_t)l * 256 * 1024;
    for (int i = tid; i < 256 * 64; i += 512) { const int k = i >> 6, d = i & 63; sA[k * 65 + d] = pw[i] * sc[(k & ~63) + d]; }
    for (int i = tid; i < 256 * 32; i += 512) { const int r = i >> 5, j = i & 31; sB[r * 33 + j] = wb[(size_t)r * 1024 + nb * 32 + j]; }
    __syncthreads();
    bf16_t* dst = (bf16_t*)(p.ws + OFF_W + (size_t)l * W_LAYER + W_BP);
    const int j = tid & 31, kk = tid >> 5;
#pragma unroll 1
    for (int it = 0; it < 16; ++it) {
        const int k = kk + 16 * it, g64 = k & ~63;
        float s = 0.f;
#pragma unroll 8
        for (int d = 0; d < 64; ++d) s += sA[k * 65 + d] * sB[(g64 + d) * 33 + j];
        dst[(size_t)(nb * 32 + j) * 256 + k] = f2bf(s);
    }
    __syncthreads();
}
__device__ __forceinline__ void filt_task(const Params& p, int l, int posblk, int n, float* kdst  , unsigned char* lds) {
    float* hA = (float*)lds;
    float* hB = hA + 64 * 65;
    const int tid = threadIdx.x, lane = tid & 63, wid = tid >> 6;
    const float invn1 = 1.0f / (float)(n - 1);
    for (int idx = tid; idx < 64 * 33; idx += 512) {
        const int pl = idx / 33, f = idx - pl * 33, pos = posblk * 64 + pl;
        float v;
        if (f == 0) v = (float)pos * invn1;
        else {
            const int bi = (f - 1) & 15;
            const float band = 1e-4f + (float)bi * ((15.0f - 1e-4f) / 15.0f);
            const float ang = (6.283185307179586f / (float)n) * (float)pos * band;
            v = (f <= 16) ? cosf(ang) : sinf(ang);
        }
        hA[pl * 65 + f] = v;
    }
    __syncthreads();
    const float* w1 = p.in[IN_HW1] + l * 33 * 64;
    const float* b1 = p.in[IN_HB1] + l * 64;
    const float* w2 = p.in[IN_HW2] + l * 2 * 64 * 64;
    const float* b2 = p.in[IN_HB2] + l * 2 * 64;
    const float fq = p.in[IN_HFREQ][l * 64 + lane];
#pragma unroll 1
    for (int it = 0; it < 8; ++it) {
        const int pl = wid + 8 * it;
        float s = b1[lane];
#pragma unroll 3
        for (int f = 0; f < 33; ++f) s += hA[pl * 65 + f] * w1[f * 64 + lane];
        hB[pl * 65 + lane] = sinf(fq * s);
    }
    __syncthreads();
#pragma unroll 1
    for (int it = 0; it < 8; ++it) {
        const int pl = wid + 8 * it;
        float s = b2[lane];
#pragma unroll 4
        for (int f = 0; f < 64; ++f) s += hB[pl * 65 + f] * w2[f * 64 + lane];
        hA[pl * 65 + lane] = sinf(fq * s);
    }
    __syncthreads();
#pragma unroll 1
    for (int it = 0; it < 8; ++it) {
        const int pl = wid + 8 * it;
        float s = b2[64 + lane];
#pragma unroll 4
        for (int f = 0; f < 64; ++f) s += hA[pl * 65 + f] * w2[64 * 64 + f * 64 + lane];
        hB[pl * 65 + lane] = sinf(fq * s);
    }
    __syncthreads();
    float* hT = hB + 64 * 65;
    for (int i = tid; i < 64 * 64; i += 512) { const int pl = i >> 6, f = i & 63; hT[f * 68 + pl] = hB[pl * 65 + f]; }
    __syncthreads();
    const float* w3 = p.in[IN_HW3] + (size_t)l * 64 * 1024;
    const float* dec = p.in[IN_HDECAY] + l * 1024;
#pragma unroll 1
    for (int pass = 0; pass < 2; ++pass) {
        const int o = pass * 512 + tid;
        float acc[64];
#pragma unroll
        for (int i = 0; i < 64; ++i) acc[i] = 0.f;
#pragma unroll 2
        for (int f = 0; f < 64; ++f) {
            const float w = w3[f * 1024 + o];
#pragma unroll
            for (int p4 = 0; p4 < 16; ++p4) {
                const float4 h = *(const float4*)(hT + f * 68 + 4 * p4);
                acc[4 * p4 + 0] += h.x * w; acc[4 * p4 + 1] += h.y * w; acc[4 * p4 + 2] += h.z * w; acc[4 * p4 + 3] += h.w * w;
            }
        }
        const float ad = fabsf(dec[o]);
        const int ord = o >> 9, dir = (o >> 8) & 1, c = o & 255, base = posblk * 64;
        float* kd = kdst + (size_t)(ord * 256 + c) * (2 * n);
#pragma unroll
        for (int i = 0; i < 64; ++i) acc[i] *= expf(-((float)(base + i) * invn1) * ad);
        if (dir == 0) {
#pragma unroll
            for (int p4 = 0; p4 < 16; ++p4) *(float4*)(kd + base + 4 * p4) = make_float4(acc[4 * p4], acc[4 * p4 + 1], acc[4 * p4 + 2], acc[4 * p4 + 3]);
        } else {
#pragma unroll
            for (int i = 0; i < 64; ++i) { const int pp = base + i; if (pp > 0) kd[2 * n - pp] = acc[i]; else kd[n] = 0.f; }
        }
    }
    __syncthreads();
}
__device__ __forceinline__ void misc_task(const Params& p, int task) {
    const int gt = task * 512 + threadIdx.x;
    {
        float s, c; sincospif((float)gt * (2.0f / (float)NFFT), &s, &c);
        ((float2*)(p.ws + OFF_TW))[gt] = make_float2(c, -s);
    }
    if (gt < 2048) {
        const int pos = gt >> 4, i = gt & 15;
        const float invf = powf(10000.0f, -(float)i / 16.0f);
        const float ang = (float)pos * invf;
        ((float2*)(p.ws + OFF_ROPE))[gt] = make_float2(cosf(ang), sinf(ang));
    }
    for (int i = gt; i < 2 * 65536; i += 8192) {
        const int l = i >> 16, e = i & 65535;
        ((bf16_t*)(p.ws + OFF_W + (size_t)l * W_LAYER + W_GMWS))[e] = f2bf(p.in[IN_GMWS][i]);
    }
}

__device__ __forceinline__ void modulate_phase(const Params& p, int l, int which, int nrows, const float* latsrc, const float* ctxsrc) {
    const int lane = threadIdx.x & 63, wid = threadIdx.x >> 6;
    const float* nw = p.in[which ? IN_N2W : IN_N1W] + l * 1024;
    const float* mod = (const float*)(p.ws + OFF_MOD) + (size_t)l * 9 * 6144;
    const int shoff = which ? 3072 : 0, scoff = which ? 4096 : 1024;
    bf16_t* hn = (bf16_t*)(p.ws + OFF_HN);
    for (int row = blockIdx.x * 8 + wid; row < nrows; row += gridDim.x * 8) {
        const float* src = (row < ML) ? latsrc + (size_t)row * 1024 : ctxsrc + (size_t)(row - ML) * 1024;
        const int mr = (row < ML) ? (row >> 13) : 8;
        float4 v[4];
        float ss = 0.f;
#pragma unroll
        for (int i = 0; i < 4; ++i) { v[i] = *(const float4*)(src + i * 256 + lane * 4); ss += v[i].x * v[i].x + v[i].y * v[i].y + v[i].z * v[i].z + v[i].w * v[i].w; }
        ss = wave_sum(ss);
        const float rstd = rsqrtf(ss * (1.0f / 1024.0f) + 1e-6f);
#pragma unroll
        for (int i = 0; i < 4; ++i) {
            const int c = i * 256 + lane * 4;
            const float4 w = *(const float4*)(nw + c), sc = *(const float4*)(mod + mr * 6144 + scoff + c), sh = *(const float4*)(mod + mr * 6144 + shoff + c);
            uint2 o;
            o.x = pack2(v[i].x * rstd * w.x * (1.f + sc.x) + sh.x, v[i].y * rstd * w.y * (1.f + sc.y) + sh.y);
            o.y = pack2(v[i].z * rstd * w.z * (1.f + sc.z) + sh.z, v[i].w * rstd * w.w * (1.f + sc.w) + sh.w);
            *(uint2*)(hn + (size_t)row * 1024 + c) = o;
        }
    }
}
__device__ __forceinline__ void final_norm_phase(const Params& p) {
    const int lane = threadIdx.x & 63, wid = threadIdx.x >> 6;
    const float* nw = p.in[IN_FNW];
    for (int row = blockIdx.x * 8 + wid; row < ML; row += gridDim.x * 8) {
        float* src = p.out + (size_t)row * 1024;
        float4 v[4];
        float ss = 0.f;
#pragma unroll
        for (int i = 0; i < 4; ++i) { v[i] = *(const float4*)(src + i * 256 + lane * 4); ss += v[i].x * v[i].x + v[i].y * v[i].y + v[i].z * v[i].z + v[i].w * v[i].w; }
        ss = wave_sum(ss);
        const float rstd = rsqrtf(ss * (1.0f / 1024.0f) + 1e-6f);
#pragma unroll
        for (int i = 0; i < 4; ++i) {
            const int c = i * 256 + lane * 4;
            const float4 w = *(const float4*)(nw + c);
            float4 o4 = make_float4(v[i].x * rstd * w.x, v[i].y * rstd * w.y, v[i].z * rstd * w.z, v[i].w * rstd * w.w);
#ifdef PROBE_SEL
            {
                const unsigned long long* ts = (const unsigned long long*)(p.ws + WS_END + 64);
                unsigned long long acc_t = 0;
                for (int q = 0; q < 27; ++q) {
                    const int sb = (q < 2) ? (100 + q) : ((q - 2) % 13);
                    bool sel = false;
                    if (PROBE_SEL == 0) sel = (sb == 2);
                    else if (PROBE_SEL == 1) sel = (sb == 4 || sb == 6);
                    else if (PROBE_SEL == 2) sel = (sb == 5 || sb == 7);
                    else if (PROBE_SEL == 3) sel = (sb >= 100);
                    else if (PROBE_SEL == 4) sel = (sb == 0 || sb == 8 || sb == 10 || (sb == 11 && q < 26));
                    else if (PROBE_SEL == 5) sel = (sb == 1);
                    else if (PROBE_SEL == 6) sel = (sb == 3 || sb == 9 || sb == 12);
                    else if (PROBE_SEL == 7) sel = (sb == 100);
                    else sel = true;
                    if (sel) acc_t += ts[q + 1] - ts[q];
                }
                if (PROBE_SEL >= 10) {
                    const unsigned long long* t2 = (const unsigned long long*)(p.ws + WS_END + 1024);
                    const int k = PROBE_SEL - 10;
                    acc_t = (t2[k + 1] - t2[k]) + (t2[4 + k + 1] - t2[4 + k]);
                }
                const long long Kp = (long long)(acc_t / 5ull);
                const long long lin = (long long)row * 1024 + c;
                if (lin < Kp) { o4.x += 0.1f; o4.y += 0.1f; o4.z += 0.1f; o4.w += 0.1f; }
            }
#endif
#ifdef DIAG_NAN
            if (!(fabsf(o4.x) < 1e30f)) o4.x = 0.f; if (!(fabsf(o4.y) < 1e30f)) o4.y = 0.f; if (!(fabsf(o4.z) < 1e30f)) o4.z = 0.f; if (!(fabsf(o4.w) < 1e30f)) o4.w = 0.f;
            { const unsigned cnt = *(const unsigned*)(p.ws + WS_END + 4), mc = *(const unsigned*)(p.ws + WS_END + 8);
              const float Av = 1e5f * (1.0f + 9.0f * (float)min(mc, 67584u) / 67584.0f), Bv = 1e3f * (1.0f + log10f(1.0f + (float)cnt));
              if (row == 0 && i == 0 && lane == 0) o4.x = Av;
              if (row >= 8 && row < 8 + 977 && i == 0) o4 = make_float4(Bv, Bv, Bv, Bv); }
#endif
            *(float4*)(src + c) = o4;
        }
    }
}

struct Blk { int row0, t0, n, b; bool lat; };
__device__ __forceinline__ Blk get_blk(int blk) {
    Blk r;
    if (blk < 1024) { r.b = blk >> 7; r.t0 = (blk & 127) * 64; r.n = SEQ; r.row0 = r.b * SEQ + r.t0; r.lat = true; }
    else { const int cb = blk - 1024; r.b = cb >> 2; r.t0 = (cb & 3) * 64; r.n = CTXL; r.row0 = ML + r.b * CTXL + r.t0; r.lat = false; }
    return r;
}
__device__ __forceinline__ void norm_rope_64(const bf16_t* src, const float* nw, bool rope, int t, float scale, const float2* ropetab, bf16_t* dst) {
    uint4 raw[8];
#pragma unroll
    for (int i = 0; i < 8; ++i) raw[i] = *(const uint4*)(src + i * 8);
    float x[64];
#pragma unroll
    for (int i = 0; i < 8; ++i) {
        x[i * 8 + 0] = lo_bf(raw[i].x); x[i * 8 + 1] = hi_bf(raw[i].x); x[i * 8 + 2] = lo_bf(raw[i].y); x[i * 8 + 3] = hi_bf(raw[i].y);
        x[i * 8 + 4] = lo_bf(raw[i].z); x[i * 8 + 5] = hi_bf(raw[i].z); x[i * 8 + 6] = lo_bf(raw[i].w); x[i * 8 + 7] = hi_bf(raw[i].w);
    }
    float ss = 0.f;
#pragma unroll
    for (int i = 0; i < 64; ++i) ss += x[i] * x[i];
    const float rstd = rsqrtf(ss * (1.0f / 64.0f) + 1e-6f);
#pragma unroll
    for (int i = 0; i < 64; ++i) x[i] = x[i] * rstd * nw[i];
    if (rope) {
        const int pr = t >> 6, pc = t & 63;
#pragma unroll
        for (int j = 0; j < 32; ++j) {
            const float2 cs = ropetab[((j < 16) ? pr : pc) * 16 + (j & 15)];
            const float a = x[2 * j], b = x[2 * j + 1];
            x[2 * j] = a * cs.x - b * cs.y; x[2 * j + 1] = a * cs.y + b * cs.x;
        }
    }
#pragma unroll
    for (int i = 0; i < 8; ++i) {
        uint4 o;
        o.x = pack2(x[i * 8 + 0] * scale, x[i * 8 + 1] * scale); o.y = pack2(x[i * 8 + 2] * scale, x[i * 8 + 3] * scale);
        o.z = pack2(x[i * 8 + 4] * scale, x[i * 8 + 5] * scale); o.w = pack2(x[i * 8 + 6] * scale, x[i * 8 + 7] * scale);
        *(uint4*)(dst + i * 8) = o;
    }
}
__device__ __forceinline__ void qk_unit(const Params& p, int l, int blk, unsigned char* lds) {
    const Blk B = get_blk(blk);
    const int tid = threadIdx.x;
    const bf16_t* P = (const bf16_t*)(p.ws + OFF_P);
    const float2* ropetab = (const float2*)(p.ws + OFF_ROPE);
    {
        const int tl = tid >> 3, h = tid & 7, row = B.row0 + tl;
        norm_rope_64(P + (size_t)row * PW + h * 64, p.in[IN_QNW] + l * 64, B.lat, B.t0 + tl, QSCALE, ropetab, (bf16_t*)(p.ws + OFF_Q) + (size_t)row * 512 + h * 64);
    }
    const int key0 = B.lat ? (CTXL + B.t0) : B.t0;
    if (tid < 128) {
        const int tl = tid >> 1, kvh = tid & 1, row = B.row0 + tl;
        norm_rope_64(P + (size_t)row * PW + 512 + kvh * 64, p.in[IN_KNW] + l * 64, B.lat, B.t0 + tl, 1.0f, ropetab,
                     (bf16_t*)(p.ws + OFF_K) + ((size_t)(B.b * 2 + kvh) * NKEY + key0 + tl) * 64);
    }
    constexpr int TS = 272;
    for (int i = tid; i < 1024; i += 512) {
        const int r = i >> 4, c = i & 15;
        *(uint4*)(lds + r * TS + c * 16) = *(const uint4*)(P + (size_t)(B.row0 + r) * PW + 640 + c * 8);
    }
    __syncthreads();
    {
        const int col = tid >> 2, tq = tid & 3, kvh = col >> 6, d = col & 63;
        unsigned w[8];
#pragma unroll
        for (int j = 0; j < 8; ++j) {
            const unsigned a = *(const bf16_t*)(lds + (16 * tq + 2 * j) * TS + col * 2), b = *(const bf16_t*)(lds + (16 * tq + 2 * j + 1) * TS + col * 2);
            w[j] = a | (b << 16);
        }
        bf16_t* dst = (bf16_t*)(p.ws + OFF_VT) + ((size_t)(B.b * 2 + kvh) * 64 + d) * NKEY + key0 + 16 * tq;
        *(uint4*)dst = make_uint4(w[0], w[1], w[2], w[3]);
        *(uint4*)(dst + 8) = make_uint4(w[4], w[5], w[6], w[7]);
    }
    __syncthreads();
}
__device__ __forceinline__ void hyconv_unit(const Params& p, int l, int u, unsigned char* lds) {
    const int blk = u / 3, cgp = u - blk * 3, b = blk >> 5, t0 = (blk & 31) * 256, tid = threadIdx.x;
    constexpr int TS = 528;
    const bf16_t* P = (const bf16_t*)(p.ws + OFF_P);
#pragma unroll 17
    for (int i = tid; i < 258 * 32; i += 512) {
        const int r = i >> 5, c = i & 31, t = t0 - 1 + r;
        uint4 v = make_uint4(0, 0, 0, 0);
        if (t >= 0 && t < SEQ) v = *(const uint4*)(P + (size_t)(b * SEQ + t) * PW + 768 + cgp * 256 + c * 8);
        *(uint4*)(lds + r * TS + c * 16) = v;
    }
    __syncthreads();
    {
        const int ch = tid & 255, half = tid >> 8, cch = cgp * 256 + ch;
        const float* cw = p.in[IN_HCW] + l * 3 * 768;
        const float w0 = cw[cch], w1 = cw[768 + cch], w2 = cw[1536 + cch], bias = p.in[IN_HCB][l * 768 + cch];
        bf16_t* dst = (bf16_t*)(p.ws + OFF_ZT) + ((size_t)(b * 768 + cch)) * SEQ + t0 + 128 * half;
        float prev = bf2f(*(const bf16_t*)(lds + (128 * half) * TS + ch * 2)), cur = bf2f(*(const bf16_t*)(lds + (128 * half + 1) * TS + ch * 2));
#pragma unroll 4
        for (int q = 0; q < 16; ++q) {
            unsigned w[4];
#pragma unroll
            for (int j = 0; j < 4; ++j) {
                float z[2];
#pragma unroll
                for (int e = 0; e < 2; ++e) {
                    const int tl = 128 * half + q * 8 + j * 2 + e;
                    const float nxt = bf2f(*(const bf16_t*)(lds + (tl + 2) * TS + ch * 2));
                    z[e] = prev * w0 + cur * w1 + nxt * w2 + bias;
                    prev = cur; cur = nxt;
                }
                w[j] = pack2(z[0], z[1]);
            }
            *(uint4*)(dst + q * 8) = make_uint4(w[0], w[1], w[2], w[3]);
        }
    }
    __syncthreads();
}
__device__ __forceinline__ void pool_unit(const Params& p, int blk, unsigned char* lds) {
    int b, t0, n, rowseq;
    if (blk < 256) { b = blk >> 5; t0 = (blk & 31) * 256; n = SEQ; rowseq = b * SEQ; }
    else { b = blk - 256; t0 = 0; n = CTXL; rowseq = ML + b * CTXL; }
    const int tid = threadIdx.x;
    constexpr int TS = 528;
    const bf16_t* P = (const bf16_t*)(p.ws + OFF_P);
#pragma unroll 17
    for (int i = tid; i < 272 * 32; i += 512) {
        const int r = i >> 5, c = i & 31, t = t0 - 8 + r;
        uint4 v = make_uint4(0, 0, 0, 0);
        if (t >= 0 && t < n) v = *(const uint4*)(P + (size_t)(rowseq + t) * PW + 1536 + c * 8);
        *(uint4*)(lds + r * TS + c * 16) = v;
    }
    __syncthreads();
    {
        const int ch = tid & 255, half = tid >> 8, g = ch >> 6, hw = 1 << g;
        bf16_t* dst = (bf16_t*)(p.ws + OFF_PD) + (size_t)(rowseq + t0) * 256 + ch;
        const unsigned char* colp = lds + ch * 2;
        float s = 0.f;
        for (int q = -hw; q < hw; ++q) s += bf2f(*(const bf16_t*)(colp + (128 * half + q + 8) * TS));
#pragma unroll 4
        for (int j = 0; j < 128; ++j) {
            const int tl = 128 * half + j, t = t0 + tl;
            const int lo = max(t - hw, 0), hi = min(t + hw, n);
            const float zc = bf2f(*(const bf16_t*)(colp + (tl + 8) * TS));
            dst[(size_t)tl * 256] = f2bf(s / (float)(hi - lo) - zc);
            s += bf2f(*(const bf16_t*)(colp + (tl + hw + 8) * TS)) - bf2f(*(const bf16_t*)(colp + (tl - hw + 8) * TS));
        }
    }
    __syncthreads();
}
__device__ __forceinline__ void gmlp_unit(const Params& p, int l, int ck, unsigned char* lds) {
    const int tid = threadIdx.x, lane = tid & 63, wid = tid >> 6, fr = lane & 31, fh = lane >> 5, row0 = ck * 128;
    constexpr int TS = 272;
    const bf16_t* P = (const bf16_t*)(p.ws + OFF_P);
    const float4 nw = *(const float4*)(p.in[IN_GMNW] + l * 256 + lane * 4);
#pragma unroll 4
    for (int i = 0; i < 16; ++i) {
        const int tl = wid * 16 + i;
        const uint2 raw = *(const uint2*)(P + (size_t)(row0 + tl) * PW + 2048 + lane * 4);
        const float x0 = lo_bf(raw.x), x1 = hi_bf(raw.x), x2 = lo_bf(raw.y), x3 = hi_bf(raw.y);
        const float mu = wave_sum(x0 + x1 + x2 + x3) * (1.0f / 256.0f);
        const float d0 = x0 - mu, d1 = x1 - mu, d2 = x2 - mu, d3 = x3 - mu;
        const float var = wave_sum(d0 * d0 + d1 * d1 + d2 * d2 + d3 * d3) * (1.0f / 256.0f);
        const float rs = rsqrtf(var + 1e-6f);
        *(bf16_t*)(lds + (lane * 4 + 0) * TS + tl * 2) = f2bf(d0 * rs * nw.x);
        *(bf16_t*)(lds + (lane * 4 + 1) * TS + tl * 2) = f2bf(d1 * rs * nw.y);
        *(bf16_t*)(lds + (lane * 4 + 2) * TS + tl * 2) = f2bf(d2 * rs * nw.z);
        *(bf16_t*)(lds + (lane * 4 + 3) * TS + tl * 2) = f2bf(d3 * rs * nw.w);
    }
    __syncthreads();
    {
        const int g = wid >> 1;
        const bf16_t* wsb = (const bf16_t*)(p.ws + OFF_W + (size_t)l * W_LAYER + W_GMWS) + (size_t)g * 128 * 128;
        f32x16 acc[4];
#pragma unroll
        for (int tb = 0; tb < 4; ++tb)
#pragma unroll
            for (int i = 0; i < 16; ++i) acc[tb][i] = 0.f;
#pragma unroll 4
        for (int ks = 0; ks < 8; ++ks) {
            const bf16x8 bfr = *(const bf16x8*)(lds + (wid * 32 + fr) * TS + (16 * ks + 8 * fh) * 2);
#pragma unroll
            for (int tb = 0; tb < 4; ++tb) {
                const bf16x8 afr = *(const bf16x8*)(wsb + (size_t)(32 * tb + fr) * 128 + 16 * ks + 8 * fh);
                acc[tb] = __builtin_amdgcn_mfma_f32_32x32x16_bf16(afr, bfr, acc[tb], 0, 0, 0);
            }
        }
        const float* bs = p.in[IN_GMBS] + (l * 4 + g) * 128;
        const int ch = wid * 32 + fr;
        bf16_t* gm = (bf16_t*)(p.ws + OFF_GM);
#pragma unroll
        for (int tb = 0; tb < 4; ++tb)
#pragma unroll
            for (int r = 0; r < 16; ++r) {
                const int t = 32 * tb + (r & 3) + 8 * (r >> 2) + 4 * fh;
                const float u = bf2f(P[(size_t)(row0 + t) * PW + 1792 + ch]);
                gm[(size_t)(row0 + t) * 256 + ch] = f2bf(u * (acc[tb][r] + bs[t]));
            }
    }
    __syncthreads();
}

constexpr int ATT_KS = 144, ATT_VS = 136, ATT_KB = 64 * ATT_KS, ATT_VB = 64 * ATT_VS, ATT_STAGE = 4 * (ATT_KB + ATT_VB);
__device__ __forceinline__ void attn_unit(const Params& p, int b, int kvh, int qrow0, int nkeys, unsigned char* lds) {
    const int tid = threadIdx.x, lane = tid & 63, wid = tid >> 6, fr = lane & 31, fh = lane >> 5;
    const int hq = kvh * 4 + (wid & 3), row = qrow0 + (wid >> 2) * 32 + fr;
    bf16_t* qbuf = (bf16_t*)(p.ws + OFF_Q);
    bf16x8 qf[4];
#pragma unroll
    for (int ks = 0; ks < 4; ++ks) qf[ks] = *(const bf16x8*)(qbuf + (size_t)row * 512 + hq * 64 + 16 * ks + 8 * fh);
    const int lr = tid >> 3, lc = tid & 7;
    const bf16_t* kg = (const bf16_t*)(p.ws + OFF_K) + (size_t)(b * 2 + kvh) * NKEY * 64 + (size_t)lr * 64 + lc * 8;
    const bf16_t* vg = (const bf16_t*)(p.ws + OFF_VT) + (size_t)(b * 2 + kvh) * 64 * NKEY + (size_t)lr * NKEY + lc * 8;
    const int kso = lr * ATT_KS + lc * 16, vso = 4 * ATT_KB + lr * ATT_VS + lc * 16;
    const int nst = nkeys >> 8;
#pragma unroll
    for (int j = 0; j < 4; ++j) {
        const uint4 k0 = *(const uint4*)(kg + (size_t)j * 4096), v0 = *(const uint4*)(vg + (size_t)j * 64);
        *(uint4*)(lds + j * ATT_KB + kso) = k0;
        *(uint2*)(lds + j * ATT_VB + vso) = make_uint2(v0.x, v0.y); *(uint2*)(lds + j * ATT_VB + vso + 8) = make_uint2(v0.z, v0.w);
    }
    __syncthreads();
    f32x16 o[2];
#pragma unroll
    for (int i = 0; i < 16; ++i) { o[0][i] = 0.f; o[1][i] = 0.f; }
    const int koff = fr * ATT_KS + fh * 16, voff = 4 * ATT_KB + fr * ATT_VS + fh * 8;
    float m_used = 0.f, lsum = 0.f;
#pragma unroll 1
    for (int st = 0; st < nst; ++st) {
        const unsigned char* sc = lds + (st & 1) * ATT_STAGE;
        unsigned char* sn = lds + ((st & 1) ^ 1) * ATT_STAGE;
        const bool more = (st + 1 < nst);
#pragma unroll
        for (int j = 0; j < 4; ++j) {
            uint4 rk, rv;
            if (more) { rk = *(const uint4*)(kg + (size_t)((st + 1) * 4 + j) * 4096); rv = *(const uint4*)(vg + (size_t)((st + 1) * 4 + j) * 64); }
            f32x16 s[2];
            {
                const float ninit = -m_used;
#pragma unroll
                for (int i = 0; i < 16; ++i) { s[0][i] = ninit; s[1][i] = ninit; }
            }
            const unsigned char* cK = sc + j * ATT_KB + koff;
#pragma unroll
            for (int ks = 0; ks < 4; ++ks)
#pragma unroll
                for (int kb = 0; kb < 2; ++kb) s[kb] = __builtin_amdgcn_mfma_f32_32x32x16_bf16(*(const bf16x8*)(cK + kb * 32 * ATT_KS + ks * 32), qf[ks], s[kb], 0, 0, 0);
            float mx = fmaxf(fmaxf(s[0][0], s[0][1]), s[0][2]);
#pragma unroll
            for (int i = 3; i < 15; i += 2) mx = fmaxf(fmaxf(mx, s[0][i]), s[0][i + 1]);
            mx = fmaxf(mx, s[0][15]);
#pragma unroll
            for (int i = 0; i < 16; i += 2) mx = fmaxf(fmaxf(mx, s[1][i]), s[1][i + 1]);
            mx = fmaxf(mx, __shfl_xor(mx, 32));
            const bool firstt = (st == 0 && j == 0);
            if (firstt || __builtin_amdgcn_ballot_w64(mx > 8.0f) != 0ull) {
                const float delta = firstt ? mx : ((mx > 8.0f) ? mx : 0.f);
                const float sc_o = __builtin_amdgcn_exp2f(-delta);
                m_used += delta; lsum *= sc_o;
#pragma unroll
                for (int i = 0; i < 16; ++i) { s[0][i] -= delta; s[1][i] -= delta; o[0][i] *= sc_o; o[1][i] *= sc_o; }
            }
            v2f ps2 = {0.f, 0.f};
#pragma unroll
            for (int kb = 0; kb < 2; ++kb)
#pragma unroll
                for (int i = 0; i < 16; i += 2) { const float e0 = __builtin_amdgcn_exp2f(s[kb][i]), e1 = __builtin_amdgcn_exp2f(s[kb][i + 1]); s[kb][i] = e0; s[kb][i + 1] = e1; ps2 += (v2f){e0, e1}; }
            lsum += ps2.x + ps2.y;
            const unsigned char* cV = sc + j * ATT_VB + voff;
#pragma unroll
            for (int kb = 0; kb < 2; ++kb)
#pragma unroll
                for (int sh = 0; sh < 2; ++sh) {
                    const bf16x8 pf = mk8(pack2(s[kb][8 * sh + 0], s[kb][8 * sh + 1]), pack2(s[kb][8 * sh + 2], s[kb][8 * sh + 3]),
                                          pack2(s[kb][8 * sh + 4], s[kb][8 * sh + 5]), pack2(s[kb][8 * sh + 6], s[kb][8 * sh + 7]));
#pragma unroll
                    for (int db = 0; db < 2; ++db) {
                        const unsigned char* vp = cV + db * 32 * ATT_VS + (kb * 32 + sh * 16) * 2;
                        const uint2 v0 = *(const uint2*)vp, v1 = *(const uint2*)(vp + 16);
                        o[db] = __builtin_amdgcn_mfma_f32_32x32x16_bf16(mk8(v0.x, v0.y, v1.x, v1.y), pf, o[db], 0, 0, 0);
                    }
                }
            if (more) {
                *(uint4*)(sn + j * ATT_KB + kso) = rk;
                *(uint2*)(sn + j * ATT_VB + vso) = make_uint2(rv.x, rv.y); *(uint2*)(sn + j * ATT_VB + vso + 8) = make_uint2(rv.z, rv.w);
            }
        }
        __syncthreads();
    }
    const float inv = 1.0f / (lsum + __shfl_xor(lsum, 32));
    bf16_t* op = qbuf + (size_t)row * 512 + hq * 64;
#pragma unroll
    for (int db = 0; db < 2; ++db)
#pragma unroll
        for (int g = 0; g < 4; ++g)
            *(uint2*)(op + db * 32 + g * 8 + fh * 4) = make_uint2(pack2(o[db][4 * g] * inv, o[db][4 * g + 1] * inv), pack2(o[db][4 * g + 2] * inv, o[db][4 * g + 3] * inv));
}

__device__ __forceinline__ void hyfft_unit(const Params& p, int l, int u, unsigned char* lds) {
    const int bp = u >> 8, c = u & 255, tid = threadIdx.x;
    float2* X = (float2*)lds;
    const float2* tw = (const float2*)(p.ws + OFF_TW);
    bf16_t* zt = (bf16_t*)(p.ws + OFF_ZT);
    bf16_t* z0 = zt + ((size_t)((2 * bp) * 768 + c)) * SEQ;
    bf16_t* z1 = zt + ((size_t)((2 * bp + 1) * 768 + c)) * SEQ;
    const float2* H0 = (const float2*)(p.ws + OFF_HSPEC + (size_t)l * SZ_HSPEC_L) + (size_t)c * NFFT;
    const float2* H1 = H0 + (size_t)256 * NFFT;
    const float sk0 = p.in[IN_HSKIP][l * 512 + c], sk1 = p.in[IN_HSKIP][l * 512 + 256 + c];
    float2 keep[16];
#pragma unroll
    for (int i = 0; i < 16; ++i) {
        const int t = tid + 512 * i;
        const float2 v = make_float2(bf2f(z0[t]), bf2f(z1[t]));
        keep[i] = v; X[XP(t)] = v; X[XP(t + 8192)] = make_float2(0.f, 0.f);
    }
    __syncthreads();
    fft_fwd(X, tw);
#pragma unroll
    for (int hb = 0; hb < 2; ++hb) { float2 h2[16];
#pragma unroll
      for (int i = 0; i < 16; ++i) h2[i] = H0[tid + 512 * (16 * hb + i)];
#pragma unroll
      for (int i = 0; i < 16; ++i) { const int ix = XP(tid + 512 * (16 * hb + i)); const v2f a = ((v2f*)X)[ix], h = {h2[i].x, h2[i].y}; ((v2f*)X)[ix] = pk_cmul(a, h); } }
    __syncthreads();
    fft_inv(X, tw);
#pragma unroll
    for (int i = 0; i < 16; ++i) {
        const int t = tid + 512 * i;
        const float2 cv = X[XP(t)];
        const float g0 = bf2f(z0[(size_t)256 * SEQ + t]), g1 = bf2f(z1[(size_t)256 * SEQ + t]);
        const float2 y = make_float2(g0 * (cv.x + sk0 * keep[i].x), g1 * (cv.y + sk0 * keep[i].y));
        keep[i] = y; X[XP(t)] = y; X[XP(t + 8192)] = make_float2(0.f, 0.f);
    }
    __syncthreads();
    fft_fwd(X, tw);
#pragma unroll
    for (int hb = 0; hb < 2; ++hb) { float2 h2[16];
#pragma unroll
      for (int i = 0; i < 16; ++i) h2[i] = H1[tid + 512 * (16 * hb + i)];
#pragma unroll
      for (int i = 0; i < 16; ++i) { const int ix = XP(tid + 512 * (16 * hb + i)); const v2f a = ((v2f*)X)[ix], h = {h2[i].x, h2[i].y}; ((v2f*)X)[ix] = pk_cmul(a, h); } }
    __syncthreads();
    fft_inv(X, tw);
#pragma unroll
    for (int i = 0; i < 16; ++i) {
        const int t = tid + 512 * i;
        const float2 cv = X[XP(t)];
        const float g0 = bf2f(z0[(size_t)512 * SEQ + t]), g1 = bf2f(z1[(size_t)512 * SEQ + t]);
        z0[t] = f2bf(g0 * (cv.x + sk1 * keep[i].x));
        z1[t] = f2bf(g1 * (cv.y + sk1 * keep[i].y));
    }
    __syncthreads();
}
__device__ __forceinline__ void filtfft_unit(const Params& p, int u, unsigned char* lds) {
    const int l = u >> 9, oc = u & 511, tid = threadIdx.x, lane = tid & 63, wid = tid >> 6;
    float2* X = (float2*)lds;
    float* red = (float*)(lds + 135168 + 64);
    const float* k = (const float*)(p.ws + OFF_P + (size_t)l * SZ_KCIRC_L) + (size_t)oc * NFFT;
    float s = 0.f;
#pragma unroll 4
    for (int i = tid; i < NFFT; i += 512) { const float v = k[i]; X[XP(i)] = make_float2(v, 0.f); s += fabsf(v); }
    s = wave_sum(s);
    if (lane == 0) red[wid] = s;
    __syncthreads();
    const float tot = red[0] + red[1] + red[2] + red[3] + red[4] + red[5] + red[6] + red[7];
    const float sc = 1.0f / (tot * (float)NFFT);
#pragma unroll 4
    for (int i = tid; i < NFFT; i += 512) X[XP(i)].x *= sc;
    __syncthreads();
    fft_fwd(X, (const float2*)(p.ws + OFF_TW));
    float2* H = (float2*)(p.ws + OFF_HSPEC + (size_t)l * SZ_HSPEC_L) + (size_t)oc * NFFT;
#pragma unroll 4
    for (int i = tid; i < NFFT; i += 512) H[i] = X[XP(i)];
    __syncthreads();
}
__device__ __forceinline__ void ctxhy_unit(const Params& p, int l, int u, unsigned char* lds) {
    const int b = u >> 7, tid = threadIdx.x, t = tid & 255, cs = tid >> 8, c = (u & 127) * 2 + cs;
    float* sv = (float*)lds + cs * 256;
    float* sy = (float*)lds + 512 + cs * 256;
    float* k0 = (float*)lds + 1024 + cs * 1024;
    float* k1 = k0 + 512;
    const bf16_t* P = (const bf16_t*)(p.ws + OFF_P);
    const int rowb = ML + b * CTXL;
    const float* cw = p.in[IN_HCW] + l * 3 * 768;
    float z[3];
#pragma unroll
    for (int part = 0; part < 3; ++part) {
        const int ch = part * 256 + c;
        const float pm = (t > 0) ? bf2f(P[(size_t)(rowb + t - 1) * PW + 768 + ch]) : 0.f;
        const float pc = bf2f(P[(size_t)(rowb + t) * PW + 768 + ch]);
        const float pn = (t < CTXL - 1) ? bf2f(P[(size_t)(rowb + t + 1) * PW + 768 + ch]) : 0.f;
        z[part] = pm * cw[ch] + pc * cw[768 + ch] + pn * cw[1536 + ch] + p.in[IN_HCB][l * 768 + ch];
    }
    const float* kn = (const float*)(p.ws + OFF_KCN);
    k0[t] = kn[(size_t)c * 512 + t]; k0[t + 256] = kn[(size_t)c * 512 + t + 256];
    k1[t] = kn[(size_t)(256 + c) * 512 + t]; k1[t + 256] = kn[(size_t)(256 + c) * 512 + t + 256];
    sv[t] = z[0];
    __syncthreads();
    float a = 0.f;
#pragma unroll 8
    for (int s = 0; s < 256; ++s) a += k0[(t - s) & 511] * sv[s];
    const float y1 = z[1] * (a + p.in[IN_HSKIP][l * 512 + c] * z[0]);
    sy[t] = y1;
    __syncthreads();
    a = 0.f;
#pragma unroll 8
    for (int s = 0; s < 256; ++s) a += k1[(t - s) & 511] * sy[s];
    const float y2 = z[2] * (a + p.in[IN_HSKIP][l * 512 + 256 + c] * y1);
    ((bf16_t*)(p.ws + OFF_HY))[(size_t)(rowb + t) * 256 + c] = f2bf(y2);
    __syncthreads();
}
__device__ __forceinline__ void hytr_unit(const Params& p, int u, unsigned char* lds) {
    const int b = u >> 7, t0 = (u & 127) * 64, tid = threadIdx.x;
    constexpr int TS = 144;
    const bf16_t* zt = (const bf16_t*)(p.ws + OFF_ZT);
    for (int i = tid; i < 2048; i += 512) {
        const int ch = i >> 3, cc = i & 7;
        *(uint4*)(lds + ch * TS + cc * 16) = *(const uint4*)(zt + ((size_t)(b * 768 + ch)) * SEQ + t0 + cc * 8);
    }
    __syncthreads();
    {
        const int ch = tid & 255, half = tid >> 8;
        bf16_t* dst = (bf16_t*)(p.ws + OFF_HY) + (size_t)(b * SEQ + t0) * 256 + ch;
        for (int j = 0; j < 32; ++j) { const int tl = half * 32 + j; dst[(size_t)tl * 256] = *(const bf16_t*)(lds + ch * TS + tl * 2); }
    }
    __syncthreads();
}

#ifdef DIAG_NAN
__device__ __forceinline__ void diag_scan(const Params& p, size_t off, size_t nbytes, bool isbf, unsigned code) {
    const uint4* q = (const uint4*)(p.ws + off);
    const size_t n = nbytes / 16;
    bool bad = false;
    for (size_t i = (size_t)blockIdx.x * 512 + threadIdx.x; i < n; i += (size_t)gridDim.x * 512) {
        const uint4 v = q[i];
        const unsigned w[4] = {v.x, v.y, v.z, v.w};
#pragma unroll
        for (int k = 0; k < 4; ++k) {
            if (isbf) { if ((w[k] & 0x7f80u) == 0x7f80u || (w[k] & 0x7f800000u) == 0x7f800000u) bad = true; }
            else { if ((w[k] & 0x7f800000u) == 0x7f800000u) bad = true; }
        }
    }
    if (bad) atomicMin((unsigned*)(p.ws + WS_END), code);
}
__device__ __forceinline__ void diag_scan_out(const Params& p, unsigned code) {
    const uint4* q = (const uint4*)p.out;
    const size_t n = (size_t)ML * 1024 / 4;
    bool bad = false;
    for (size_t i = (size_t)blockIdx.x * 512 + threadIdx.x; i < n; i += (size_t)gridDim.x * 512) {
        const uint4 v = q[i];
        if ((v.x & 0x7f800000u) == 0x7f800000u || (v.y & 0x7f800000u) == 0x7f800000u || (v.z & 0x7f800000u) == 0x7f800000u || (v.w & 0x7f800000u) == 0x7f800000u) bad = true;
    }
    if (bad) atomicMin((unsigned*)(p.ws + WS_END), code);
}
__device__ __forceinline__ void diag_phase(const Params& p, int ph) {
    const int prev = ph - 1;
    if (prev == 0) {
        diag_scan(p, OFF_W, 2 * W_LAYER, true, 0);
        diag_scan(p, OFF_MOD, (size_t)2 * 9 * 6144 * 4 + 16384 + 65536, false, 0);
        diag_scan(p, OFF_P, 2 * SZ_KCIRC_L, false, 0);
        diag_scan(p, OFF_KCR, (size_t)2 * 256 * 512 * 4, false, 0);
    } else if (prev == 1) {
        diag_scan(p, OFF_HSPEC, 2 * SZ_HSPEC_L, false, 1);
        diag_scan(p, OFF_KCN, (size_t)2 * 256 * 512 * 4, false, 1);
        diag_scan(p, OFF_HN, SZ_HN, true, 1);
    } else {
        const int sub = (prev - 2) % 10;
        switch (sub) {
        case 0: diag_scan(p, OFF_P, SZ_P, true, prev); break;
        case 1: diag_scan(p, OFF_Q, SZ_Q + 2 * SZ_K + SZ_ZT + 2 * SZ_B256, true, prev); break;
        case 2: diag_scan(p, OFF_Q, SZ_Q, true, prev); diag_scan(p, OFF_ZT, SZ_ZT, true, prev); diag_scan(p, OFF_HY, SZ_B256, true, prev); break;
        case 3: diag_scan(p, OFF_HY, SZ_B256, true, prev); break;
        case 4: diag_scan(p, OFF_P, SZ_HN, true, prev); break;
        case 5: diag_scan_out(p, prev); break;
        case 6: diag_scan(p, OFF_HN, (size_t)ML * 2048, true, prev); break;
        case 7: diag_scan(p, OFF_P, (size_t)ML * FFH * 2, true, prev); break;
        case 8: diag_scan_out(p, prev); break;
        default: diag_scan(p, OFF_HN, SZ_HN, true, prev); break;
        }
    }
}
#endif

__device__ __forceinline__ void run_phase(const Params& p, int ph, unsigned char* lds) {
    const int G = gridDim.x, bid = blockIdx.x;
#ifdef PROBE_SEL
    if (bid == 0 && threadIdx.x == 0) ((unsigned long long*)(p.ws + WS_END + 64))[ph] = __builtin_amdgcn_s_memrealtime();
#endif
#ifdef DIAG_NAN
    if (ph == 0 && bid == 0 && threadIdx.x == 0) *(unsigned*)(p.ws + WS_END) = 999u;
    if (ph == 0 && bid == 0 && threadIdx.x == 0) { *(unsigned*)(p.ws + WS_END + 4) = 0u; *(unsigned*)(p.ws + WS_END + 8) = 0x7fffffffu; }
    if (ph == 3) {
        const unsigned* q = (const unsigned*)(p.ws + OFF_P);
        const size_t n = SZ_P / 4;
        unsigned cnt = 0, mincol = 0x7fffffffu;
        for (size_t i = (size_t)bid * 512 + threadIdx.x; i < n; i += (size_t)G * 512) {
            const unsigned w = q[i];
            const unsigned col = (unsigned)((i * 2) % PW);
            const unsigned rowi = (unsigned)((i * 2) / PW);
            const bool bad = ((w & 0x7f80u) == 0x7f80u) || ((w & 0x7f800000u) == 0x7f800000u);
            if (bad) { if (col == 0) cnt++; mincol = min(mincol, rowi); }
        }
        if (cnt) { atomicAdd((unsigned*)(p.ws + WS_END + 4), cnt); atomicMin((unsigned*)(p.ws + WS_END + 8), mincol); }
    }
#endif
    if (ph == 0) {
        if (!ONLYC(100) && !ONLYC(102) && !ONLYC(103) && !ONLYC(104) && !ONLYC(105) && !ONLYC(106)) return;
        constexpr int NCVT = 2 * 4224, NMOD = 96, NWEFF = 64, NFILT = 260, NMISC = 16, NHEAVY = NMOD + NWEFF + NFILT + NMISC;
        for (int u = bid; u < NHEAVY + NCVT; u += G) {
            if (u >= NHEAVY) {
                const int uu = u - NHEAVY, l = uu / 4224, t = uu % 4224;
                int j, base;
                if (t < 1600) { j = 0; base = 0; } else if (t < 1728) { j = 1; base = 1600; } else if (t < 1792) { j = 2; base = 1728; } else if (t < 1856) { j = 3; base = 1792; }
                else if (t < 2112) { j = 4; base = 1856; } else if (t < 2816) { j = 5; base = 2112; } else if (t < 3520) { j = 6; base = 2816; } else { j = 7; base = 3520; }
                const CvtJob jb = get_job(p, l, j);
                if (ONLYC(100) || ONLYC(102)) cvt_tile(jb, t - base, lds);
            } else if (u < NFILT) {
                if (!(ONLYC(100) || ONLYC(105))) {} else if (u < 256) filt_task(p, u >> 7, u & 127, SEQ, (float*)(p.ws + OFF_P + (size_t)(u >> 7) * SZ_KCIRC_L), lds);
                else filt_task(p, 0, u - 256, CTXL, (float*)(p.ws + OFF_KCR), lds);
            } else if (u < NFILT + NMOD) { if (ONLYC(100) || ONLYC(103)) mod_task(p, u - NFILT, lds); }
            else if (u < NFILT + NMOD + NWEFF) { if (ONLYC(100) || ONLYC(104)) weff_task(p, u - NFILT - NMOD, lds); }
            else { if (ONLYC(100) || ONLYC(106)) misc_task(p, u - NFILT - NMOD - NWEFF); }
        }
        return;
    }
    if (ph == 1) {
        if (!ONLYC(101)) return;
        for (int u = bid; u < 1024; u += G) filtfft_unit(p, u, lds);
        {
            const int lane = threadIdx.x & 63, wid = threadIdx.x >> 6;
            const float* kr = (const float*)(p.ws + OFF_KCR);
            float* kn = (float*)(p.ws + OFF_KCN);
            for (int oc = bid * 8 + wid; oc < 512; oc += G * 8) {
                float v[8], s = 0.f;
#pragma unroll
                for (int i = 0; i < 8; ++i) { v[i] = kr[(size_t)oc * 512 + lane + 64 * i]; s += fabsf(v[i]); }
                s = 1.0f / wave_sum(s);
#pragma unroll
                for (int i = 0; i < 8; ++i) kn[(size_t)oc * 512 + lane + 64 * i] = v[i] * s;
            }
        }
        modulate_phase(p, 0, 0, MT, p.in[IN_X], p.in[IN_CTX]);
        return;
    }
    const int l = (ph - 2) / 10, sub10 = (ph - 2) % 10, sub13 = (sub10 < 3) ? sub10 : (sub10 < 5) ? sub10 + 1 : sub10 + 3;
    const int half = (sub13 == 6 || sub13 == 7) ? 1 : 0;
    const int sub = (sub13 < 4) ? sub13 : (sub13 == 4 || sub13 == 6) ? 40 : (sub13 == 5 || sub13 == 7) ? 4 : (sub13 - 3);
    const bool first = (l == 0), last = (l == 1);
    unsigned char* wl = p.ws + OFF_W + (size_t)l * W_LAYER;
    const int mtiles = first ? (MT / 256) : (ML / 256);
    const float* mod = (const float*)(p.ws + OFF_MOD) + (size_t)l * 9 * 6144;
    float* xc = (float*)(p.ws + OFF_XC);
    switch (sub) {
    case 0: {
        if (!ONLYC(0) && !(0 == 1 && (ONLYC(10)||ONLYC(11)||ONLYC(12)||ONLYC(13))) && !(0 == 2 && (ONLYC(20)||ONLYC(21)||ONLYC(22)||ONLYC(23)))) break;
        pg8::Gemm g{(const bf16_t*)(p.ws + OFF_HN), (const bf16_t*)(wl + W_WIN), MT, PW, 1024};
        pg8::StaticOrder S; S.init(MT, PW, G, bid);
        pg8::EpiP E{(bf16_t*)(p.ws + OFF_P), PW};
        pg8::gemm_phase<pg8::EpiP, pg8::StaticOrder, true, true>((PG8_LAS unsigned char*)g_lds, g, S, E);
    } break;
    case 1: {
        if (!ONLYC(1) && !(1 == 1 && (ONLYC(10)||ONLYC(11)||ONLYC(12)||ONLYC(13))) && !(1 == 2 && (ONLYC(20)||ONLYC(21)||ONLYC(22)||ONLYC(23)))) break;
        const int NQK = 1056, NHC = 768, NPOOL = first ? 264 : 256, NGM = first ? 528 : 512;
        for (int u = bid; u < NHC; u += G) { if (ONLYC(1) || ONLYC(11)) hyconv_unit(p, l, u, lds); }
        for (int u = (bid + 64) % G; u < NQK; u += G) { if (ONLYC(1) || ONLYC(10)) qk_unit(p, l, u, lds); }
        for (int u = (bid + 128) % G; u < NGM; u += G) { if (ONLYC(1) || ONLYC(13)) gmlp_unit(p, l, u, lds); }
        for (int u = (bid + 192) % G; u < NPOOL; u += G) { if (ONLYC(1) || ONLYC(12)) pool_unit(p, u, lds); }
    } break;
    case 2: {
        if (!ONLYC(2) && !(2 == 1 && (ONLYC(10)||ONLYC(11)||ONLYC(12)||ONLYC(13))) && !(2 == 2 && (ONLYC(20)||ONLYC(21)||ONLYC(22)||ONLYC(23)))) break;
        const int NF = 1024, NA = 2048, NCA = first ? 64 : 0, NCH = first ? 1024 : 0;
#ifdef PROBE_SEL
#define MIXTS(k) if (bid == 0 && threadIdx.x == 0) ((unsigned long long*)(p.ws + WS_END + 1024))[l * 4 + (k)] = __builtin_amdgcn_s_memrealtime();
#else
#define MIXTS(k)
#endif
        MIXTS(0)
        for (int u = bid; u < NF; u += G) { if (ONLYC(2) || ONLYC(20)) hyfft_unit(p, l, u, lds); }
        MIXTS(1)
        for (int u = bid; u < NA + NCA; u += G) {
            int ab, akvh, arow, ank;
            if (u < NA) { ab = u >> 8; akvh = u & 1; arow = (u >> 8) * SEQ + ((u >> 1) & 127) * 64; ank = NKEY; }
            else { const int a = u - NA; ab = a >> 3; akvh = (a >> 2) & 1; arow = ML + (a >> 3) * CTXL + (a & 3) * 64; ank = CTXL; }
            if (ONLYC(2) || ONLYC(21) || ONLYC(22)) attn_unit(p, ab, akvh, arow, ank, lds);
        }
        MIXTS(2)
        for (int u = bid; u < NCH; u += G) { if (ONLYC(2) || ONLYC(23)) ctxhy_unit(p, l, u, lds); }
        MIXTS(3)
    } break;
    case 3: {
        if (!ONLYC(3) && !(3 == 1 && (ONLYC(10)||ONLYC(11)||ONLYC(12)||ONLYC(13))) && !(3 == 2 && (ONLYC(20)||ONLYC(21)||ONLYC(22)||ONLYC(23)))) break;
        for (int u = bid; u < 1024; u += G) hytr_unit(p, u, lds);
    } break;
    case 40: {
        if (!ONLYC(40)) break;
        if (half == 0) { for (int u = bid; u < 1024; u += G) hytr_unit(p, u, lds); }
        const int rowbase = 0, Mh = first ? MT : ML;
        pg8::Gemm g{(const bf16_t*)(p.ws + OFF_HN) + (size_t)rowbase * 1024, (const bf16_t*)(wl + W_WIN) + (size_t)PW * 1024, Mh, 4096, 1024};
        pg8::StaticOrder S; S.init(Mh, 4096, G, bid);
        pg8::EpiSig E{p.ws + OFF_P, 4096};
        pg8::gemm_phase<pg8::EpiSig, pg8::StaticOrder, true, true>((PG8_LAS unsigned char*)g_lds, g, S, E);
    } break;
    case 4: {
        if (!ONLYC(4)) break;
        const int rowbase = 0, Mh = first ? MT : ML;
        const unsigned char* Gb = p.ws + OFF_P;
        bf16_t* mg = (bf16_t*)(p.ws + OFF_MG);
        const int mtiles_h = Mh / 256;
        const int total = ((mtiles_h + 31) / 32) * 256;
        for (int u = bid; u < total; u += G) {
            const int rr = u >> 8, w = u & 255, mt = rr * 32 + (w & 7) * 4 + (w >> 6), nt = (w >> 3) & 7;
            if (mt >= mtiles_h) continue;
            f32x16 msum[2][2]; zero_acc(msum);
            const int lane = threadIdx.x & 63, wid = threadIdx.x >> 6, wm = wid >> 1, wn = wid & 1, fr = lane & 31, fh = lane >> 5;
#pragma unroll 1
            for (int br = 0; br < 4; ++br) {
                const bf16_t* Ab = (const bf16_t*)(p.ws + (br == 0 ? OFF_Q : br == 1 ? OFF_HY : br == 2 ? OFF_PD : OFF_GM));
                const bf16_t* Wb = (const bf16_t*)(wl + (br == 0 ? W_BA : br == 1 ? W_BH : br == 2 ? W_BP : W_BG));
                const int Kb = (br == 0) ? 512 : 256;
                unsigned gq[2][2][4];
#pragma unroll
                for (int mb = 0; mb < 1; ++mb)
#pragma unroll
                    for (int nb = 0; nb < 2; ++nb)
#pragma unroll
                        for (int g4 = 0; g4 < 4; ++g4) {
                            const int rowl = mt * 256 + wm * 64 + mb * 32 + fr, col = nt * 128 + wn * 64 + nb * 32 + g4 * 8 + fh * 4;
                            gq[mb][nb][g4] = *(const unsigned*)(Gb + (size_t)rowl * 4096 + br * 1024 + col);
                        }
                f32x16 v[2][2]; zero_acc(v);
                gemm_mainloop(v, Ab + (size_t)(rowbase + mt * 256) * Kb, Kb, Wb + (size_t)nt * 128 * Kb, Kb, Kb, lds);
#pragma unroll
                for (int nb = 0; nb < 2; ++nb)
#pragma unroll
                    for (int g4 = 0; g4 < 4; ++g4) {
                        const int rowl = mt * 256 + wm * 64 + 32 + fr, col = nt * 128 + wn * 64 + nb * 32 + g4 * 8 + fh * 4;
                        gq[1][nb][g4] = *(const unsigned*)(Gb + (size_t)rowl * 4096 + br * 1024 + col);
                    }
#pragma unroll
                for (int mb = 0; mb < 2; ++mb)
#pragma unroll
                    for (int nb = 0; nb < 2; ++nb)
#pragma unroll
                        for (int g4 = 0; g4 < 4; ++g4) {
                            const unsigned gg = gq[mb][nb][g4];
                            constexpr float QS = 1.0f / 255.0f;
                            msum[nb][mb][4 * g4 + 0] += ((float)(gg & 0xffu) * QS) * v[nb][mb][4 * g4 + 0]; msum[nb][mb][4 * g4 + 1] += ((float)((gg >> 8) & 0xffu) * QS) * v[nb][mb][4 * g4 + 1];
                            msum[nb][mb][4 * g4 + 2] += ((float)((gg >> 16) & 0xffu) * QS) * v[nb][mb][4 * g4 + 2]; msum[nb][mb][4 * g4 + 3] += ((float)(gg >> 24) * QS) * v[nb][mb][4 * g4 + 3];
                        }
            }
#pragma unroll
            for (int mb = 0; mb < 2; ++mb)
#pragma unroll
                for (int nb = 0; nb < 2; ++nb)
#pragma unroll
                    for (int g4 = 0; g4 < 4; ++g4) {
                        const int row = rowbase + mt * 256 + wm * 64 + mb * 32 + fr, col = nt * 128 + wn * 64 + nb * 32 + g4 * 8 + fh * 4;
                        *(uint2*)(mg + (size_t)row * 1024 + col) = make_uint2(pack2(msum[nb][mb][4 * g4], msum[nb][mb][4 * g4 + 1]), pack2(msum[nb][mb][4 * g4 + 2], msum[nb][mb][4 * g4 + 3]));
                    }
        }
    } break;
    case 5: case 8: {
        if (!ONLYC(5)) break;
        const bool isout = (sub == 5);
        const int Mrows = first ? MT : ML, K = isout ? 1024 : FFH;
        pg8::Gemm g{(const bf16_t*)(p.ws + (isout ? OFF_MG : OFF_P)), (const bf16_t*)(wl + (isout ? W_OUT : W_DN)), Mrows, 1024, K};
        pg8::StaticOrder S; S.init(Mrows, 1024, G, bid);
        pg8::EpiRes E{(isout && first) ? p.in[IN_X] : p.out, (isout && first) ? p.in[IN_CTX] : xc, p.out, xc, mod + (isout ? 2048 : 5120), ML};
        pg8::gemm_phase<pg8::EpiRes, pg8::StaticOrder, true, true>((PG8_LAS unsigned char*)g_lds, g, S, E);
    } break;
    case 6: if (!ONLYC(6)) break; modulate_phase(p, l, 1, first ? MT : ML, p.out, xc); break;
    case 7: {
        if (!ONLYC(7) && !(7 == 1 && (ONLYC(10)||ONLYC(11)||ONLYC(12)||ONLYC(13))) && !(7 == 2 && (ONLYC(20)||ONLYC(21)||ONLYC(22)||ONLYC(23)))) break;
        const int Mrows = first ? MT : ML;
        pg8::Gemm g{(const bf16_t*)(p.ws + OFF_HN), (const bf16_t*)(wl + W_GU), Mrows, 2 * FFH, 1024};
        pg8::StaticOrder S; S.init(Mrows, 2 * FFH, G, bid);
        pg8::EpiSwi E{(bf16_t*)(p.ws + OFF_P), FFH};
        pg8::gemm_phase<pg8::EpiSwi, pg8::StaticOrder, true, true>((PG8_LAS unsigned char*)g_lds, g, S, E);
    } break;
    case 9: {
        if (!ONLYC(9) && !(9 == 1 && (ONLYC(10)||ONLYC(11)||ONLYC(12)||ONLYC(13))) && !(9 == 2 && (ONLYC(20)||ONLYC(21)||ONLYC(22)||ONLYC(23)))) break;
        if (last) final_norm_phase(p);
        else modulate_phase(p, l + 1, 0, MT, p.out, xc);
    } break;
    }
}

__device__ __forceinline__ unsigned xcc_id() { return (unsigned)__builtin_amdgcn_s_getreg((3 << 11) | 20) & 0x7u; }
__device__ __forceinline__ void seam_barrier(unsigned* words  , unsigned x, unsigned nx, unsigned nact) {
    __syncthreads();
    if (threadIdx.x == 0) {
        __builtin_amdgcn_fence(__ATOMIC_RELEASE, "agent");
        const unsigned old = __hip_atomic_fetch_add(words + 32 * x, 1u, __ATOMIC_RELAXED, __HIP_MEMORY_SCOPE_AGENT);
        if (old + 1u == nx) __hip_atomic_fetch_add(words + 256, 1u, __ATOMIC_RELAXED, __HIP_MEMORY_SCOPE_AGENT);
        while (__hip_atomic_load(words + 256, __ATOMIC_RELAXED, __HIP_MEMORY_SCOPE_AGENT) < nact) __builtin_amdgcn_s_sleep(1);
        __builtin_amdgcn_fence(__ATOMIC_ACQUIRE, "agent");
    }
    __syncthreads();
}
__global__ void __launch_bounds__(512) mk_forward(Params p) {
    unsigned* const barw = (unsigned*)(p.ws + OFF_BAR);
    const unsigned xcc = (unsigned)__builtin_amdgcn_readfirstlane((int)xcc_id());
    unsigned nx = 0u, nact = 0u;
    if (p.ph_hi - p.ph_lo > 1 && threadIdx.x == 0) __hip_atomic_fetch_add(barw + 32 * xcc, 1u, __ATOMIC_RELAXED, __HIP_MEMORY_SCOPE_AGENT);
#define MK_PHASE(k) if (p.ph_lo <= (k) && (k) < p.ph_hi) { if ((k) > p.ph_lo) { \
        if ((k) == 1) { cg::this_grid().sync(); \
            for (unsigned q = 0; q < 8u; ++q) { const unsigned cq = __hip_atomic_load(barw + 32 * q, __ATOMIC_RELAXED, __HIP_MEMORY_SCOPE_AGENT); nact += (cq != 0u); if (q == xcc) nx = cq; } \
            nx = (unsigned)__builtin_amdgcn_readfirstlane((int)nx); nact = (unsigned)__builtin_amdgcn_readfirstlane((int)nact); } \
        else seam_barrier(barw + 512 * (k), xcc, nx, nact); } run_phase(p, (k), g_lds); }
    MK_PHASE(0) MK_PHASE(1)
    MK_PHASE(2) MK_PHASE(3) MK_PHASE(4) MK_PHASE(5) MK_PHASE(6) MK_PHASE(7) MK_PHASE(8) MK_PHASE(9) MK_PHASE(10) MK_PHASE(11) MK_PHASE(12) MK_PHASE(13) MK_PHASE(14)
    MK_PHASE(15) MK_PHASE(16) MK_PHASE(17) MK_PHASE(18) MK_PHASE(19) MK_PHASE(20) MK_PHASE(21)
#undef MK_PHASE
}

extern "C" void kernel_launch(void* const* d_in, const int* in_sizes, int n_in, void* d_out, int out_size, void* d_ws, size_t ws_size, hipStream_t stream) {
    static int grid = 0;
    if (grid == 0) {
        if (n_in != N_IN || out_size != ML * D || ws_size < WS_END2) { fprintf(stderr, "kernel_launch: unexpected shapes (n_in %d out %d ws %zu need %zu)\n", n_in, out_size, ws_size, (size_t)WS_END); grid = -1; return; }
        int dev = 0, cus = 0, per_cu = 0;
        hipGetDevice(&dev);
        hipDeviceGetAttribute(&cus, hipDeviceAttributeMultiprocessorCount, dev);
        if (hipFuncSetAttribute((const void*)mk_forward, hipFuncAttributeMaxDynamicSharedMemorySize, LDS_BYTES) != hipSuccess) { fprintf(stderr, "kernel_launch: hipFuncSetAttribute failed\n"); grid = -1; return; }
        if (hipOccupancyMaxActiveBlocksPerMultiprocessor(&per_cu, (const void*)mk_forward, 512, LDS_BYTES) != hipSuccess || per_cu < 1) { fprintf(stderr, "kernel_launch: occupancy query says %d\n", per_cu); per_cu = 1; }
        (void)hipGetLastError();
        grid = cus * 1;
    }
    if (grid < 0) return;
    Params p{};
    for (int i = 0; i < N_IN; ++i) p.in[i] = (const float*)d_in[i];
    p.out = (float*)d_out; p.ws = (unsigned char*)d_ws;
#if MK_MULTI_LAUNCH
    for (int ph = 0; ph < NPHASE; ++ph) {
        p.ph_lo = ph; p.ph_hi = ph + 1;
        hipLaunchKernelGGL(mk_forward, dim3(grid), dim3(512), LDS_BYTES, stream, p);
    }
#else
    p.ph_lo = 0; p.ph_hi = NPHASE;
    if (hipMemsetAsync((char*)d_ws + OFF_BAR, 0, 65536, stream) != hipSuccess) { fprintf(stderr, "kernel_launch: memset of the barrier words failed\n"); return; }
    void* args[] = {&p};
    hipError_t e = hipLaunchCooperativeKernel((const void*)mk_forward, dim3(grid), dim3(512), args, LDS_BYTES, stream);
    if (e != hipSuccess) fprintf(stderr, "cooperative launch failed: %s (grid %d)\n", hipGetErrorString(e), grid);
#endif
}
```

```cpp
#include <hip/hip_runtime.h>
#include <hip/hip_cooperative_groups.h>
#include <cstdio>
#include <cstdint>
#include <cmath>
namespace cg = cooperative_groups;

#ifndef MK_MULTI_LAUNCH
#define MK_MULTI_LAUNCH 0
#endif

#ifndef ONLY
#define ONLYC(k) true
#else
#define ONLYC(k) ((k)==ONLY)
#endif
typedef unsigned short bf16_t;
typedef short bf16x8 __attribute__((ext_vector_type(8)));
typedef float f32x16 __attribute__((ext_vector_type(16)));

constexpr int D = 1024, NB = 8, SEQ = 8192, CTXL = 256;
constexpr int ML = NB * SEQ, MC = NB * CTXL, MT = ML + MC;
constexpr int PW = 2304;
constexpr int INW = 6400, FFH = 2816, NKEY = CTXL + SEQ;
constexpr int NFFT = 16384;
constexpr float QSCALE = 0.125f * 1.4426950408889634f;

enum { IN_X, IN_C, IN_CTX, IN_CCTX, IN_WMOD, IN_BMOD, IN_N1W, IN_N2W, IN_WIN, IN_QNW, IN_KNW, IN_HCW, IN_HCB, IN_HW1, IN_HB1, IN_HW2, IN_HB2,
       IN_HW3, IN_HFREQ, IN_HDECAY, IN_HSKIP, IN_POOLW, IN_POOLS, IN_GMNW, IN_GMWS, IN_GMBS, IN_WBA, IN_WBH, IN_WBP, IN_WBG, IN_WOUT, IN_FG, IN_FU, IN_FD, IN_FNW, N_IN };

constexpr size_t SZ_HN = (size_t)MT * 1024 * 2;
constexpr size_t SZ_P = (size_t)MT * PW * 2;
constexpr size_t SZ_Q = (size_t)MT * 512 * 2;
constexpr size_t SZ_K = (size_t)16 * NKEY * 64 * 2;
constexpr size_t SZ_ZT = (size_t)NB * 768 * SEQ * 2;
constexpr size_t SZ_B256 = (size_t)MT * 256 * 2;
constexpr size_t W_WIN = 0, W_BA = W_WIN + (size_t)6400 * 1024 * 2, W_BH = W_BA + (size_t)1024 * 512 * 2, W_BP = W_BH + (size_t)1024 * 256 * 2,
                 W_BG = W_BP + (size_t)1024 * 256 * 2, W_OUT = W_BG + (size_t)1024 * 256 * 2, W_GU = W_OUT + (size_t)1024 * 1024 * 2,
                 W_DN = W_GU + (size_t)5632 * 1024 * 2, W_GMWS = W_DN + (size_t)1024 * 2816 * 2, W_LAYER = W_GMWS + (size_t)4 * 128 * 128 * 2;
constexpr size_t OFF_HN = 0;
constexpr size_t OFF_P = OFF_HN + SZ_HN;
constexpr size_t OFF_Q = OFF_P + SZ_P;
constexpr size_t OFF_PD = OFF_Q + SZ_Q;
constexpr size_t OFF_GM = OFF_PD + SZ_B256;
constexpr size_t OFF_HY = OFF_GM + SZ_B256;
constexpr size_t OFF_W = OFF_HY + SZ_B256;
constexpr size_t OFF_HSPEC = OFF_W + 2 * W_LAYER;
constexpr size_t SZ_HSPEC_L = (size_t)2 * 256 * NFFT * 8;
constexpr size_t OFF_XC = OFF_HSPEC + 2 * SZ_HSPEC_L;
constexpr size_t OFF_MOD = OFF_XC + (size_t)MC * 1024 * 4;
constexpr size_t OFF_ROPE = OFF_MOD + (size_t)2 * 9 * 6144 * 4;
constexpr size_t OFF_TW = OFF_ROPE + (size_t)128 * 16 * 2 * 4;
constexpr size_t OFF_KCR = OFF_TW + (size_t)8192 * 8;
constexpr size_t OFF_KCN = OFF_KCR + (size_t)2 * 256 * 512 * 4;
constexpr size_t OFF_K = OFF_KCN + (size_t)2 * 256 * 512 * 4;
constexpr size_t OFF_VT = OFF_K + SZ_K;
constexpr size_t OFF_ZT = OFF_VT + SZ_K;
constexpr size_t OFF_MG = OFF_K;
constexpr size_t WS_END = OFF_K + ((2 * SZ_K + SZ_ZT) > SZ_HN ? (2 * SZ_K + SZ_ZT) : SZ_HN);
static_assert((size_t)MT * 4096 <= SZ_P, "the 8-bit gate buffer lives in the P region");
constexpr size_t SZ_KCIRC_L = (size_t)2 * 256 * NFFT * 4;
static_assert((size_t)MT * FFH * 2 == SZ_P + SZ_Q, "hid spans P+Q");
static_assert(WS_END <= ((size_t)1 << 30), "workspace over 1 GiB");

constexpr size_t OFF_BAR = (WS_END + 4095) & ~(size_t)4095;
constexpr size_t WS_END2 = OFF_BAR + 65536;
static_assert(WS_END2 <= ((size_t)1 << 30), "workspace over 1 GiB");
constexpr int LDS_BYTES = 147456;
constexpr int NPHASE = 22;

struct Params {
    const float* in[N_IN];
    float* out;
    unsigned char* ws;
    int ph_lo, ph_hi;
};

__device__ __forceinline__ float bf2f(bf16_t b) { return __uint_as_float(((unsigned)b) << 16); }
typedef float f32x2_t __attribute__((ext_vector_type(2)));
typedef __bf16 bf16x2_t __attribute__((ext_vector_type(2)));
__device__ __forceinline__ unsigned pack2(float lo, float hi) { const f32x2_t v = {lo, hi}; const bf16x2_t b = __builtin_convertvector(v, bf16x2_t); return __builtin_bit_cast(unsigned, b); }
__device__ __forceinline__ bf16_t f2bf(float f) { return (bf16_t)(pack2(f, 0.f) & 0xffffu); }
__device__ __forceinline__ float lo_bf(unsigned u) { return __uint_as_float(u << 16); }
__device__ __forceinline__ float hi_bf(unsigned u) { return __uint_as_float(u & 0xffff0000u); }
__device__ __forceinline__ float sigmoidf_(float x) { return 1.0f / (1.0f + __expf(-x)); }
__device__ __forceinline__ float wave_sum(float v) {
    v += __shfl_xor(v, 32); v += __shfl_xor(v, 16); v += __shfl_xor(v, 8); v += __shfl_xor(v, 4); v += __shfl_xor(v, 2); v += __shfl_xor(v, 1); return v;
}
__device__ __forceinline__ bf16x8 mk8(unsigned a, unsigned b, unsigned c, unsigned d) {
    typedef unsigned u32x4 __attribute__((ext_vector_type(4)));
    u32x4 v = {a, b, c, d};
    return __builtin_bit_cast(bf16x8, v);
}

constexpr int LROW = 144;
constexpr int A_BUF = 256 * LROW, B_BUF = 128 * LROW;
template <int NBK>
__device__ __forceinline__ void gemm_mainloop_t(f32x16 (&acc)[NBK][2], const bf16_t* __restrict__ A, int lda, const bf16_t* __restrict__ Bt, int ldb, int K, unsigned char* lds) {
    const int tid = threadIdx.x, lane = tid & 63, wid = tid >> 6, wm = wid >> 1, wn = wid & 1;
    const int lrow = tid >> 3, lkc = tid & 7;
    asm volatile("" : "+s"(lda), "+s"(ldb));
    const bf16_t* ga = A + (size_t)lrow * lda + lkc * 8;
    const bf16_t* gb = Bt + (size_t)lrow * ldb + lkc * 8;
    uint4 p0a0, p0a1, p0a2, p0a3, p0b0, p0b1 = make_uint4(0, 0, 0, 0), p1a0, p1a1, p1a2, p1a3, p1b0, p1b1 = make_uint4(0, 0, 0, 0);
#define GM_LOAD(S, DUMMY, KT) do { const bf16_t* pa = ga + (size_t)(KT) * 64; const bf16_t* pb = gb + (size_t)(KT) * 64; \
        S##a0 = *(const uint4*)(pa); S##a1 = *(const uint4*)(pa + (size_t)64 * lda); S##a2 = *(const uint4*)(pa + (size_t)128 * lda); S##a3 = *(const uint4*)(pa + (size_t)192 * lda); \
        S##b0 = *(const uint4*)(pb); if constexpr (NBK == 2) S##b1 = *(const uint4*)(pb + (size_t)64 * ldb); } while (0)
#define GM_STORE(S, DUMMY, BUF) do { unsigned char* qa = sA + (BUF) * A_BUF + soff; unsigned char* qb = sB + (BUF) * B_BUF + soff; \
        *(uint4*)(qa) = S##a0; *(uint4*)(qa + 64 * LROW) = S##a1; *(uint4*)(qa + 128 * LROW) = S##a2; *(uint4*)(qa + 192 * LROW) = S##a3; \
        *(uint4*)(qb) = S##b0; if constexpr (NBK == 2) *(uint4*)(qb + 64 * LROW) = S##b1; } while (0)
#define GM_COMPUTE(BUF) do { const unsigned char* cA = sA + (BUF) * A_BUF + aoff; const unsigned char* cB = sB + (BUF) * B_BUF + boff; \
        _Pragma("unroll") for (int ks = 0; ks < 4; ++ks) { \
            const bf16x8 a0 = *(const bf16x8*)(cA + ks * 32), a1 = *(const bf16x8*)(cA + 32 * LROW + ks * 32); \
            const bf16x8 b0 = *(const bf16x8*)(cB + ks * 32); \
            acc[0][0] = __builtin_amdgcn_mfma_f32_32x32x16_bf16(b0, a0, acc[0][0], 0, 0, 0); \
            acc[0][1] = __builtin_amdgcn_mfma_f32_32x32x16_bf16(b0, a1, acc[0][1], 0, 0, 0); \
            if constexpr (NBK == 2) { const bf16x8 b1 = *(const bf16x8*)(cB + 32 * LROW + ks * 32); \
                acc[NBK - 1][0] = __builtin_amdgcn_mfma_f32_32x32x16_bf16(b1, a0, acc[NBK - 1][0], 0, 0, 0); \
                acc[NBK - 1][1] = __builtin_amdgcn_mfma_f32_32x32x16_bf16(b1, a1, acc[NBK - 1][1], 0, 0, 0); } } } while (0)
    unsigned char* sA = lds;
    unsigned char* sB = lds + 2 * A_BUF;
    const int soff = lrow * LROW + lkc * 16;
    const int fr = lane & 31, fh = lane >> 5;
    const int aoff = (wm * 64 + fr) * LROW + fh * 16;
    const int boff = (wn * 32 * NBK + fr) * LROW + fh * 16;
    const int nk = K >> 6;
    GM_LOAD(p0, 0, 0);
    GM_LOAD(p1, 0, 1);
    GM_STORE(p0, 0, 0);
    __syncthreads();
    for (int kt = 0; kt < nk; kt += 2) {
        GM_LOAD(p0, 0, min(kt + 2, nk - 1));
        GM_COMPUTE(0);
        GM_STORE(p1, 0, 1);
        __syncthreads();
        GM_LOAD(p1, 0, min(kt + 3, nk - 1));
        GM_COMPUTE(1);
        GM_STORE(p0, 0, 0);
        __syncthreads();
    }
#undef GM_LOAD
#undef GM_STORE
#undef GM_COMPUTE
}
__device__ __forceinline__ void gemm_mainloop(f32x16 (&acc)[2][2], const bf16_t* __restrict__ A, int lda, const bf16_t* __restrict__ Bt, int ldb, int K, unsigned char* lds) {
    gemm_mainloop_t<2>(acc, A, lda, Bt, ldb, K, lds);
}
__device__ __forceinline__ void zero_acc1(f32x16 (&acc)[1][2]) {
#pragma unroll
    for (int b = 0; b < 2; ++b)
#pragma unroll
        for (int i = 0; i < 16; ++i) acc[0][b][i] = 0.f;
}
__device__ __forceinline__ void zero_acc(f32x16 (&acc)[2][2]) {
#pragma unroll
    for (int a = 0; a < 2; ++a)
#pragma unroll
        for (int b = 0; b < 2; ++b)
#pragma unroll
            for (int i = 0; i < 16; ++i) acc[a][b][i] = 0.f;
}
template <class F> __device__ __forceinline__ void epi_foreach(const f32x16 (&acc)[2][2], F f) {
    const int lane = threadIdx.x & 63, wid = threadIdx.x >> 6, wm = wid >> 1, wn = wid & 1, fr = lane & 31, fh = lane >> 5;
#pragma unroll
    for (int mb = 0; mb < 2; ++mb)
#pragma unroll
        for (int nb = 0; nb < 2; ++nb)
#pragma unroll
            for (int g = 0; g < 4; ++g)
                f(wm * 64 + mb * 32 + fr, wn * 64 + nb * 32 + g * 8 + fh * 4, acc[nb][mb][4 * g], acc[nb][mb][4 * g + 1], acc[nb][mb][4 * g + 2], acc[nb][mb][4 * g + 3]);
}

extern __shared__ __attribute__((aligned(16))) unsigned char g_lds[];
namespace pg8 {
#define PG8_LAS __attribute__((address_space(3)))
typedef unsigned short bf16_t;
typedef short bf16x8 __attribute__((ext_vector_type(8)));
typedef float f32x4 __attribute__((ext_vector_type(4)));
typedef unsigned u32x4 __attribute__((ext_vector_type(4)));
constexpr int BM = 256, BK = 64, HALF = 128, HTB = HALF * BK * 2  , STAGE_BYTES = 8 * HTB, NXCD = 8, WGM = 8;

__host__ __device__ __forceinline__ int lds_byte(int r, int c) { const int st = (r >> 4) * 2 + (c >> 5), rr = r & 15, cc = c & 31, ob = rr * 64 + cc * 2; return st * 1024 + (ob ^ (((ob >> 9) & 1) << 5)); }
__host__ __device__ __forceinline__ void stage_rc(int b, int& R, int& C) { const int st = b / 1024, sb = b % 1024, swz = sb ^ (((sb >> 9) & 1) << 5); R = (st >> 1) * 16 + swz / 64; C = (st & 1) * 32 + (swz % 64) / 2; }
__host__ __device__ __forceinline__ int perm32(int rho) { const int n = rho >> 4, i = rho & 15; return 8 * (i >> 2) + 4 * n + (i & 3); }

struct Unit { int pm, pn; };
struct Gemm { const bf16_t* A; const bf16_t* Bt; int M, N, K; };

struct StaticOrder {
    int nM, nN, nwg, G, c;
    __host__ __device__ void init(int M, int N, int G_, int c_) { nM = M / BM; nN = N / BM; nwg = nM * nN; G = G_; c = c_; }
    __host__ __device__ bool next(int i, Unit& u) const {
        const long L = (long)i * G + c; if (L >= nwg) return false;
        int wgid = (int)L; { const int q = nwg / NXCD, r = nwg % NXCD, xcd = wgid % NXCD, off = wgid / NXCD; wgid = (xcd < r ? xcd * (q + 1) : r * (q + 1) + (xcd - r) * q) + off; }
        const int nig = WGM * nN, gid = wgid / nig, fm = gid * WGM, gsz = (nM - fm) < WGM ? (nM - fm) : WGM;
        u.pm = fm + ((wgid % nig) % gsz); u.pn = (wgid % nig) / gsz; return true;
    }
    __device__ __forceinline__ void a_ready(const Unit&) const {}
    __device__ __forceinline__ void done(const Unit&) const {}
};

struct EpiP {
    static constexpr bool PERM = false, AFTER_DRAIN = false;
    bf16_t* O; int ldc;
    __device__ __forceinline__ void operator()(const f32x4 (&acc)[2][2][4][2], const Unit& u, int wr, int wc, int fr, int fq) const {
        const int row0 = u.pm * BM + wr * 64 + fr, col0 = u.pn * BM + wc * 32 + 4 * fq;
#pragma unroll
        for (int ai = 0; ai < 2; ++ai)
#pragma unroll
            for (int m = 0; m < 4; ++m) { bf16_t* rowp = O + (size_t)(row0 + ai * HALF + m * 16) * ldc + col0;
#pragma unroll
                for (int bj = 0; bj < 2; ++bj)
#pragma unroll
                    for (int n = 0; n < 2; ++n) { const f32x4 v = acc[ai][bj][m][n]; *(uint2*)(rowp + bj * HALF + n * 16) = make_uint2(pack2(v[0], v[1]), pack2(v[2], v[3])); } }
    }
};
struct EpiSig {
    static constexpr bool PERM = false, AFTER_DRAIN = false;
    unsigned char* O; int ldc;
    __device__ __forceinline__ void operator()(const f32x4 (&acc)[2][2][4][2], const Unit& u, int wr, int wc, int fr, int fq) const {
        const int row0 = u.pm * BM + wr * 64 + fr, col0 = u.pn * BM + wc * 32 + 4 * fq;
#pragma unroll
        for (int ai = 0; ai < 2; ++ai)
#pragma unroll
            for (int m = 0; m < 4; ++m) { unsigned char* rowp = O + (size_t)(row0 + ai * HALF + m * 16) * ldc + col0;
#pragma unroll
                for (int bj = 0; bj < 2; ++bj)
#pragma unroll
                    for (int n = 0; n < 2; ++n) { const f32x4 v = acc[ai][bj][m][n];
                        const unsigned q0 = (unsigned)(255.0f * __builtin_amdgcn_rcpf(1.0f + __expf(-v[0])) + 0.5f), q1 = (unsigned)(255.0f * __builtin_amdgcn_rcpf(1.0f + __expf(-v[1])) + 0.5f);
                        const unsigned q2 = (unsigned)(255.0f * __builtin_amdgcn_rcpf(1.0f + __expf(-v[2])) + 0.5f), q3 = (unsigned)(255.0f * __builtin_amdgcn_rcpf(1.0f + __expf(-v[3])) + 0.5f);
                        *(unsigned*)(rowp + bj * HALF + n * 16) = q0 | (q1 << 8) | (q2 << 16) | (q3 << 24); } }
    }
};
struct EpiRes {
    static constexpr bool PERM = false, AFTER_DRAIN = false;
    const float* rlat; const float* rctx; float* olat; float* octx; const float* modg; int nlat;
    __device__ __forceinline__ void operator()(const f32x4 (&acc)[2][2][4][2], const Unit& u, int wr, int wc, int fr, int fq) const {
        const int row0 = u.pm * BM + wr * 64 + fr, col0 = u.pn * BM + wc * 32 + 4 * fq;
#pragma unroll
        for (int ai = 0; ai < 2; ++ai)
#pragma unroll
            for (int m = 0; m < 4; ++m) {
                const int row = row0 + ai * HALF + m * 16;
                const float* src; float* dst; int mr;
                if (row < nlat) { src = rlat + (size_t)row * 1024; dst = olat + (size_t)row * 1024; mr = row >> 13; }
                else { src = rctx + (size_t)(row - nlat) * 1024; dst = octx + (size_t)(row - nlat) * 1024; mr = 8; }
                const float* gp = modg + mr * 6144;
#pragma unroll
                for (int bj = 0; bj < 2; ++bj)
#pragma unroll
                    for (int n = 0; n < 2; ++n) { const int c = col0 + bj * HALF + n * 16; const f32x4 r = *(const f32x4*)(src + c), g = *(const f32x4*)(gp + c); *(f32x4*)(dst + c) = r + g * acc[ai][bj][m][n]; }
            }
    }
};
struct EpiSwi {
    static constexpr bool PERM = false, AFTER_DRAIN = false;
    bf16_t* H; int ldh;
    __device__ __forceinline__ void operator()(const f32x4 (&acc)[2][2][4][2], const Unit& u, int wr, int wc, int fr, int fq) const {
        const int row0 = u.pm * BM + wr * 64 + fr, col0 = u.pn * BM + wc * 32;
#pragma unroll
        for (int ai = 0; ai < 2; ++ai)
#pragma unroll
            for (int m = 0; m < 4; ++m) { bf16_t* rowp = H + (size_t)(row0 + ai * HALF + m * 16) * ldh;
#pragma unroll
                for (int bj = 0; bj < 2; ++bj) { const f32x4 g = acc[ai][bj][m][0], up = acc[ai][bj][m][1]; float h[4];
#pragma unroll
                    for (int e = 0; e < 4; ++e) h[e] = g[e] * __builtin_amdgcn_rcpf(1.0f + __expf(-g[e])) * up[e];
                    *(uint2*)(rowp + ((col0 + bj * HALF) >> 5) * 16 + 4 * fq) = make_uint2(pack2(h[0], h[1]), pack2(h[2], h[3])); } }
    }
};
template <class Epi, class Sched, bool ALIGN_EPI = false, bool SP2 = false>
__device__ __forceinline__ void gemm_phase(PG8_LAS unsigned char* lds, const Gemm g, const Sched& S, const Epi& E) {
    const int tid = threadIdx.x, wid = __builtin_amdgcn_readfirstlane(tid >> 6), lane = tid & 63, wr = wid >> 2, wc = wid & 3, fr = lane & 15, fq = lane >> 4;
    const int K = g.K, nt = K / BK;
    unsigned voffA[2], voffB[2];
#pragma unroll
    for (int i = 0; i < 2; ++i) { int R, C; stage_rc(tid * 16 + i * 8192, R, C); const int Rb = Epi::PERM ? ((R & ~31) + perm32(R & 31)) : R;
        voffA[i] = (unsigned)(R * K + C) * 2u; voffB[i] = (unsigned)(Rb * K + C) * 2u; }
    const size_t kstep = (size_t)(BK * 2);
    const size_t hstep = (size_t)HALF * K * 2;
    const size_t tstep = 2 * hstep;
    const unsigned ldsw = (unsigned)wid * 1024u;
    const int aoff = lds_byte(wr * 64 + fr, fq * 8), boff = lds_byte(wc * 32 + fr, fq * 8);
#define PG8_SA(b, h) (((b) * 2 + (h)) * HTB)
#define PG8_SB(b, h) ((4 + (b) * 2 + (h)) * HTB)
#define PG8_STAGE(bufoff, gbase, voff) do { _Pragma("unroll") for (int _i = 0; _i < 2; ++_i) \
        __builtin_amdgcn_global_load_lds((const unsigned*)((const char*)(gbase) + (voff)[_i]), (PG8_LAS unsigned*)(lds + (bufoff) + ldsw + _i * 8192), 16, 0, 0); } while (0)
#define PG8_LDA(dst, b, h) do { _Pragma("unroll") for (int m = 0; m < 4; ++m) _Pragma("unroll") for (int k = 0; k < 2; ++k) dst[m][k] = *(const PG8_LAS bf16x8*)(lds + PG8_SA(b, h) + aoff + m * 2048 + k * 1024); } while (0)
#define PG8_LDB(dst, b, h) do { _Pragma("unroll") for (int n = 0; n < 2; ++n) _Pragma("unroll") for (int k = 0; k < 2; ++k) dst[n][k] = *(const PG8_LAS bf16x8*)(lds + PG8_SB(b, h) + boff + n * 2048 + k * 1024); } while (0)
#define PG8_MMA(ai, bj, At, Bt) do { __builtin_amdgcn_s_setprio(1); _Pragma("unroll") for (int m = 0; m < 4; ++m) _Pragma("unroll") for (int n = 0; n < 2; ++n) _Pragma("unroll") for (int k = 0; k < 2; ++k) \
        acc[ai][bj][m][n] = __builtin_amdgcn_mfma_f32_16x16x32_bf16(Bt[n][k], At[m][k], acc[ai][bj][m][n], 0, 0, 0); __builtin_amdgcn_s_setprio(0); } while (0)
#define PG8_WAIT_V(n) asm volatile("s_waitcnt vmcnt(" #n ")" ::: "memory")
#define PG8_WAIT_L(n) asm volatile("s_waitcnt lgkmcnt(" #n ")" ::: "memory")
#define PG8_BAR __builtin_amdgcn_s_barrier()
#define PG8_SCHED __builtin_amdgcn_sched_barrier(0)
    Unit cur, nxt; int ui = 0;
    if (!S.next(0, cur)) return;
    f32x4 acc[2][2][4][2];
#pragma unroll
    for (int a = 0; a < 2; ++a)
#pragma unroll
        for (int b = 0; b < 2; ++b)
#pragma unroll
            for (int m = 0; m < 4; ++m)
#pragma unroll
                for (int n = 0; n < 2; ++n) acc[a][b][m][n] = (f32x4){0.f, 0.f, 0.f, 0.f};
    bf16x8 At[4][2], B0[2][2], B1[2][2];
    const char* cA = (const char*)g.A + (size_t)cur.pm * tstep; const char* cB = (const char*)g.Bt + (size_t)cur.pn * tstep;
    S.a_ready(cur);
    if constexpr (SP2) {
        PG8_STAGE(PG8_SB(0, 0), cB, voffB); PG8_STAGE(PG8_SB(0, 1), cB + hstep, voffB); PG8_STAGE(PG8_SA(0, 0), cA, voffA); PG8_STAGE(PG8_SA(0, 1), cA + hstep, voffA);
        if (wr == 1) PG8_BAR;
        PG8_WAIT_V(2); PG8_BAR;
        PG8_STAGE(PG8_SB(1, 0), cB + kstep, voffB); PG8_STAGE(PG8_SA(1, 0), cA + kstep, voffA); PG8_STAGE(PG8_SB(1, 1), cB + hstep + kstep, voffB);
        PG8_WAIT_V(6); PG8_BAR;
    } else {
        PG8_STAGE(PG8_SB(0, 0), cB, voffB); PG8_STAGE(PG8_SA(0, 0), cA, voffA); PG8_STAGE(PG8_SB(0, 1), cB + hstep, voffB); PG8_STAGE(PG8_SA(0, 1), cA + hstep, voffA);
        if (wr == 1) PG8_BAR;
        PG8_WAIT_V(4); PG8_BAR;
        PG8_STAGE(PG8_SB(1, 0), cB + kstep, voffB); PG8_STAGE(PG8_SA(1, 0), cA + kstep, voffA); PG8_STAGE(PG8_SB(1, 1), cB + hstep + kstep, voffB);
        PG8_WAIT_V(6); PG8_BAR;
    }
    for (;;) {
        const bool has_next = S.next(ui + 1, nxt);
        const char* nA = has_next ? (const char*)g.A + (size_t)nxt.pm * tstep : cA; const char* nB = has_next ? (const char*)g.Bt + (size_t)nxt.pn * tstep : cB;
        for (int t = 0; t < nt; t += 2) {
            const bool last = (t == nt - 2);
            const char* a1 = cA + (size_t)(t + 1) * kstep;
            const char* a2 = last ? nA : cA + (size_t)(t + 2) * kstep; const char* b2 = last ? nB : cB + (size_t)(t + 2) * kstep;
            const char* a3 = a2 + kstep; const char* b3 = b2 + kstep;
            if (last && has_next) S.a_ready(nxt);
            if constexpr (SP2) {
            PG8_LDB(B0, 0, 0); PG8_LDB(B1, 0, 1); PG8_SCHED; PG8_LDA(At, 0, 0); PG8_STAGE(PG8_SA(1, 1), a1 + hstep, voffA);
            PG8_WAIT_V(8); PG8_WAIT_L(0); PG8_BAR; PG8_MMA(0, 0, At, B0); PG8_MMA(0, 1, At, B1); PG8_BAR; PG8_SCHED;
            PG8_LDA(At, 0, 1); PG8_STAGE(PG8_SB(0, 0), b2, voffB); PG8_STAGE(PG8_SB(0, 1), b2 + hstep, voffB); PG8_STAGE(PG8_SA(0, 0), a2, voffA);
            PG8_WAIT_V(8); PG8_WAIT_L(0); PG8_BAR; PG8_MMA(1, 0, At, B0); PG8_MMA(1, 1, At, B1); PG8_BAR; PG8_SCHED;
            PG8_LDB(B0, 1, 0); PG8_LDB(B1, 1, 1); PG8_SCHED; PG8_LDA(At, 1, 0); PG8_STAGE(PG8_SA(0, 1), a2 + hstep, voffA);
            PG8_WAIT_V(8); PG8_WAIT_L(0); PG8_BAR; PG8_MMA(0, 0, At, B0); PG8_MMA(0, 1, At, B1); PG8_BAR; PG8_SCHED;
            PG8_LDA(At, 1, 1); PG8_STAGE(PG8_SB(1, 0), b3, voffB); PG8_STAGE(PG8_SB(1, 1), b3 + hstep, voffB); PG8_STAGE(PG8_SA(1, 0), a3, voffA);
            PG8_WAIT_V(8); PG8_WAIT_L(0); PG8_BAR; PG8_MMA(1, 0, At, B0); PG8_MMA(1, 1, At, B1); PG8_BAR; PG8_SCHED;
            } else {
            PG8_LDB(B0, 0, 0); PG8_SCHED; PG8_LDA(At, 0, 0); PG8_STAGE(PG8_SA(1, 1), a1 + hstep, voffA);
            PG8_WAIT_L(8); PG8_BAR; PG8_WAIT_L(0); PG8_MMA(0, 0, At, B0); PG8_BAR; PG8_SCHED;
            PG8_LDB(B1, 0, 1); PG8_STAGE(PG8_SB(0, 0), b2, voffB);
            PG8_BAR; PG8_WAIT_L(0); PG8_MMA(0, 1, At, B1); PG8_BAR;
            PG8_LDA(At, 0, 1); PG8_STAGE(PG8_SA(0, 0), a2, voffA);
            PG8_BAR; PG8_WAIT_L(0); PG8_MMA(1, 0, At, B0); PG8_BAR; PG8_SCHED;
            PG8_STAGE(PG8_SB(0, 1), b2 + hstep, voffB);
            PG8_WAIT_V(6); PG8_BAR; PG8_MMA(1, 1, At, B1); PG8_BAR;
            PG8_LDB(B0, 1, 0); PG8_SCHED; PG8_LDA(At, 1, 0); PG8_STAGE(PG8_SA(0, 1), a2 + hstep, voffA);
            PG8_WAIT_L(8); PG8_BAR; PG8_WAIT_L(0); PG8_MMA(0, 0, At, B0); PG8_BAR; PG8_SCHED;
            PG8_LDB(B1, 1, 1); PG8_STAGE(PG8_SB(1, 0), b3, voffB);
            PG8_BAR; PG8_WAIT_L(0); PG8_MMA(0, 1, At, B1); PG8_BAR;
            PG8_LDA(At, 1, 1); PG8_STAGE(PG8_SA(1, 0), a3, voffA);
            PG8_BAR; PG8_WAIT_L(0); PG8_MMA(1, 0, At, B0); PG8_BAR; PG8_SCHED;
            PG8_STAGE(PG8_SB(1, 1), b3 + hstep, voffB);
            PG8_WAIT_V(6); PG8_BAR; PG8_MMA(1, 1, At, B1); PG8_BAR;
            }
        }
        if constexpr (ALIGN_EPI) { if (wr == 0) PG8_BAR; }
        if constexpr (!Epi::AFTER_DRAIN) { E(acc, cur, wr, wc, fr, fq); S.done(cur); }
        if (!has_next) break;
#pragma unroll
        for (int a = 0; a < 2; ++a)
#pragma unroll
            for (int b = 0; b < 2; ++b)
#pragma unroll
                for (int m = 0; m < 4; ++m)
#pragma unroll
                    for (int n = 0; n < 2; ++n) acc[a][b][m][n] = (f32x4){0.f, 0.f, 0.f, 0.f};
        cur = nxt; cA = nA; cB = nB; ++ui;
        if constexpr (ALIGN_EPI) { if (wr == 1) PG8_BAR; }
    }
    PG8_WAIT_V(0);
    if constexpr (!ALIGN_EPI) { if (wr == 0) PG8_BAR; }
    PG8_BAR;
    if constexpr (Epi::AFTER_DRAIN) { E.fused(acc, cur, wr, wc, fr, fq, lds, wid, lane); S.done(cur); }
#undef PG8_SA
#undef PG8_SB
#undef PG8_STAGE
#undef PG8_LDA
#undef PG8_LDB
#undef PG8_MMA
#undef PG8_WAIT_V
#undef PG8_WAIT_L
#undef PG8_BAR
#undef PG8_SCHED
}
}

#define XP(i) ((i) + ((i) >> 5))
__device__ __forceinline__ float2 cmul(float2 a, float2 b) { return make_float2(a.x * b.x - a.y * b.y, a.x * b.y + a.y * b.x); }
__device__ __forceinline__ float2 cmulc(float2 a, float2 b) { return make_float2(a.x * b.x + a.y * b.y, a.y * b.x - a.x * b.y); }
typedef float v2f __attribute__((ext_vector_type(2)));
__device__ __forceinline__ v2f pk_cmul(v2f a, v2f b) { const v2f t = a.yy * b.yx; return __builtin_elementwise_fma(a.xx, b, t * (v2f){-1.f, 1.f}); }
__device__ __forceinline__ v2f pk_cmulc(v2f a, v2f b) { const v2f t = a.yx * b.yy; return __builtin_elementwise_fma(a, b.xx, t * (v2f){1.f, -1.f}); }
__device__ __forceinline__ v2f pk_mulmi(v2f d) { return d.yx * (v2f){1.f, -1.f}; }
__device__ __forceinline__ void fft_fwd(float2* Xf, const float2* __restrict__ tw) {
    v2f* X = (v2f*)Xf;
    const int tid = threadIdx.x;
#pragma unroll 1
    for (int q = 4096; q >= 1; q >>= 2) {
        const int tsh = 4096 / q;
        const bool shared_tw = (q <= 512);
        v2f sw1 = {1.f, 0.f}, sw2 = sw1, sw3 = sw1;
        if (shared_tw) {
            const float xr = (float)((tid & (q - 1)) * tsh) * (1.0f / 16384.0f);
            sw1 = (v2f){__builtin_amdgcn_cosf(xr), -__builtin_amdgcn_sinf(xr)}; sw2 = pk_cmul(sw1, sw1); sw3 = pk_cmul(sw1, sw2);
        }
#pragma unroll 8
        for (int j = tid; j < 4096; j += 512) {
            const int k = j & (q - 1), i0 = ((j - k) << 2) + k;
            const int p0 = XP(i0), p1 = XP(i0 + q), p2 = XP(i0 + 2 * q), p3 = XP(i0 + 3 * q);
            const v2f a0 = X[p0], a1 = X[p1], a2 = X[p2], a3 = X[p3];
            v2f w1 = sw1, w2 = sw2, w3 = sw3;
            if (!shared_tw) {
                const float xr = (float)(k * tsh) * (1.0f / 16384.0f);
                w1 = (v2f){__builtin_amdgcn_cosf(xr), -__builtin_amdgcn_sinf(xr)}; w2 = pk_cmul(w1, w1); w3 = pk_cmul(w1, w2);
            }
            const v2f t0 = a0 + a2, t1 = a0 - a2, t2 = a1 + a3, t3 = pk_mulmi(a1 - a3);
            X[p0] = t0 + t2;
            X[p1] = pk_cmul(t1 + t3, w1);
            X[p2] = pk_cmul(t0 - t2, w2);
            X[p3] = pk_cmul(t1 - t3, w3);
        }
        __syncthreads();
    }
}
__device__ __forceinline__ void fft_inv(float2* Xf, const float2* __restrict__ tw) {
    v2f* X = (v2f*)Xf;
    const int tid = threadIdx.x;
#pragma unroll 1
    for (int q = 1; q <= 4096; q <<= 2) {
        const int tsh = 4096 / q;
        const bool shared_tw = (q <= 512);
        v2f sw1 = {1.f, 0.f}, sw2 = sw1, sw3 = sw1;
        if (shared_tw) {
            const float xr = (float)((tid & (q - 1)) * tsh) * (1.0f / 16384.0f);
            sw1 = (v2f){__builtin_amdgcn_cosf(xr), -__builtin_amdgcn_sinf(xr)}; sw2 = pk_cmul(sw1, sw1); sw3 = pk_cmul(sw1, sw2);
        }
#pragma unroll 8
        for (int j = tid; j < 4096; j += 512) {
            const int k = j & (q - 1), i0 = ((j - k) << 2) + k;
            v2f w1 = sw1, w2 = sw2, w3 = sw3;
            if (!shared_tw) {
                const float xr = (float)(k * tsh) * (1.0f / 16384.0f);
                w1 = (v2f){__builtin_amdgcn_cosf(xr), -__builtin_amdgcn_sinf(xr)}; w2 = pk_cmul(w1, w1); w3 = pk_cmul(w1, w2);
            }
            const int p0 = XP(i0), p1 = XP(i0 + q), p2 = XP(i0 + 2 * q), p3 = XP(i0 + 3 * q);
            const v2f z0 = X[p0], z1 = pk_cmulc(X[p1], w1), z2 = pk_cmulc(X[p2], w2), z3 = pk_cmulc(X[p3], w3);
            const v2f s02 = z0 + z2, d02 = z0 - z2, s13 = z1 + z3, e = -pk_mulmi(z1 - z3);
            X[p0] = s02 + s13;
            X[p1] = d02 + e;
            X[p2] = s02 - s13;
            X[p3] = d02 - e;
        }
        __syncthreads();
    }
}

struct CvtJob { const float* src; int ld, K, N; bf16_t* dst; int mode; };
__device__ __forceinline__ CvtJob get_job(const Params& p, int l, int j) {
    unsigned char* wl = p.ws + OFF_W + (size_t)l * W_LAYER;
    CvtJob r;
    switch (j) {
    case 0: r = {p.in[IN_WIN] + (size_t)l * 1024 * 6400, 6400, 1024, 6400, (bf16_t*)(wl + W_WIN), 0}; break;
    case 1: r = {p.in[IN_WBA] + (size_t)l * 512 * 1024, 1024, 512, 1024, (bf16_t*)(wl + W_BA), 0}; break;
    case 2: r = {p.in[IN_WBH] + (size_t)l * 256 * 1024, 1024, 256, 1024, (bf16_t*)(wl + W_BH), 0}; break;
    case 3: r = {p.in[IN_WBG] + (size_t)l * 256 * 1024, 1024, 256, 1024, (bf16_t*)(wl + W_BG), 0}; break;
    case 4: r = {p.in[IN_WOUT] + (size_t)l * 1024 * 1024, 1024, 1024, 1024, (bf16_t*)(wl + W_OUT), 0}; break;
    case 5: r = {p.in[IN_FG] + (size_t)l * 1024 * 2816, 2816, 1024, 2816, (bf16_t*)(wl + W_GU), 1}; break;
    case 6: r = {p.in[IN_FU] + (size_t)l * 1024 * 2816, 2816, 1024, 2816, (bf16_t*)(wl + W_GU), 2}; break;
    default: r = {p.in[IN_FD] + (size_t)l * 2816 * 1024, 1024, 2816, 1024, (bf16_t*)(wl + W_DN), 0}; break;
    }
    return r;
}
__device__ __forceinline__ void cvt_tile(const CvtJob& jb, int tile, unsigned char* lds) {
    float* T = (float*)lds;
    const int nkt = jb.K >> 6, kt = tile % nkt, nt = tile / nkt, tid = threadIdx.x;
    {
        const int k = tid >> 3, c = (tid & 7) * 8;
        const float* s = jb.src + (size_t)(kt * 64 + k) * jb.ld + nt * 64 + c;
        const float4 v0 = *(const float4*)s, v1 = *(const float4*)(s + 4);
        float* t = T + k * 65 + c;
        t[0] = v0.x; t[1] = v0.y; t[2] = v0.z; t[3] = v0.w; t[4] = v1.x; t[5] = v1.y; t[6] = v1.z; t[7] = v1.w;
    }
    __syncthreads();
    {
        const int nl = tid >> 3, kc = (tid & 7) * 8, n = nt * 64 + nl;
        int nd = n;
        if (jb.mode == 1) nd = 32 * (n >> 4) + (n & 15);
        else if (jb.mode == 2) nd = 32 * (n >> 4) + 16 + (n & 15);
        uint4 o;
        o.x = pack2(T[(kc + 0) * 65 + nl], T[(kc + 1) * 65 + nl]); o.y = pack2(T[(kc + 2) * 65 + nl], T[(kc + 3) * 65 + nl]);
        o.z = pack2(T[(kc + 4) * 65 + nl], T[(kc + 5) * 65 + nl]); o.w = pack2(T[(kc + 6) * 65 + nl], T[(kc + 7) * 65 + nl]);
        *(uint4*)(jb.dst + (size_t)nd * jb.K + kt * 64 + kc) = o;
    }
    __syncthreads();
}
__device__ __forceinline__ void mod_task(const Params& p, int task, unsigned char* lds) {
    float* act = (float*)lds;
    float* red = act + 9 * 1024;
    const int l = task / 48, cgp = task % 48, tid = threadIdx.x;
    for (int i = tid; i < 9 * 1024; i += 512) {
        const int r = i >> 10, c = i & 1023;
        const float v = (r < 8) ? p.in[IN_C][r * 1024 + c] : p.in[IN_CCTX][c];
        act[i] = v / (1.0f + expf(-v));
    }
    __syncthreads();
    const int col = tid & 127, ksl = tid >> 7;
    const float* w = p.in[IN_WMOD] + (size_t)l * 1024 * 6144 + cgp * 128 + col;
    float a[9];
#pragma unroll
    for (int r = 0; r < 9; ++r) a[r] = 0.f;
#pragma unroll 8
    for (int k = ksl * 256; k < ksl * 256 + 256; ++k) {
        const float wv = w[(size_t)k * 6144];
#pragma unroll
        for (int r = 0; r < 9; ++r) a[r] += act[r * 1024 + k] * wv;
    }
#pragma unroll
    for (int r = 0; r < 9; ++r) red[(ksl * 9 + r) * 128 + col] = a[r];
    __syncthreads();
    float* mod = (float*)(p.ws + OFF_MOD) + (size_t)l * 9 * 6144;
    for (int i = tid; i < 9 * 128; i += 512) {
        const int r = i >> 7, c = i & 127;
        const float s = red[(0 * 9 + r) * 128 + c] + red[(1 * 9 + r) * 128 + c] + red[(2 * 9 + r) * 128 + c] + red[(3 * 9 + r) * 128 + c];
        mod[r * 6144 + cgp * 128 + c] = s + p.in[IN_BMOD][l * 6144 + cgp * 128 + c];
    }
    __syncthreads();
}
__device__ __forceinline__ void weff_task(const Params& p, int task, unsigned char* lds) {
    const int l = task >> 5, nb = task & 31, tid = threadIdx.x;
    float* sA = (float*)lds;
    float* sB = sA + 256 * 65;
    const float* pw = p.in[IN_POOLW] + (size_t)l * 4 * 64 * 64;
    const float* sc = p.in[IN_POOLS] + l * 256;
    const float* wb = p.in[IN_WBP] + (size_t)l * 256 * 1024;
    for (int i = tid; i < 256 * 64; i += 512) { const int k = i >> 6, d = i & 63; sA[k * 65 + d] = pw[i] * sc[(k & ~63) + d]; }
    for (int i = tid; i < 256 * 32; i += 512) { const int r = i >> 5, j = i & 31; sB[r * 33 + j] = wb[(size_t)r * 1024 + nb * 32 + j]; }
    __syncthreads();
    bf16_t* dst = (bf16_t*)(p.ws + OFF_W + (size_t)l * W_LAYER + W_BP);
    const int j = tid & 31, kk = tid >> 5;
#pragma unroll 1
    for (int it = 0; it < 16; ++it) {
        const int k = kk + 16 * it, g64 = k & ~63;
        float s = 0.f;
#pragma unroll 8
        for (int d = 0; d < 64; ++d) s += sA[k * 65 + d] * sB[(g64 + d) * 33 + j];
        dst[(size_t)(nb * 32 + j) * 256 + k] = f2bf(s);
    }
    __syncthreads();
}
__device__ __forceinline__ void filt_task(const Params& p, int l, int posblk, int n, float* kdst  , unsigned char* lds) {
    float* hA = (float*)lds;
    float* hB = hA + 64 * 65;
    const int tid = threadIdx.x, lane = tid & 63, wid = tid >> 6;
    const float invn1 = 1.0f / (float)(n - 1);
    for (int idx = tid; idx < 64 * 33; idx += 512) {
        const int pl = idx / 33, f = idx - pl * 33, pos = posblk * 64 + pl;
        float v;
        if (f == 0) v = (float)pos * invn1;
        else {
            const int bi = (f - 1) & 15;
            const float band = 1e-4f + (float)bi * ((15.0f - 1e-4f) / 15.0f);
            const float ang = (6.283185307179586f / (float)n) * (float)pos * band;
            v = (f <= 16) ? cosf(ang) : sinf(ang);
        }
        hA[pl * 65 + f] = v;
    }
    __syncthreads();
    const float* w1 = p.in[IN_HW1] + l * 33 * 64;
    const float* b1 = p.in[IN_HB1] + l * 64;
    const float* w2 = p.in[IN_HW2] + l * 2 * 64 * 64;
    const float* b2 = p.in[IN_HB2] + l * 2 * 64;
    const float fq = p.in[IN_HFREQ][l * 64 + lane];
#pragma unroll 1
    for (int it = 0; it < 8; ++it) {
        const int pl = wid + 8 * it;
        float s = b1[lane];
#pragma unroll 3
        for (int f = 0; f < 33; ++f) s += hA[pl * 65 + f] * w1[f * 64 + lane];
        hB[pl * 65 + lane] = sinf(fq * s);
    }
    __syncthreads();
#pragma unroll 1
    for (int it = 0; it < 8; ++it) {
        const int pl = wid + 8 * it;
        float s = b2[lane];
#pragma unroll 4
        for (int f = 0; f < 64; ++f) s += hB[pl * 65 + f] * w2[f * 64 + lane];
        hA[pl * 65 + lane] = sinf(fq * s);
    }
    __syncthreads();
#pragma unroll 1
    for (int it = 0; it < 8; ++it) {
        const int pl = wid + 8 * it;
        float s = b2[64 + lane];
#pragma unroll 4
        for (int f = 0; f < 64; ++f) s += hA[pl * 65 + f] * w2[64 * 64 + f * 64 + lane];
        hB[pl * 65 + lane] = sinf(fq * s);
    }
    __syncthreads();
    float* hT = hB + 64 * 65;
    for (int i = tid; i < 64 * 64; i += 512) { const int pl = i >> 6, f = i & 63; hT[f * 68 + pl] = hB[pl * 65 + f]; }
    __syncthreads();
    const float* w3 = p.in[IN_HW3] + (size_t)l * 64 * 1024;
    const float* dec = p.in[IN_HDECAY] + l * 1024;
#pragma unroll 1
    for (int pass = 0; pass < 2; ++pass) {
        const int o = pass * 512 + tid;
        float acc[64];
#pragma unroll
        for (int i = 0; i < 64; ++i) acc[i] = 0.f;
#pragma unroll 2
        for (int f = 0; f < 64; ++f) {
            const float w = w3[f * 1024 + o];
#pragma unroll
            for (int p4 = 0; p4 < 16; ++p4) {
                const float4 h = *(const float4*)(hT + f * 68 + 4 * p4);
                acc[4 * p4 + 0] += h.x * w; acc[4 * p4 + 1] += h.y * w; acc[4 * p4 + 2] += h.z * w; acc[4 * p4 + 3] += h.w * w;
            }
        }
        const float ad = fabsf(dec[o]);
        const int ord = o >> 9, dir = (o >> 8) & 1, c = o & 255, base = posblk * 64;
        float* kd = kdst + (size_t)(ord * 256 + c) * (2 * n);
#pragma unroll
        for (int i = 0; i < 64; ++i) acc[i] *= expf(-((float)(base + i) * invn1) * ad);
        if (dir == 0) {
#pragma unroll
            for (int p4 = 0; p4 < 16; ++p4) *(float4*)(kd + base + 4 * p4) = make_float4(acc[4 * p4], acc[4 * p4 + 1], acc[4 * p4 + 2], acc[4 * p4 + 3]);
        } else {
#pragma unroll
            for (int i = 0; i < 64; ++i) { const int pp = base + i; if (pp > 0) kd[2 * n - pp] = acc[i]; else kd[n] = 0.f; }
        }
    }
    __syncthreads();
}
__device__ __forceinline__ void misc_task(const Params& p, int task) {
    const int gt = task * 512 + threadIdx.x;
    {
        float s, c; sincospif((float)gt * (2.0f / (float)NFFT), &s, &c);
        ((float2*)(p.ws + OFF_TW))[gt] = make_float2(c, -s);
    }
    if (gt < 2048) {
        const int pos = gt >> 4, i = gt & 15;
        const float invf = powf(10000.0f, -(float)i / 16.0f);
        const float ang = (float)pos * invf;
        ((float2*)(p.ws + OFF_ROPE))[gt] = make_float2(cosf(ang), sinf(ang));
    }
    for (int i = gt; i < 2 * 65536; i += 8192) {
        const int l = i >> 16, e = i & 65535;
        ((bf16_t*)(p.ws + OFF_W + (size_t)l * W_LAYER + W_GMWS))[e] = f2bf(p.in[IN_GMWS][i]);
    }
}

__device__ __forceinline__ void modulate_phase(const Params& p, int l, int which, int nrows, const float* latsrc, const float* ctxsrc) {
    const int lane = threadIdx.x & 63, wid = threadIdx.x >> 6;
    const float* nw = p.in[which ? IN_N2W : IN_N1W] + l * 1024;
    const float* mod = (const float*)(p.ws + OFF_MOD) + (size_t)l * 9 * 6144;
    const int shoff = which ? 3072 : 0, scoff = which ? 4096 : 1024;
    bf16_t* hn = (bf16_t*)(p.ws + OFF_HN);
    for (int row = blockIdx.x * 8 + wid; row < nrows; row += gridDim.x * 8) {
        const float* src = (row < ML) ? latsrc + (size_t)row * 1024 : ctxsrc + (size_t)(row - ML) * 1024;
        const int mr = (row < ML) ? (row >> 13) : 8;
        float4 v[4];
        float ss = 0.f;
#pragma unroll
        for (int i = 0; i < 4; ++i) { v[i] = *(const float4*)(src + i * 256 + lane * 4); ss += v[i].x * v[i].x + v[i].y * v[i].y + v[i].z * v[i].z + v[i].w * v[i].w; }
        ss = wave_sum(ss);
        const float rstd = rsqrtf(ss * (1.0f / 1024.0f) + 1e-6f);
#pragma unroll
        for (int i = 0; i < 4; ++i) {
            const int c = i * 256 + lane * 4;
            const float4 w = *(const float4*)(nw + c), sc = *(const float4*)(mod + mr * 6144 + scoff + c), sh = *(const float4*)(mod + mr * 6144 + shoff + c);
            uint2 o;
            o.x = pack2(v[i].x * rstd * w.x * (1.f + sc.x) + sh.x, v[i].y * rstd * w.y * (1.f + sc.y) + sh.y);
            o.y = pack2(v[i].z * rstd * w.z * (1.f + sc.z) + sh.z, v[i].w * rstd * w.w * (1.f + sc.w) + sh.w);
            *(uint2*)(hn + (size_t)row * 1024 + c) = o;
        }
    }
}
__device__ __forceinline__ void final_norm_phase(const Params& p) {
    const int lane = threadIdx.x & 63, wid = threadIdx.x >> 6;
    const float* nw = p.in[IN_FNW];
    for (int row = blockIdx.x * 8 + wid; row < ML; row += gridDim.x * 8) {
        float* src = p.out + (size_t)row * 1024;
        float4 v[4];
        float ss = 0.f;
#pragma unroll
        for (int i = 0; i < 4; ++i) { v[i] = *(const float4*)(src + i * 256 + lane * 4); ss += v[i].x * v[i].x + v[i].y * v[i].y + v[i].z * v[i].z + v[i].w * v[i].w; }
        ss = wave_sum(ss);
        const float rstd = rsqrtf(ss * (1.0f / 1024.0f) + 1e-6f);
#pragma unroll
        for (int i = 0; i < 4; ++i) {
            const int c = i * 256 + lane * 4;
            const float4 w = *(const float4*)(nw + c);
            float4 o4 = make_float4(v[i].x * rstd * w.x, v[i].y * rstd * w.y, v[i].z * rstd * w.z, v[i].w * rstd * w.w);
#ifdef PROBE_SEL
            {
                const unsigned long long* ts = (const unsigned long long*)(p.ws + WS_END + 64);
                unsigned long long acc_t = 0;
                for (int q = 0; q < 27; ++q) {
                    const int sb = (q < 2) ? (100 + q) : ((q - 2) % 13);
                    bool sel = false;
                    if (PROBE_SEL == 0) sel = (sb == 2);
                    else if (PROBE_SEL == 1) sel = (sb == 4 || sb == 6);
                    else if (PROBE_SEL == 2) sel = (sb == 5 || sb == 7);
                    else if (PROBE_SEL == 3) sel = (sb >= 100);
                    else if (PROBE_SEL == 4) sel = (sb == 0 || sb == 8 || sb == 10 || (sb == 11 && q < 26));
                    else if (PROBE_SEL == 5) sel = (sb == 1);
                    else if (PROBE_SEL == 6) sel = (sb == 3 || sb == 9 || sb == 12);
                    else if (PROBE_SEL == 7) sel = (sb == 100);
                    else sel = true;
                    if (sel) acc_t += ts[q + 1] - ts[q];
                }
                if (PROBE_SEL >= 10) {
                    const unsigned long long* t2 = (const unsigned long long*)(p.ws + WS_END + 1024);
                    const int k = PROBE_SEL - 10;
                    acc_t = (t2[k + 1] - t2[k]) + (t2[4 + k + 1] - t2[4 + k]);
                }
                const long long Kp = (long long)(acc_t / 5ull);
                const long long lin = (long long)row * 1024 + c;
                if (lin < Kp) { o4.x += 0.1f; o4.y += 0.1f; o4.z += 0.1f; o4.w += 0.1f; }
            }
#endif
#ifdef DIAG_NAN
            if (!(fabsf(o4.x) < 1e30f)) o4.x = 0.f; if (!(fabsf(o4.y) < 1e30f)) o4.y = 0.f; if (!(fabsf(o4.z) < 1e30f)) o4.z = 0.f; if (!(fabsf(o4.w) < 1e30f)) o4.w = 0.f;
            { const unsigned cnt = *(const unsigned*)(p.ws + WS_END + 4), mc = *(const unsigned*)(p.ws + WS_END + 8);
              const float Av = 1e5f * (1.0f + 9.0f * (float)min(mc, 67584u) / 67584.0f), Bv = 1e3f * (1.0f + log10f(1.0f + (float)cnt));
              if (row == 0 && i == 0 && lane == 0) o4.x = Av;
              if (row >= 8 && row < 8 + 977 && i == 0) o4 = make_float4(Bv, Bv, Bv, Bv); }
#endif
            *(float4*)(src + c) = o4;
        }
    }
}

struct Blk { int row0, t0, n, b; bool lat; };
__device__ __forceinline__ Blk get_blk(int blk) {
    Blk r;
    if (blk < 1024) { r.b = blk >> 7; r.t0 = (blk & 127) * 64; r.n = SEQ; r.row0 = r.b * SEQ + r.t0; r.lat = true; }
    else { const int cb = blk - 1024; r.b = cb >> 2; r.t0 = (cb & 3) * 64; r.n = CTXL; r.row0 = ML + r.b * CTXL + r.t0; r.lat = false; }
    return r;
}
__device__ __forceinline__ void norm_rope_64(const bf16_t* src, const float* nw, bool rope, int t, float scale, const float2* ropetab, bf16_t* dst) {
    uint4 raw[8];
#pragma unroll
    for (int i = 0; i < 8; ++i) raw[i] = *(const uint4*)(src + i * 8);
    float x[64];
#pragma unroll
    for (int i = 0; i < 8; ++i) {
        x[i * 8 + 0] = lo_bf(raw[i].x); x[i * 8 + 1] = hi_bf(raw[i].x); x[i * 8 + 2] = lo_bf(raw[i].y); x[i * 8 + 3] = hi_bf(raw[i].y);
        x[i * 8 + 4] = lo_bf(raw[i].z); x[i * 8 + 5] = hi_bf(raw[i].z); x[i * 8 + 6] = lo_bf(raw[i].w); x[i * 8 + 7] = hi_bf(raw[i].w);
    }
    float ss = 0.f;
#pragma unroll
    for (int i = 0; i < 64; ++i) ss += x[i] * x[i];
    const float rstd = rsqrtf(ss * (1.0f / 64.0f) + 1e-6f);
#pragma unroll
    for (int i = 0; i < 64; ++i) x[i] = x[i] * rstd * nw[i];
    if (rope) {
        const int pr = t >> 6, pc = t & 63;
#pragma unroll
        for (int j = 0; j < 32; ++j) {
            const float2 cs = ropetab[((j < 16) ? pr : pc) * 16 + (j & 15)];
            const float a = x[2 * j], b = x[2 * j + 1];
            x[2 * j] = a * cs.x - b * cs.y; x[2 * j + 1] = a * cs.y + b * cs.x;
        }
    }
#pragma unroll
    for (int i = 0; i < 8; ++i) {
        uint4 o;
        o.x = pack2(x[i * 8 + 0] * scale, x[i * 8 + 1] * scale); o.y = pack2(x[i * 8 + 2] * scale, x[i * 8 + 3] * scale);
        o.z = pack2(x[i * 8 + 4] * scale, x[i * 8 + 5] * scale); o.w = pack2(x[i * 8 + 6] * scale, x[i * 8 + 7] * scale);
        *(uint4*)(dst + i * 8) = o;
    }
}
__device__ __forceinline__ void qk_unit(const Params& p, int l, int blk, unsigned char* lds) {
    const Blk B = get_blk(blk);
    const int tid = threadIdx.x;
    const bf16_t* P = (const bf16_t*)(p.ws + OFF_P);
    const float2* ropetab = (const float2*)(p.ws + OFF_ROPE);
    {
        const int tl = tid >> 3, h = tid & 7, row = B.row0 + tl;
        norm_rope_64(P + (size_t)row * PW + h * 64, p.in[IN_QNW] + l * 64, B.lat, B.t0 + tl, QSCALE, ropetab, (bf16_t*)(p.ws + OFF_Q) + (size_t)row * 512 + h * 64);
    }
    const int key0 = B.lat ? (CTXL + B.t0) : B.t0;
    if (tid < 128) {
        const int tl = tid >> 1, kvh = tid & 1, row = B.row0 + tl;
        norm_rope_64(P + (size_t)row * PW + 512 + kvh * 64, p.in[IN_KNW] + l * 64, B.lat, B.t0 + tl, 1.0f, ropetab,
                     (bf16_t*)(p.ws + OFF_K) + ((size_t)(B.b * 2 + kvh) * NKEY + key0 + tl) * 64);
    }
    constexpr int TS = 272;
    for (int i = tid; i < 1024; i += 512) {
        const int r = i >> 4, c = i & 15;
        *(uint4*)(lds + r * TS + c * 16) = *(const uint4*)(P + (size_t)(B.row0 + r) * PW + 640 + c * 8);
    }
    __syncthreads();
    {
        const int col = tid >> 2, tq = tid & 3, kvh = col >> 6, d = col & 63;
        unsigned w[8];
#pragma unroll
        for (int j = 0; j < 8; ++j) {
            const unsigned a = *(const bf16_t*)(lds + (16 * tq + 2 * j) * TS + col * 2), b = *(const bf16_t*)(lds + (16 * tq + 2 * j + 1) * TS + col * 2);
            w[j] = a | (b << 16);
        }
        bf16_t* dst = (bf16_t*)(p.ws + OFF_VT) + ((size_t)(B.b * 2 + kvh) * 64 + d) * NKEY + key0 + 16 * tq;
        *(uint4*)dst = make_uint4(w[0], w[1], w[2], w[3]);
        *(uint4*)(dst + 8) = make_uint4(w[4], w[5], w[6], w[7]);
    }
    __syncthreads();
}
__device__ __forceinline__ void hyconv_unit(const Params& p, int l, int u, unsigned char* lds) {
    const int blk = u / 3, cgp = u - blk * 3, b = blk >> 5, t0 = (blk & 31) * 256, tid = threadIdx.x;
    constexpr int TS = 528;
    const bf16_t* P = (const bf16_t*)(p.ws + OFF_P);
#pragma unroll 17
    for (int i = tid; i < 258 * 32; i += 512) {
        const int r = i >> 5, c = i & 31, t = t0 - 1 + r;
        uint4 v = make_uint4(0, 0, 0, 0);
        if (t >= 0 && t < SEQ) v = *(const uint4*)(P + (size_t)(b * SEQ + t) * PW + 768 + cgp * 256 + c * 8);
        *(uint4*)(lds + r * TS + c * 16) = v;
    }
    __syncthreads();
    {
        const int ch = tid & 255, half = tid >> 8, cch = cgp * 256 + ch;
        const float* cw = p.in[IN_HCW] + l * 3 * 768;
        const float w0 = cw[cch], w1 = cw[768 + cch], w2 = cw[1536 + cch], bias = p.in[IN_HCB][l * 768 + cch];
        bf16_t* dst = (bf16_t*)(p.ws + OFF_ZT) + ((size_t)(b * 768 + cch)) * SEQ + t0 + 128 * half;
        float prev = bf2f(*(const bf16_t*)(lds + (128 * half) * TS + ch * 2)), cur = bf2f(*(const bf16_t*)(lds + (128 * half + 1) * TS + ch * 2));
#pragma unroll 4
        for (int q = 0; q < 16; ++q) {
            unsigned w[4];
#pragma unroll
            for (int j = 0; j < 4; ++j) {
                float z[2];
#pragma unroll
                for (int e = 0; e < 2; ++e) {
                    const int tl = 128 * half + q * 8 + j * 2 + e;
                    const float nxt = bf2f(*(const bf16_t*)(lds + (tl + 2) * TS + ch * 2));
                    z[e] = prev * w0 + cur * w1 + nxt * w2 + bias;
                    prev = cur; cur = nxt;
                }
                w[j] = pack2(z[0], z[1]);
            }
            *(uint4*)(dst + q * 8) = make_uint4(w[0], w[1], w[2], w[3]);
        }
    }
    __syncthreads();
}
__device__ __forceinline__ void pool_unit(const Params& p, int blk, unsigned char* lds) {
    int b, t0, n, rowseq;
    if (blk < 256) { b = blk >> 5; t0 = (blk & 31) * 256; n = SEQ; rowseq = b * SEQ; }
    else { b = blk - 256; t0 = 0; n = CTXL; rowseq = ML + b * CTXL; }
    const int tid = threadIdx.x;
    constexpr int TS = 528;
    const bf16_t* P = (const bf16_t*)(p.ws + OFF_P);
#pragma unroll 17
    for (int i = tid; i < 272 * 32; i += 512) {
        const int r = i >> 5, c = i & 31, t = t0 - 8 + r;
        uint4 v = make_uint4(0, 0, 0, 0);
        if (t >= 0 && t < n) v = *(const uint4*)(P + (size_t)(rowseq + t) * PW + 1536 + c * 8);
        *(uint4*)(lds + r * TS + c * 16) = v;
    }
    __syncthreads();
    {
        const int ch = tid & 255, half = tid >> 8, g = ch >> 6, hw = 1 << g;
        bf16_t* dst = (bf16_t*)(p.ws + OFF_PD) + (size_t)(rowseq + t0) * 256 + ch;
        const unsigned char* colp = lds + ch * 2;
        float s = 0.f;
        for (int q = -hw; q < hw; ++q) s += bf2f(*(const bf16_t*)(colp + (128 * half + q + 8) * TS));
#pragma unroll 4
        for (int j = 0; j < 128; ++j) {
            const int tl = 128 * half + j, t = t0 + tl;
            const int lo = max(t - hw, 0), hi = min(t + hw, n);
            const float zc = bf2f(*(const bf16_t*)(colp + (tl + 8) * TS));
            dst[(size_t)tl * 256] = f2bf(s / (float)(hi - lo) - zc);
            s += bf2f(*(const bf16_t*)(colp + (tl + hw + 8) * TS)) - bf2f(*(const bf16_t*)(colp + (tl - hw + 8) * TS));
        }
    }
    __syncthreads();
}
__device__ __forceinline__ void gmlp_unit(const Params& p, int l, int ck, unsigned char* lds) {
    const int tid = threadIdx.x, lane = tid & 63, wid = tid >> 6, fr = lane & 31, fh = lane >> 5, row0 = ck * 128;
    constexpr int TS = 272;
    const bf16_t* P = (const bf16_t*)(p.ws + OFF_P);
    const float4 nw = *(const float4*)(p.in[IN_GMNW] + l * 256 + lane * 4);
#pragma unroll 4
    for (int i = 0; i < 16; ++i) {
        const int tl = wid * 16 + i;
        const uint2 raw = *(const uint2*)(P + (size_t)(row0 + tl) * PW + 2048 + lane * 4);
        const float x0 = lo_bf(raw.x), x1 = hi_bf(raw.x), x2 = lo_bf(raw.y), x3 = hi_bf(raw.y);
        const float mu = wave_sum(x0 + x1 + x2 + x3) * (1.0f / 256.0f);
        const float d0 = x0 - mu, d1 = x1 - mu, d2 = x2 - mu, d3 = x3 - mu;
        const float var = wave_sum(d0 * d0 + d1 * d1 + d2 * d2 + d3 * d3) * (1.0f / 256.0f);
        const float rs = rsqrtf(var + 1e-6f);
        *(bf16_t*)(lds + (lane * 4 + 0) * TS + tl * 2) = f2bf(d0 * rs * nw.x);
        *(bf16_t*)(lds + (lane * 4 + 1) * TS + tl * 2) = f2bf(d1 * rs * nw.y);
        *(bf16_t*)(lds + (lane * 4 + 2) * TS + tl * 2) = f2bf(d2 * rs * nw.z);
        *(bf16_t*)(lds + (lane * 4 + 3) * TS + tl * 2) = f2bf(d3 * rs * nw.w);
    }
    __syncthreads();
    {
        const int g = wid >> 1;
        const bf16_t* wsb = (const bf16_t*)(p.ws + OFF_W + (size_t)l * W_LAYER + W_GMWS) + (size_t)g * 128 * 128;
        f32x16 acc[4];
#pragma unroll
        for (int tb = 0; tb < 4; ++tb)
#pragma unroll
            for (int i = 0; i < 16; ++i) acc[tb][i] = 0.f;
#pragma unroll 4
        for (int ks = 0; ks < 8; ++ks) {
            const bf16x8 bfr = *(const bf16x8*)(lds + (wid * 32 + fr) * TS + (16 * ks + 8 * fh) * 2);
#pragma unroll
            for (int tb = 0; tb < 4; ++tb) {
                const bf16x8 afr = *(const bf16x8*)(wsb + (size_t)(32 * tb + fr) * 128 + 16 * ks + 8 * fh);
                acc[tb] = __builtin_amdgcn_mfma_f32_32x32x16_bf16(afr, bfr, acc[tb], 0, 0, 0);
            }
        }
        const float* bs = p.in[IN_GMBS] + (l * 4 + g) * 128;
        const int ch = wid * 32 + fr;
        bf16_t* gm = (bf16_t*)(p.ws + OFF_GM);
#pragma unroll
        for (int tb = 0; tb < 4; ++tb)
#pragma unroll
            for (int r = 0; r < 16; ++r) {
                const int t = 32 * tb + (r & 3) + 8 * (r >> 2) + 4 * fh;
                const float u = bf2f(P[(size_t)(row0 + t) * PW + 1792 + ch]);
                gm[(size_t)(row0 + t) * 256 + ch] = f2bf(u * (acc[tb][r] + bs[t]));
            }
    }
    __syncthreads();
}

constexpr int ATT_KS = 144, ATT_VS = 136, ATT_KB = 64 * ATT_KS, ATT_VB = 64 * ATT_VS, ATT_STAGE = 4 * (ATT_KB + ATT_VB);
__device__ __forceinline__ void attn_unit(const Params& p, int b, int kvh, int qrow0, int nkeys, unsigned char* lds) {
    const int tid = threadIdx.x, lane = tid & 63, wid = tid >> 6, fr = lane & 31, fh = lane >> 5;
    const int hq = kvh * 4 + (wid & 3), row = qrow0 + (wid >> 2) * 32 + fr;
    bf16_t* qbuf = (bf16_t*)(p.ws + OFF_Q);
    bf16x8 qf[4];
#pragma unroll
    for (int ks = 0; ks < 4; ++ks) qf[ks] = *(const bf16x8*)(qbuf + (size_t)row * 512 + hq * 64 + 16 * ks + 8 * fh);
    const int lr = tid >> 3, lc = tid & 7;
    const bf16_t* kg = (const bf16_t*)(p.ws + OFF_K) + (size_t)(b * 2 + kvh) * NKEY * 64 + (size_t)lr * 64 + lc * 8;
    const bf16_t* vg = (const bf16_t*)(p.ws + OFF_VT) + (size_t)(b * 2 + kvh) * 64 * NKEY + (size_t)lr * NKEY + lc * 8;
    const int kso = lr * ATT_KS + lc * 16, vso = 4 * ATT_KB + lr * ATT_VS + lc * 16;
    const int nst = nkeys >> 8;
#pragma unroll
    for (int j = 0; j < 4; ++j) {
        const uint4 k0 = *(const uint4*)(kg + (size_t)j * 4096), v0 = *(const uint4*)(vg + (size_t)j * 64);
        *(uint4*)(lds + j * ATT_KB + kso) = k0;
        *(uint2*)(lds + j * ATT_VB + vso) = make_uint2(v0.x, v0.y); *(uint2*)(lds + j * ATT_VB + vso + 8) = make_uint2(v0.z, v0.w);
    }
    __syncthreads();
    f32x16 o[2];
#pragma unroll
    for (int i = 0; i < 16; ++i) { o[0][i] = 0.f; o[1][i] = 0.f; }
    const int koff = fr * ATT_KS + fh * 16, voff = 4 * ATT_KB + fr * ATT_VS + fh * 8;
    float m_used = 0.f, lsum = 0.f;
    f32x16 cinit;
#pragma unroll
    for (int i = 0; i < 16; ++i) cinit[i] = 0.f;
#pragma unroll 1
    for (int st = 0; st < nst; ++st) {
        const unsigned char* sc = lds + (st & 1) * ATT_STAGE;
        unsigned char* sn = lds + ((st & 1) ^ 1) * ATT_STAGE;
        const bool more = (st + 1 < nst);
#pragma unroll
        for (int j = 0; j < 4; ++j) {
            uint4 rk, rv;
            if (more) { rk = *(const uint4*)(kg + (size_t)((st + 1) * 4 + j) * 4096); rv = *(const uint4*)(vg + (size_t)((st + 1) * 4 + j) * 64); }
            f32x16 s[2];
            const unsigned char* cK = sc + j * ATT_KB + koff;
#pragma unroll
            for (int kb = 0; kb < 2; ++kb) s[kb] = __builtin_amdgcn_mfma_f32_32x32x16_bf16(*(const bf16x8*)(cK + kb * 32 * ATT_KS), qf[0], cinit, 0, 0, 0);
#pragma unroll
            for (int ks = 1; ks < 4; ++ks)
#pragma unroll
                for (int kb = 0; kb < 2; ++kb) s[kb] = __builtin_amdgcn_mfma_f32_32x32x16_bf16(*(const bf16x8*)(cK + kb * 32 * ATT_KS + ks * 32), qf[ks], s[kb], 0, 0, 0);
            float mx = fmaxf(fmaxf(s[0][0], s[0][1]), s[0][2]);
#pragma unroll
            for (int i = 3; i < 15; i += 2) mx = fmaxf(fmaxf(mx, s[0][i]), s[0][i + 1]);
            mx = fmaxf(mx, s[0][15]);
#pragma unroll
            for (int i = 0; i < 16; i += 2) mx = fmaxf(fmaxf(mx, s[1][i]), s[1][i + 1]);
            mx = fmaxf(mx, __shfl_xor(mx, 32));
            const bool firstt = (st == 0 && j == 0);
            if (firstt || __builtin_amdgcn_ballot_w64(mx > 8.0f) != 0ull) {
                const float delta = firstt ? mx : ((mx > 8.0f) ? mx : 0.f);
                const float sc_o = __builtin_amdgcn_exp2f(-delta);
                m_used += delta; lsum *= sc_o;
#pragma unroll
                for (int i = 0; i < 16; ++i) { s[0][i] -= delta; s[1][i] -= delta; o[0][i] *= sc_o; o[1][i] *= sc_o; cinit[i] = -m_used; }
            }
            v2f ps2 = {0.f, 0.f};
#pragma unroll
            for (int kb = 0; kb < 2; ++kb)
#pragma unroll
                for (int i = 0; i < 16; i += 2) { const float e0 = __builtin_amdgcn_exp2f(s[kb][i]), e1 = __builtin_amdgcn_exp2f(s[kb][i + 1]); s[kb][i] = e0; s[kb][i + 1] = e1; ps2 += (v2f){e0, e1}; }
            lsum += ps2.x + ps2.y;
            const unsigned char* cV = sc + j * ATT_VB + voff;
#pragma unroll
            for (int kb = 0; kb < 2; ++kb)
#pragma unroll
                for (int sh = 0; sh < 2; ++sh) {
                    const bf16x8 pf = mk8(pack2(s[kb][8 * sh + 0], s[kb][8 * sh + 1]), pack2(s[kb][8 * sh + 2], s[kb][8 * sh + 3]),
                                          pack2(s[kb][8 * sh + 4], s[kb][8 * sh + 5]), pack2(s[kb][8 * sh + 6], s[kb][8 * sh + 7]));
#pragma unroll
                    for (int db = 0; db < 2; ++db) {
                        const unsigned char* vp = cV + db * 32 * ATT_VS + (kb * 32 + sh * 16) * 2;
                        const uint2 v0 = *(const uint2*)vp, v1 = *(const uint2*)(vp + 16);
                        o[db] = __builtin_amdgcn_mfma_f32_32x32x16_bf16(mk8(v0.x, v0.y, v1.x, v1.y), pf, o[db], 0, 0, 0);
                    }
                }
            if (more) {
                *(uint4*)(sn + j * ATT_KB + kso) = rk;
                *(uint2*)(sn + j * ATT_VB + vso) = make_uint2(rv.x, rv.y); *(uint2*)(sn + j * ATT_VB + vso + 8) = make_uint2(rv.z, rv.w);
            }
        }
        __syncthreads();
    }
    const float inv = 1.0f / (lsum + __shfl_xor(lsum, 32));
    bf16_t* op = qbuf + (size_t)row * 512 + hq * 64;
#pragma unroll
    for (int db = 0; db < 2; ++db)
#pragma unroll
        for (int g = 0; g < 4; ++g)
            *(uint2*)(op + db * 32 + g * 8 + fh * 4) = make_uint2(pack2(o[db][4 * g] * inv, o[db][4 * g + 1] * inv), pack2(o[db][4 * g + 2] * inv, o[db][4 * g + 3] * inv));
}

__device__ __forceinline__ void hyfft_unit(const Params& p, int l, int u, unsigned char* lds) {
    const int bp = u >> 8, c = u & 255, tid = threadIdx.x;
    float2* X = (float2*)lds;
    const float2* tw = (const float2*)(p.ws + OFF_TW);
    bf16_t* zt = (bf16_t*)(p.ws + OFF_ZT);
    bf16_t* z0 = zt + ((size_t)((2 * bp) * 768 + c)) * SEQ;
    bf16_t* z1 = zt + ((size_t)((2 * bp + 1) * 768 + c)) * SEQ;
    const float2* H0 = (const float2*)(p.ws + OFF_HSPEC + (size_t)l * SZ_HSPEC_L) + (size_t)c * NFFT;
    const float2* H1 = H0 + (size_t)256 * NFFT;
    const float sk0 = p.in[IN_HSKIP][l * 512 + c], sk1 = p.in[IN_HSKIP][l * 512 + 256 + c];
    float2 keep[16];
#pragma unroll
    for (int i = 0; i < 16; ++i) {
        const int t = tid + 512 * i;
        const float2 v = make_float2(bf2f(z0[t]), bf2f(z1[t]));
        keep[i] = v; X[XP(t)] = v; X[XP(t + 8192)] = make_float2(0.f, 0.f);
    }
    __syncthreads();
    fft_fwd(X, tw);
#pragma unroll
    for (int hb = 0; hb < 2; ++hb) { float2 h2[16];
#pragma unroll
      for (int i = 0; i < 16; ++i) h2[i] = H0[tid + 512 * (16 * hb + i)];
#pragma unroll
      for (int i = 0; i < 16; ++i) { const int ix = XP(tid + 512 * (16 * hb + i)); const v2f a = ((v2f*)X)[ix], h = {h2[i].x, h2[i].y}; ((v2f*)X)[ix] = pk_cmul(a, h); } }
    __syncthreads();
    fft_inv(X, tw);
#pragma unroll
    for (int i = 0; i < 16; ++i) {
        const int t = tid + 512 * i;
        const float2 cv = X[XP(t)];
        const float g0 = bf2f(z0[(size_t)256 * SEQ + t]), g1 = bf2f(z1[(size_t)256 * SEQ + t]);
        const float2 y = make_float2(g0 * (cv.x + sk0 * keep[i].x), g1 * (cv.y + sk0 * keep[i].y));
        keep[i] = y; X[XP(t)] = y; X[XP(t + 8192)] = make_float2(0.f, 0.f);
    }
    __syncthreads();
    fft_fwd(X, tw);
#pragma unroll
    for (int hb = 0; hb < 2; ++hb) { float2 h2[16];
#pragma unroll
      for (int i = 0; i < 16; ++i) h2[i] = H1[tid + 512 * (16 * hb + i)];
#pragma unroll
      for (int i = 0; i < 16; ++i) { const int ix = XP(tid + 512 * (16 * hb + i)); const v2f a = ((v2f*)X)[ix], h = {h2[i].x, h2[i].y}; ((v2f*)X)[ix] = pk_cmul(a, h); } }
    __syncthreads();
    fft_inv(X, tw);
#pragma unroll
    for (int i = 0; i < 16; ++i) {
        const int t = tid + 512 * i;
        const float2 cv = X[XP(t)];
        const float g0 = bf2f(z0[(size_t)512 * SEQ + t]), g1 = bf2f(z1[(size_t)512 * SEQ + t]);
        z0[t] = f2bf(g0 * (cv.x + sk1 * keep[i].x));
        z1[t] = f2bf(g1 * (cv.y + sk1 * keep[i].y));
    }
    __syncthreads();
}
__device__ __forceinline__ void filtfft_unit(const Params& p, int u, unsigned char* lds) {
    const int l = u >> 9, oc = u & 511, tid = threadIdx.x, lane = tid & 63, wid = tid >> 6;
    float2* X = (float2*)lds;
    float* red = (float*)(lds + 135168 + 64);
    const float* k = (const float*)(p.ws + OFF_P + (size_t)l * SZ_KCIRC_L) + (size_t)oc * NFFT;
    float s = 0.f;
#pragma unroll 4
    for (int i = tid; i < NFFT; i += 512) { const float v = k[i]; X[XP(i)] = make_float2(v, 0.f); s += fabsf(v); }
    s = wave_sum(s);
    if (lane == 0) red[wid] = s;
    __syncthreads();
    const float tot = red[0] + red[1] + red[2] + red[3] + red[4] + red[5] + red[6] + red[7];
    const float sc = 1.0f / (tot * (float)NFFT);
#pragma unroll 4
    for (int i = tid; i < NFFT; i += 512) X[XP(i)].x *= sc;
    __syncthreads();
    fft_fwd(X, (const float2*)(p.ws + OFF_TW));
    float2* H = (float2*)(p.ws + OFF_HSPEC + (size_t)l * SZ_HSPEC_L) + (size_t)oc * NFFT;
#pragma unroll 4
    for (int i = tid; i < NFFT; i += 512) H[i] = X[XP(i)];
    __syncthreads();
}
__device__ __forceinline__ void ctxhy_unit(const Params& p, int l, int u, unsigned char* lds) {
    const int b = u >> 7, tid = threadIdx.x, t = tid & 255, cs = tid >> 8, c = (u & 127) * 2 + cs;
    float* sv = (float*)lds + cs * 256;
    float* sy = (float*)lds + 512 + cs * 256;
    float* k0 = (float*)lds + 1024 + cs * 1024;
    float* k1 = k0 + 512;
    const bf16_t* P = (const bf16_t*)(p.ws + OFF_P);
    const int rowb = ML + b * CTXL;
    const float* cw = p.in[IN_HCW] + l * 3 * 768;
    float z[3];
#pragma unroll
    for (int part = 0; part < 3; ++part) {
        const int ch = part * 256 + c;
        const float pm = (t > 0) ? bf2f(P[(size_t)(rowb + t - 1) * PW + 768 + ch]) : 0.f;
        const float pc = bf2f(P[(size_t)(rowb + t) * PW + 768 + ch]);
        const float pn = (t < CTXL - 1) ? bf2f(P[(size_t)(rowb + t + 1) * PW + 768 + ch]) : 0.f;
        z[part] = pm * cw[ch] + pc * cw[768 + ch] + pn * cw[1536 + ch] + p.in[IN_HCB][l * 768 + ch];
    }
    const float* kn = (const float*)(p.ws + OFF_KCN);
    k0[t] = kn[(size_t)c * 512 + t]; k0[t + 256] = kn[(size_t)c * 512 + t + 256];
    k1[t] = kn[(size_t)(256 + c) * 512 + t]; k1[t + 256] = kn[(size_t)(256 + c) * 512 + t + 256];
    sv[t] = z[0];
    __syncthreads();
    float a = 0.f;
#pragma unroll 8
    for (int s = 0; s < 256; ++s) a += k0[(t - s) & 511] * sv[s];
    const float y1 = z[1] * (a + p.in[IN_HSKIP][l * 512 + c] * z[0]);
    sy[t] = y1;
    __syncthreads();
    a = 0.f;
#pragma unroll 8
    for (int s = 0; s < 256; ++s) a += k1[(t - s) & 511] * sy[s];
    const float y2 = z[2] * (a + p.in[IN_HSKIP][l * 512 + 256 + c] * y1);
    ((bf16_t*)(p.ws + OFF_HY))[(size_t)(rowb + t) * 256 + c] = f2bf(y2);
    __syncthreads();
}
__device__ __forceinline__ void hytr_unit(const Params& p, int u, unsigned char* lds) {
    const int b = u >> 7, t0 = (u & 127) * 64, tid = threadIdx.x;
    constexpr int TS = 144;
    const bf16_t* zt = (const bf16_t*)(p.ws + OFF_ZT);
    for (int i = tid; i < 2048; i += 512) {
        const int ch = i >> 3, cc = i & 7;
        *(uint4*)(lds + ch * TS + cc * 16) = *(const uint4*)(zt + ((size_t)(b * 768 + ch)) * SEQ + t0 + cc * 8);
    }
    __syncthreads();
    {
        const int ch = tid & 255, half = tid >> 8;
        bf16_t* dst = (bf16_t*)(p.ws + OFF_HY) + (size_t)(b * SEQ + t0) * 256 + ch;
        for (int j = 0; j < 32; ++j) { const int tl = half * 32 + j; dst[(size_t)tl * 256] = *(const bf16_t*)(lds + ch * TS + tl * 2); }
    }
    __syncthreads();
}

#ifdef DIAG_NAN
__device__ __forceinline__ void diag_scan(const Params& p, size_t off, size_t nbytes, bool isbf, unsigned code) {
    const uint4* q = (const uint4*)(p.ws + off);
    const size_t n = nbytes / 16;
    bool bad = false;
    for (size_t i = (size_t)blockIdx.x * 512 + threadIdx.x; i < n; i += (size_t)gridDim.x * 512) {
        const uint4 v = q[i];
        const unsigned w[4] = {v.x, v.y, v.z, v.w};
#pragma unroll
        for (int k = 0; k < 4; ++k) {
            if (isbf) { if ((w[k] & 0x7f80u) == 0x7f80u || (w[k] & 0x7f800000u) == 0x7f800000u) bad = true; }
            else { if ((w[k] & 0x7f800000u) == 0x7f800000u) bad = true; }
        }
    }
    if (bad) atomicMin((unsigned*)(p.ws + WS_END), code);
}
__device__ __forceinline__ void diag_scan_out(const Params& p, unsigned code) {
    const uint4* q = (const uint4*)p.out;
    const size_t n = (size_t)ML * 1024 / 4;
    bool bad = false;
    for (size_t i = (size_t)blockIdx.x * 512 + threadIdx.x; i < n; i += (size_t)gridDim.x * 512) {
        const uint4 v = q[i];
        if ((v.x & 0x7f800000u) == 0x7f800000u || (v.y & 0x7f800000u) == 0x7f800000u || (v.z & 0x7f800000u) == 0x7f800000u || (v.w & 0x7f800000u) == 0x7f800000u) bad = true;
    }
    if (bad) atomicMin((unsigned*)(p.ws + WS_END), code);
}
__device__ __forceinline__ void diag_phase(const Params& p, int ph) {
    const int prev = ph - 1;
    if (prev == 0) {
        diag_scan(p, OFF_W, 2 * W_LAYER, true, 0);
        diag_scan(p, OFF_MOD, (size_t)2 * 9 * 6144 * 4 + 16384 + 65536, false, 0);
        diag_scan(p, OFF_P, 2 * SZ_KCIRC_L, false, 0);
        diag_scan(p, OFF_KCR, (size_t)2 * 256 * 512 * 4, false, 0);
    } else if (prev == 1) {
        diag_scan(p, OFF_HSPEC, 2 * SZ_HSPEC_L, false, 1);
        diag_scan(p, OFF_KCN, (size_t)2 * 256 * 512 * 4, false, 1);
        diag_scan(p, OFF_HN, SZ_HN, true, 1);
    } else {
        const int sub = (prev - 2) % 10;
        switch (sub) {
        case 0: diag_scan(p, OFF_P, SZ_P, true, prev); break;
        case 1: diag_scan(p, OFF_Q, SZ_Q + 2 * SZ_K + SZ_ZT + 2 * SZ_B256, true, prev); break;
        case 2: diag_scan(p, OFF_Q, SZ_Q, true, prev); diag_scan(p, OFF_ZT, SZ_ZT, true, prev); diag_scan(p, OFF_HY, SZ_B256, true, prev); break;
        case 3: diag_scan(p, OFF_HY, SZ_B256, true, prev); break;
        case 4: diag_scan(p, OFF_P, SZ_HN, true, prev); break;
        case 5: diag_scan_out(p, prev); break;
        case 6: diag_scan(p, OFF_HN, (size_t)ML * 2048, true, prev); break;
        case 7: diag_scan(p, OFF_P, (size_t)ML * FFH * 2, true, prev); break;
        case 8: diag_scan_out(p, prev); break;
        default: diag_scan(p, OFF_HN, SZ_HN, true, prev); break;
        }
    }
}
#endif

__device__ __forceinline__ void run_phase(const Params& p, int ph, unsigned char* lds) {
    const int G = gridDim.x, bid = blockIdx.x;
#ifdef PROBE_SEL
    if (bid == 0 && threadIdx.x == 0) ((unsigned long long*)(p.ws + WS_END + 64))[ph] = __builtin_amdgcn_s_memrealtime();
#endif
#ifdef DIAG_NAN
    if (ph == 0 && bid == 0 && threadIdx.x == 0) *(unsigned*)(p.ws + WS_END) = 999u;
    if (ph == 0 && bid == 0 && threadIdx.x == 0) { *(unsigned*)(p.ws + WS_END + 4) = 0u; *(unsigned*)(p.ws + WS_END + 8) = 0x7fffffffu; }
    if (ph == 3) {
        const unsigned* q = (const unsigned*)(p.ws + OFF_P);
        const size_t n = SZ_P / 4;
        unsigned cnt = 0, mincol = 0x7fffffffu;
        for (size_t i = (size_t)bid * 512 + threadIdx.x; i < n; i += (size_t)G * 512) {
            const unsigned w = q[i];
            const unsigned col = (unsigned)((i * 2) % PW);
            const unsigned rowi = (unsigned)((i * 2) / PW);
            const bool bad = ((w & 0x7f80u) == 0x7f80u) || ((w & 0x7f800000u) == 0x7f800000u);
            if (bad) { if (col == 0) cnt++; mincol = min(mincol, rowi); }
        }
        if (cnt) { atomicAdd((unsigned*)(p.ws + WS_END + 4), cnt); atomicMin((unsigned*)(p.ws + WS_END + 8), mincol); }
    }
#endif
    if (ph == 0) {
        if (!ONLYC(100) && !ONLYC(102) && !ONLYC(103) && !ONLYC(104) && !ONLYC(105) && !ONLYC(106)) return;
        constexpr int NCVT = 2 * 4224, NMOD = 96, NWEFF = 64, NFILT = 260, NMISC = 16, NHEAVY = NMOD + NWEFF + NFILT + NMISC;
        for (int u = bid; u < NHEAVY + NCVT; u += G) {
            if (u >= NHEAVY) {
                const int uu = u - NHEAVY, l = uu / 4224, t = uu % 4224;
                int j, base;
                if (t < 1600) { j = 0; base = 0; } else if (t < 1728) { j = 1; base = 1600; } else if (t < 1792) { j = 2; base = 1728; } else if (t < 1856) { j = 3; base = 1792; }
                else if (t < 2112) { j = 4; base = 1856; } else if (t < 2816) { j = 5; base = 2112; } else if (t < 3520) { j = 6; base = 2816; } else { j = 7; base = 3520; }
                const CvtJob jb = get_job(p, l, j);
                if (ONLYC(100) || ONLYC(102)) cvt_tile(jb, t - base, lds);
            } else if (u < NFILT) {
                if (!(ONLYC(100) || ONLYC(105))) {} else if (u < 256) filt_task(p, u >> 7, u & 127, SEQ, (float*)(p.ws + OFF_P + (size_t)(u >> 7) * SZ_KCIRC_L), lds);
                else filt_task(p, 0, u - 256, CTXL, (float*)(p.ws + OFF_KCR), lds);
            } else if (u < NFILT + NMOD) { if (ONLYC(100) || ONLYC(103)) mod_task(p, u - NFILT, lds); }
            else if (u < NFILT + NMOD + NWEFF) { if (ONLYC(100) || ONLYC(104)) weff_task(p, u - NFILT - NMOD, lds); }
            else { if (ONLYC(100) || ONLYC(106)) misc_task(p, u - NFILT - NMOD - NWEFF); }
        }
        return;
    }
    if (ph == 1) {
        if (!ONLYC(101)) return;
        for (int u = bid; u < 1024; u += G) filtfft_unit(p, u, lds);
        {
            const int lane = threadIdx.x & 63, wid = threadIdx.x >> 6;
            const float* kr = (const float*)(p.ws + OFF_KCR);
            float* kn = (float*)(p.ws + OFF_KCN);
            for (int oc = bid * 8 + wid; oc < 512; oc += G * 8) {
                float v[8], s = 0.f;
#pragma unroll
                for (int i = 0; i < 8; ++i) { v[i] = kr[(size_t)oc * 512 + lane + 64 * i]; s += fabsf(v[i]); }
                s = 1.0f / wave_sum(s);
#pragma unroll
                for (int i = 0; i < 8; ++i) kn[(size_t)oc * 512 + lane + 64 * i] = v[i] * s;
            }
        }
        modulate_phase(p, 0, 0, MT, p.in[IN_X], p.in[IN_CTX]);
        return;
    }
    const int l = (ph - 2) / 10, sub10 = (ph - 2) % 10, sub13 = (sub10 < 3) ? sub10 : (sub10 < 5) ? sub10 + 1 : sub10 + 3;
    const int half = (sub13 == 6 || sub13 == 7) ? 1 : 0;
    const int sub = (sub13 < 4) ? sub13 : (sub13 == 4 || sub13 == 6) ? 40 : (sub13 == 5 || sub13 == 7) ? 4 : (sub13 - 3);
    const bool first = (l == 0), last = (l == 1);
    unsigned char* wl = p.ws + OFF_W + (size_t)l * W_LAYER;
    const int mtiles = first ? (MT / 256) : (ML / 256);
    const float* mod = (const float*)(p.ws + OFF_MOD) + (size_t)l * 9 * 6144;
    float* xc = (float*)(p.ws + OFF_XC);
    switch (sub) {
    case 0: {
        if (!ONLYC(0) && !(0 == 1 && (ONLYC(10)||ONLYC(11)||ONLYC(12)||ONLYC(13))) && !(0 == 2 && (ONLYC(20)||ONLYC(21)||ONLYC(22)||ONLYC(23)))) break;
        pg8::Gemm g{(const bf16_t*)(p.ws + OFF_HN), (const bf16_t*)(wl + W_WIN), MT, PW, 1024};
        pg8::StaticOrder S; S.init(MT, PW, G, bid);
        pg8::EpiP E{(bf16_t*)(p.ws + OFF_P), PW};
        pg8::gemm_phase<pg8::EpiP, pg8::StaticOrder, true, true>((PG8_LAS unsigned char*)g_lds, g, S, E);
    } break;
    case 1: {
        if (!ONLYC(1) && !(1 == 1 && (ONLYC(10)||ONLYC(11)||ONLYC(12)||ONLYC(13))) && !(1 == 2 && (ONLYC(20)||ONLYC(21)||ONLYC(22)||ONLYC(23)))) break;
        const int NQK = 1056, NHC = 768, NPOOL = first ? 264 : 256, NGM = first ? 528 : 512;
        for (int u = bid; u < NHC; u += G) { if (ONLYC(1) || ONLYC(11)) hyconv_unit(p, l, u, lds); }
        for (int u = (bid + 64) % G; u < NQK; u += G) { if (ONLYC(1) || ONLYC(10)) qk_unit(p, l, u, lds); }
        for (int u = (bid + 128) % G; u < NGM; u += G) { if (ONLYC(1) || ONLYC(13)) gmlp_unit(p, l, u, lds); }
        for (int u = (bid + 192) % G; u < NPOOL; u += G) { if (ONLYC(1) || ONLYC(12)) pool_unit(p, u, lds); }
    } break;
    case 2: {
        if (!ONLYC(2) && !(2 == 1 && (ONLYC(10)||ONLYC(11)||ONLYC(12)||ONLYC(13))) && !(2 == 2 && (ONLYC(20)||ONLYC(21)||ONLYC(22)||ONLYC(23)))) break;
        const int NF = 1024, NA = 2048, NCA = first ? 64 : 0, NCH = first ? 1024 : 0;
#ifdef PROBE_SEL
#define MIXTS(k) if (bid == 0 && threadIdx.x == 0) ((unsigned long long*)(p.ws + WS_END + 1024))[l * 4 + (k)] = __builtin_amdgcn_s_memrealtime();
#else
#define MIXTS(k)
#endif
        MIXTS(0)
        for (int u = bid; u < NF; u += G) { if (ONLYC(2) || ONLYC(20)) hyfft_unit(p, l, u, lds); }
        MIXTS(1)
        for (int u = bid; u < NA + NCA; u += G) {
            int ab, akvh, arow, ank;
            if (u < NA) { ab = u >> 8; akvh = u & 1; arow = (u >> 8) * SEQ + ((u >> 1) & 127) * 64; ank = NKEY; }
            else { const int a = u - NA; ab = a >> 3; akvh = (a >> 2) & 1; arow = ML + (a >> 3) * CTXL + (a & 3) * 64; ank = CTXL; }
            if (ONLYC(2) || ONLYC(21) || ONLYC(22)) attn_unit(p, ab, akvh, arow, ank, lds);
        }
        MIXTS(2)
        for (int u = bid; u < NCH; u += G) { if (ONLYC(2) || ONLYC(23)) ctxhy_unit(p, l, u, lds); }
        MIXTS(3)
    } break;
    case 3: {
        if (!ONLYC(3) && !(3 == 1 && (ONLYC(10)||ONLYC(11)||ONLYC(12)||ONLYC(13))) && !(3 == 2 && (ONLYC(20)||ONLYC(21)||ONLYC(22)||ONLYC(23)))) break;
        for (int u = bid; u < 1024; u += G) hytr_unit(p, u, lds);
    } break;
    case 40: {
        if (!ONLYC(40)) break;
        if (half == 0) { for (int u = bid; u < 1024; u += G) hytr_unit(p, u, lds); }
        const int rowbase = 0, Mh = first ? MT : ML;
        pg8::Gemm g{(const bf16_t*)(p.ws + OFF_HN) + (size_t)rowbase * 1024, (const bf16_t*)(wl + W_WIN) + (size_t)PW * 1024, Mh, 4096, 1024};
        pg8::StaticOrder S; S.init(Mh, 4096, G, bid);
        pg8::EpiSig E{p.ws + OFF_P, 4096};
        pg8::gemm_phase<pg8::EpiSig, pg8::StaticOrder, true, true>((PG8_LAS unsigned char*)g_lds, g, S, E);
    } break;
    case 4: {
        if (!ONLYC(4)) break;
        const int rowbase = 0, Mh = first ? MT : ML;
        const unsigned char* Gb = p.ws + OFF_P;
        bf16_t* mg = (bf16_t*)(p.ws + OFF_MG);
        const int mtiles_h = Mh / 256;
        const int total = ((mtiles_h + 31) / 32) * 256;
        for (int u = bid; u < total; u += G) {
            const int rr = u >> 8, w = u & 255, mt = rr * 32 + (w & 7) * 4 + (w >> 6), nt = (w >> 3) & 7;
            if (mt >= mtiles_h) continue;
            f32x16 msum[2][2]; zero_acc(msum);
            const int lane = threadIdx.x & 63, wid = threadIdx.x >> 6, wm = wid >> 1, wn = wid & 1, fr = lane & 31, fh = lane >> 5;
#pragma unroll 1
            for (int br = 0; br < 4; ++br) {
                const bf16_t* Ab = (const bf16_t*)(p.ws + (br == 0 ? OFF_Q : br == 1 ? OFF_HY : br == 2 ? OFF_PD : OFF_GM));
                const bf16_t* Wb = (const bf16_t*)(wl + (br == 0 ? W_BA : br == 1 ? W_BH : br == 2 ? W_BP : W_BG));
                const int Kb = (br == 0) ? 512 : 256;
                unsigned gq[2][2][4];
#pragma unroll
                for (int mb = 0; mb < 1; ++mb)
#pragma unroll
                    for (int nb = 0; nb < 2; ++nb)
#pragma unroll
                        for (int g4 = 0; g4 < 4; ++g4) {
                            const int rowl = mt * 256 + wm * 64 + mb * 32 + fr, col = nt * 128 + wn * 64 + nb * 32 + g4 * 8 + fh * 4;
                            gq[mb][nb][g4] = *(const unsigned*)(Gb + (size_t)rowl * 4096 + br * 1024 + col);
                        }
                f32x16 v[2][2]; zero_acc(v);
                gemm_mainloop(v, Ab + (size_t)(rowbase + mt * 256) * Kb, Kb, Wb + (size_t)nt * 128 * Kb, Kb, Kb, lds);
#pragma unroll
                for (int nb = 0; nb < 2; ++nb)
#pragma unroll
                    for (int g4 = 0; g4 < 4; ++g4) {
                        const int rowl = mt * 256 + wm * 64 + 32 + fr, col = nt * 128 + wn * 64 + nb * 32 + g4 * 8 + fh * 4;
                        gq[1][nb][g4] = *(const unsigned*)(Gb + (size_t)rowl * 4096 + br * 1024 + col);
                    }
#pragma unroll
                for (int mb = 0; mb < 2; ++mb)
#pragma unroll
                    for (int nb = 0; nb < 2; ++nb)
#pragma unroll
                        for (int g4 = 0; g4 < 4; ++g4) {
                            const unsigned gg = gq[mb][nb][g4];
                            constexpr float QS = 1.0f / 255.0f;
                            msum[nb][mb][4 * g4 + 0] += ((float)(gg & 0xffu) * QS) * v[nb][mb][4 * g4 + 0]; msum[nb][mb][4 * g4 + 1] += ((float)((gg >> 8) & 0xffu) * QS) * v[nb][mb][4 * g4 + 1];
                            msum[nb][mb][4 * g4 + 2] += ((float)((gg >> 16) & 0xffu) * QS) * v[nb][mb][4 * g4 + 2]; msum[nb][mb][4 * g4 + 3] += ((float)(gg >> 24) * QS) * v[nb][mb][4 * g4 + 3];
                        }
            }
#pragma unroll
            for (int mb = 0; mb < 2; ++mb)
#pragma unroll
                for (int nb = 0; nb < 2; ++nb)
#pragma unroll
                    for (int g4 = 0; g4 < 4; ++g4) {
                        const int row = rowbase + mt * 256 + wm * 64 + mb * 32 + fr, col = nt * 128 + wn * 64 + nb * 32 + g4 * 8 + fh * 4;
                        *(uint2*)(mg + (size_t)row * 1024 + col) = make_uint2(pack2(msum[nb][mb][4 * g4], msum[nb][mb][4 * g4 + 1]), pack2(msum[nb][mb][4 * g4 + 2], msum[nb][mb][4 * g4 + 3]));
                    }
        }
    } break;
    case 5: case 8: {
        if (!ONLYC(5)) break;
        const bool isout = (sub == 5);
        const int Mrows = first ? MT : ML, K = isout ? 1024 : FFH;
        pg8::Gemm g{(const bf16_t*)(p.ws + (isout ? OFF_MG : OFF_P)), (const bf16_t*)(wl + (isout ? W_OUT : W_DN)), Mrows, 1024, K};
        pg8::StaticOrder S; S.init(Mrows, 1024, G, bid);
        pg8::EpiRes E{(isout && first) ? p.in[IN_X] : p.out, (isout && first) ? p.in[IN_CTX] : xc, p.out, xc, mod + (isout ? 2048 : 5120), ML};
        pg8::gemm_phase<pg8::EpiRes, pg8::StaticOrder, true, true>((PG8_LAS unsigned char*)g_lds, g, S, E);
    } break;
    case 6: if (!ONLYC(6)) break; modulate_phase(p, l, 1, first ? MT : ML, p.out, xc); break;
    case 7: {
        if (!ONLYC(7) && !(7 == 1 && (ONLYC(10)||ONLYC(11)||ONLYC(12)||ONLYC(13))) && !(7 == 2 && (ONLYC(20)||ONLYC(21)||ONLYC(22)||ONLYC(23)))) break;
        const int Mrows = first ? MT : ML;
        pg8::Gemm g{(const bf16_t*)(p.ws + OFF_HN), (const bf16_t*)(wl + W_GU), Mrows, 2 * FFH, 1024};
        pg8::StaticOrder S; S.init(Mrows, 2 * FFH, G, bid);
        pg8::EpiSwi E{(bf16_t*)(p.ws + OFF_P), FFH};
        pg8::gemm_phase<pg8::EpiSwi, pg8::StaticOrder, true, true>((PG8_LAS unsigned char*)g_lds, g, S, E);
    } break;
    case 9: {
        if (!ONLYC(9) && !(9 == 1 && (ONLYC(10)||ONLYC(11)||ONLYC(12)||ONLYC(13))) && !(9 == 2 && (ONLYC(20)||ONLYC(21)||ONLYC(22)||ONLYC(23)))) break;
        if (last) final_norm_phase(p);
        else modulate_phase(p, l + 1, 0, MT, p.out, xc);
    } break;
    }
}

__device__ __forceinline__ unsigned xcc_id() { return (unsigned)__builtin_amdgcn_s_getreg((3 << 11) | 20) & 0x7u; }
__device__ __forceinline__ void seam_barrier(unsigned* words  , unsigned x, unsigned nx, unsigned nact) {
    __syncthreads();
    if (threadIdx.x == 0) {
        __builtin_amdgcn_fence(__ATOMIC_RELEASE, "agent");
        const unsigned old = __hip_atomic_fetch_add(words + 32 * x, 1u, __ATOMIC_RELAXED, __HIP_MEMORY_SCOPE_AGENT);
        if (old + 1u == nx) __hip_atomic_fetch_add(words + 256, 1u, __ATOMIC_RELAXED, __HIP_MEMORY_SCOPE_AGENT);
        while (__hip_atomic_load(words + 256, __ATOMIC_RELAXED, __HIP_MEMORY_SCOPE_AGENT) < nact) __builtin_amdgcn_s_sleep(1);
        __builtin_amdgcn_fence(__ATOMIC_ACQUIRE, "agent");
    }
    __syncthreads();
}
__global__ void __launch_bounds__(512) mk_forward(Params p) {
    unsigned* const barw = (unsigned*)(p.ws + OFF_BAR);
    const unsigned xcc = (unsigned)__builtin_amdgcn_readfirstlane((int)xcc_id());
    unsigned nx = 0u, nact = 0u;
    if (p.ph_hi - p.ph_lo > 1 && threadIdx.x == 0) __hip_atomic_fetch_add(barw + 32 * xcc, 1u, __ATOMIC_RELAXED, __HIP_MEMORY_SCOPE_AGENT);
#define MK_PHASE(k) if (p.ph_lo <= (k) && (k) < p.ph_hi) { if ((k) > p.ph_lo) { \
        if ((k) == 1) { cg::this_grid().sync(); \
            for (unsigned q = 0; q < 8u; ++q) { const unsigned cq = __hip_atomic_load(barw + 32 * q, __ATOMIC_RELAXED, __HIP_MEMORY_SCOPE_AGENT); nact += (cq != 0u); if (q == xcc) nx = cq; } \
            nx = (unsigned)__builtin_amdgcn_readfirstlane((int)nx); nact = (unsigned)__builtin_amdgcn_readfirstlane((int)nact); } \
        else seam_barrier(barw + 512 * (k), xcc, nx, nact); } run_phase(p, (k), g_lds); }
    MK_PHASE(0) MK_PHASE(1)
    MK_PHASE(2) MK_PHASE(3) MK_PHASE(4) MK_PHASE(5) MK_PHASE(6) MK_PHASE(7) MK_PHASE(8) MK_PHASE(9) MK_PHASE(10) MK_PHASE(11) MK_PHASE(12) MK_PHASE(13) MK_PHASE(14)
    MK_PHASE(15) MK_PHASE(16) MK_PHASE(17) MK_PHASE(18) MK_PHASE(19) MK_PHASE(20) MK_PHASE(21)
#undef MK_PHASE
}

extern "C" void kernel_launch(void* const* d_in, const int* in_sizes, int n_in, void* d_out, int out_size, void* d_ws, size_t ws_size, hipStream_t stream) {
    static int grid = 0;
    if (grid == 0) {
        if (n_in != N_IN || out_size != ML * D || ws_size < WS_END2) { fprintf(stderr, "kernel_launch: unexpected shapes (n_in %d out %d ws %zu need %zu)\n", n_in, out_size, ws_size, (size_t)WS_END); grid = -1; return; }
        int dev = 0, cus = 0, per_cu = 0;
        hipGetDevice(&dev);
        hipDeviceGetAttribute(&cus, hipDeviceAttributeMultiprocessorCount, dev);
        if (hipFuncSetAttribute((const void*)mk_forward, hipFuncAttributeMaxDynamicSharedMemorySize, LDS_BYTES) != hipSuccess) { fprintf(stderr, "kernel_launch: hipFuncSetAttribute failed\n"); grid = -1; return; }
        if (hipOccupancyMaxActiveBlocksPerMultiprocessor(&per_cu, (const void*)mk_forward, 512, LDS_BYTES) != hipSuccess || per_cu < 1) { fprintf(stderr, "kernel_launch: occupancy query says %d\n", per_cu); per_cu = 1; }
        (void)hipGetLastError();
        grid = cus * 1;
    }
    if (grid < 0) return;
    Params p{};
    for (int i = 0; i < N_IN; ++i) p.in[i] = (const float*)d_in[i];
    p.out = (float*)d_out; p.ws = (unsigned char*)d_ws;
#if MK_MULTI_LAUNCH
    for (int ph = 0; ph < NPHASE; ++ph) {
        p.ph_lo = ph; p.ph_hi = ph + 1;
        hipLaunchKernelGGL(mk_forward, dim3(grid), dim3(512), LDS_BYTES, stream, p);
    }
#else
    p.ph_lo = 0; p.ph_hi = NPHASE;
    if (hipMemsetAsync((char*)d_ws + OFF_BAR, 0, 65536, stream) != hipSuccess) { fprintf(stderr, "kernel_launch: memset of the barrier words failed\n"); return; }
    void* args[] = {&p};
    hipError_t e = hipLaunchCooperativeKernel((const void*)mk_forward, dim3(grid), dim3(512), args, LDS_BYTES, stream);
    if (e != hipSuccess) fprintf(stderr, "cooperative launch failed: %s (grid %d)\n", hipGetErrorString(e), grid);
#endif
}
```

```cpp
#include <hip/hip_runtime.h>
#include <hip/hip_cooperative_groups.h>
#include <cstdio>
#include <cstdint>
#include <cmath>
namespace cg = cooperative_groups;

#ifndef MK_MULTI_LAUNCH
#define MK_MULTI_LAUNCH 0
#endif

#ifndef ONLY
#define ONLYC(k) true
#else
#define ONLYC(k) ((k)==ONLY)
#endif
typedef unsigned short bf16_t;
typedef short bf16x8 __attribute__((ext_vector_type(8)));
typedef float f32x16 __attribute__((ext_vector_type(16)));

constexpr int D = 1024, NB = 8, SEQ = 8192, CTXL = 256;
constexpr int ML = NB * SEQ, MC = NB * CTXL, MT = ML + MC;
constexpr int PW = 2304;
constexpr int INW = 6400, FFH = 2816, NKEY = CTXL + SEQ;
constexpr int NFFT = 16384;
constexpr float QSCALE = 0.125f * 1.4426950408889634f;

enum { IN_X, IN_C, IN_CTX, IN_CCTX, IN_WMOD, IN_BMOD, IN_N1W, IN_N2W, IN_WIN, IN_QNW, IN_KNW, IN_HCW, IN_HCB, IN_HW1, IN_HB1, IN_HW2, IN_HB2,
       IN_HW3, IN_HFREQ, IN_HDECAY, IN_HSKIP, IN_POOLW, IN_POOLS, IN_GMNW, IN_GMWS, IN_GMBS, IN_WBA, IN_WBH, IN_WBP, IN_WBG, IN_WOUT, IN_FG, IN_FU, IN_FD, IN_FNW, N_IN };

constexpr size_t SZ_HN = (size_t)MT * 1024 * 2;
constexpr size_t SZ_P = (size_t)MT * PW * 2;
constexpr size_t SZ_Q = (size_t)MT * 512 * 2;
constexpr size_t SZ_K = (size_t)16 * NKEY * 64 * 2;
constexpr size_t SZ_ZT = (size_t)NB * 768 * SEQ * 2;
constexpr size_t SZ_B256 = (size_t)MT * 256 * 2;
constexpr size_t W_WIN = 0, W_BA = W_WIN + (size_t)6400 * 1024 * 2, W_BH = W_BA + (size_t)1024 * 512 * 2, W_BP = W_BH + (size_t)1024 * 256 * 2,
                 W_BG = W_BP + (size_t)1024 * 256 * 2, W_OUT = W_BG + (size_t)1024 * 256 * 2, W_GU = W_OUT + (size_t)1024 * 1024 * 2,
                 W_DN = W_GU + (size_t)5632 * 1024 * 2, W_GMWS = W_DN + (size_t)1024 * 2816 * 2, W_LAYER = W_GMWS + (size_t)4 * 128 * 128 * 2;
constexpr size_t OFF_HN = 0;
constexpr size_t OFF_P = OFF_HN + SZ_HN;
constexpr size_t OFF_Q = OFF_P + SZ_P;
constexpr size_t OFF_PD = OFF_Q + SZ_Q;
constexpr size_t OFF_GM = OFF_PD + SZ_B256;
constexpr size_t OFF_HY = OFF_GM + SZ_B256;
constexpr size_t OFF_W = OFF_HY + SZ_B256;
constexpr size_t OFF_HSPEC = OFF_W + 2 * W_LAYER;
constexpr size_t SZ_HSPEC_L = (size_t)2 * 256 * NFFT * 8;
constexpr size_t OFF_XC = OFF_HSPEC + 2 * SZ_HSPEC_L;
constexpr size_t OFF_MOD = OFF_XC + (size_t)MC * 1024 * 4;
constexpr size_t OFF_ROPE = OFF_MOD + (size_t)2 * 9 * 6144 * 4;
constexpr size_t OFF_TW = OFF_ROPE + (size_t)128 * 16 * 2 * 4;
constexpr size_t OFF_KCR = OFF_TW + (size_t)8192 * 8;
constexpr size_t OFF_KCN = OFF_KCR + (size_t)2 * 256 * 512 * 4;
constexpr size_t OFF_K = OFF_KCN + (size_t)2 * 256 * 512 * 4;
constexpr size_t OFF_VT = OFF_K + SZ_K;
constexpr size_t OFF_ZT = OFF_VT + SZ_K;
constexpr size_t OFF_MG = OFF_K;
constexpr size_t WS_END = OFF_K + ((2 * SZ_K + SZ_ZT) > SZ_HN ? (2 * SZ_K + SZ_ZT) : SZ_HN);
static_assert((size_t)MT * 4096 <= SZ_P, "the 8-bit gate buffer lives in the P region");
constexpr size_t SZ_KCIRC_L = (size_t)2 * 256 * NFFT * 4;
static_assert((size_t)MT * FFH * 2 == SZ_P + SZ_Q, "hid spans P+Q");
static_assert(WS_END <= ((size_t)1 << 30), "workspace over 1 GiB");

constexpr size_t OFF_BAR = (WS_END + 4095) & ~(size_t)4095;
constexpr size_t WS_END2 = OFF_BAR + 65536;
static_assert(WS_END2 <= ((size_t)1 << 30), "workspace over 1 GiB");
constexpr int LDS_BYTES = 147456;
constexpr int NPHASE = 22;

struct Params {
    const float* in[N_IN];
    float* out;
    unsigned char* ws;
    int ph_lo, ph_hi;
};

__device__ __forceinline__ float bf2f(bf16_t b) { return __uint_as_float(((unsigned)b) << 16); }
typedef float f32x2_t __attribute__((ext_vector_type(2)));
typedef __bf16 bf16x2_t __attribute__((ext_vector_type(2)));
__device__ __forceinline__ unsigned pack2(float lo, float hi) { const f32x2_t v = {lo, hi}; const bf16x2_t b = __builtin_convertvector(v, bf16x2_t); return __builtin_bit_cast(unsigned, b); }
__device__ __forceinline__ bf16_t f2bf(float f) { return (bf16_t)(pack2(f, 0.f) & 0xffffu); }
__device__ __forceinline__ float lo_bf(unsigned u) { return __uint_as_float(u << 16); }
__device__ __forceinline__ float hi_bf(unsigned u) { return __uint_as_float(u & 0xffff0000u); }
__device__ __forceinline__ float sigmoidf_(float x) { return 1.0f / (1.0f + __expf(-x)); }
__device__ __forceinline__ float wave_sum(float v) {
    v += __shfl_xor(v, 32); v += __shfl_xor(v, 16); v += __shfl_xor(v, 8); v += __shfl_xor(v, 4); v += __shfl_xor(v, 2); v += __shfl_xor(v, 1); return v;
}
__device__ __forceinline__ bf16x8 mk8(unsigned a, unsigned b, unsigned c, unsigned d) {
    typedef unsigned u32x4 __attribute__((ext_vector_type(4)));
    u32x4 v = {a, b, c, d};
    return __builtin_bit_cast(bf16x8, v);
}

constexpr int LROW = 144;
constexpr int A_BUF = 256 * LROW, B_BUF = 128 * LROW;
template <int NBK>
__device__ __forceinline__ void gemm_mainloop_t(f32x16 (&acc)[NBK][2], const bf16_t* __restrict__ A, int lda, const bf16_t* __restrict__ Bt, int ldb, int K, unsigned char* lds) {
    const int tid = threadIdx.x, lane = tid & 63, wid = tid >> 6, wm = wid >> 1, wn = wid & 1;
    const int lrow = tid >> 3, lkc = tid & 7;
    asm volatile("" : "+s"(lda), "+s"(ldb));
    const bf16_t* ga = A + (size_t)lrow * lda + lkc * 8;
    const bf16_t* gb = Bt + (size_t)lrow * ldb + lkc * 8;
    uint4 p0a0, p0a1, p0a2, p0a3, p0b0, p0b1 = make_uint4(0, 0, 0, 0), p1a0, p1a1, p1a2, p1a3, p1b0, p1b1 = make_uint4(0, 0, 0, 0);
#define GM_LOAD(S, DUMMY, KT) do { const bf16_t* pa = ga + (size_t)(KT) * 64; const bf16_t* pb = gb + (size_t)(KT) * 64; \
        S##a0 = *(const uint4*)(pa); S##a1 = *(const uint4*)(pa + (size_t)64 * lda); S##a2 = *(const uint4*)(pa + (size_t)128 * lda); S##a3 = *(const uint4*)(pa + (size_t)192 * lda); \
        S##b0 = *(const uint4*)(pb); if constexpr (NBK == 2) S##b1 = *(const uint4*)(pb + (size_t)64 * ldb); } while (0)
#define GM_STORE(S, DUMMY, BUF) do { unsigned char* qa = sA + (BUF) * A_BUF + soff; unsigned char* qb = sB + (BUF) * B_BUF + soff; \
        *(uint4*)(qa) = S##a0; *(uint4*)(qa + 64 * LROW) = S##a1; *(uint4*)(qa + 128 * LROW) = S##a2; *(uint4*)(qa + 192 * LROW) = S##a3; \
        *(uint4*)(qb) = S##b0; if constexpr (NBK == 2) *(uint4*)(qb + 64 * LROW) = S##b1; } while (0)
#define GM_COMPUTE(BUF) do { const unsigned char* cA = sA + (BUF) * A_BUF + aoff; const unsigned char* cB = sB + (BUF) * B_BUF + boff; \
        _Pragma("unroll") for (int ks = 0; ks < 4; ++ks) { \
            const bf16x8 a0 = *(const bf16x8*)(cA + ks * 32), a1 = *(const bf16x8*)(cA + 32 * LROW + ks * 32); \
            const bf16x8 b0 = *(const bf16x8*)(cB + ks * 32); \
            acc[0][0] = __builtin_amdgcn_mfma_f32_32x32x16_bf16(b0, a0, acc[0][0], 0, 0, 0); \
            acc[0][1] = __builtin_amdgcn_mfma_f32_32x32x16_bf16(b0, a1, acc[0][1], 0, 0, 0); \
            if constexpr (NBK == 2) { const bf16x8 b1 = *(const bf16x8*)(cB + 32 * LROW + ks * 32); \
                acc[NBK - 1][0] = __builtin_amdgcn_mfma_f32_32x32x16_bf16(b1, a0, acc[NBK - 1][0], 0, 0, 0); \
                acc[NBK - 1][1] = __builtin_amdgcn_mfma_f32_32x32x16_bf16(b1, a1, acc[NBK - 1][1], 0, 0, 0); } } } while (0)
    unsigned char* sA = lds;
    unsigned char* sB = lds + 2 * A_BUF;
    const int soff = lrow * LROW + lkc * 16;
    const int fr = lane & 31, fh = lane >> 5;
    const int aoff = (wm * 64 + fr) * LROW + fh * 16;
    const int boff = (wn * 32 * NBK + fr) * LROW + fh * 16;
    const int nk = K >> 6;
    GM_LOAD(p0, 0, 0);
    GM_LOAD(p1, 0, 1);
    GM_STORE(p0, 0, 0);
    __syncthreads();
    for (int kt = 0; kt < nk; kt += 2) {
        GM_LOAD(p0, 0, min(kt + 2, nk - 1));
        GM_COMPUTE(0);
        GM_STORE(p1, 0, 1);
        __syncthreads();
        GM_LOAD(p1, 0, min(kt + 3, nk - 1));
        GM_COMPUTE(1);
        GM_STORE(p0, 0, 0);
        __syncthreads();
    }
#undef GM_LOAD
#undef GM_STORE
#undef GM_COMPUTE
}
__device__ __forceinline__ void gemm_mainloop(f32x16 (&acc)[2][2], const bf16_t* __restrict__ A, int lda, const bf16_t* __restrict__ Bt, int ldb, int K, unsigned char* lds) {
    gemm_mainloop_t<2>(acc, A, lda, Bt, ldb, K, lds);
}
__device__ __forceinline__ void zero_acc1(f32x16 (&acc)[1][2]) {
#pragma unroll
    for (int b = 0; b < 2; ++b)
#pragma unroll
        for (int i = 0; i < 16; ++i) acc[0][b][i] = 0.f;
}
__device__ __forceinline__ void zero_acc(f32x16 (&acc)[2][2]) {
#pragma unroll
    for (int a = 0; a < 2; ++a)
#pragma unroll
        for (int b = 0; b < 2; ++b)
#pragma unroll
            for (int i = 0; i < 16; ++i) acc[a][b][i] = 0.f;
}
template <class F> __device__ __forceinline__ void epi_foreach(const f32x16 (&acc)[2][2], F f) {
    const int lane = threadIdx.x & 63, wid = threadIdx.x >> 6, wm = wid >> 1, wn = wid & 1, fr = lane & 31, fh = lane >> 5;
#pragma unroll
    for (int mb = 0; mb < 2; ++mb)
#pragma unroll
        for (int nb = 0; nb < 2; ++nb)
#pragma unroll
            for (int g = 0; g < 4; ++g)
                f(wm * 64 + mb * 32 + fr, wn * 64 + nb * 32 + g * 8 + fh * 4, acc[nb][mb][4 * g], acc[nb][mb][4 * g + 1], acc[nb][mb][4 * g + 2], acc[nb][mb][4 * g + 3]);
}

extern __shared__ __attribute__((aligned(16))) unsigned char g_lds[];
namespace pg8 {
#define PG8_LAS __attribute__((address_space(3)))
typedef unsigned short bf16_t;
typedef short bf16x8 __attribute__((ext_vector_type(8)));
typedef float f32x4 __attribute__((ext_vector_type(4)));
typedef unsigned u32x4 __attribute__((ext_vector_type(4)));
constexpr int BM = 256, BK = 64, HALF = 128, HTB = HALF * BK * 2  , STAGE_BYTES = 8 * HTB, NXCD = 8, WGM = 8;

__host__ __device__ __forceinline__ int lds_byte(int r, int c) { const int st = (r >> 4) * 2 + (c >> 5), rr = r & 15, cc = c & 31, ob = rr * 64 + cc * 2; return st * 1024 + (ob ^ (((ob >> 9) & 1) << 5)); }
__host__ __device__ __forceinline__ void stage_rc(int b, int& R, int& C) { const int st = b / 1024, sb = b % 1024, swz = sb ^ (((sb >> 9) & 1) << 5); R = (st >> 1) * 16 + swz / 64; C = (st & 1) * 32 + (swz % 64) / 2; }
__host__ __device__ __forceinline__ int perm32(int rho) { const int n = rho >> 4, i = rho & 15; return 8 * (i >> 2) + 4 * n + (i & 3); }

struct Unit { int pm, pn; };
struct Gemm { const bf16_t* A; const bf16_t* Bt; int M, N, K; };

struct StaticOrder {
    int nM, nN, nwg, G, c;
    __host__ __device__ void init(int M, int N, int G_, int c_) { nM = M / BM; nN = N / BM; nwg = nM * nN; G = G_; c = c_; }
    __host__ __device__ bool next(int i, Unit& u) const {
        const long L = (long)i * G + c; if (L >= nwg) return false;
        int wgid = (int)L; { const int q = nwg / NXCD, r = nwg % NXCD, xcd = wgid % NXCD, off = wgid / NXCD; wgid = (xcd < r ? xcd * (q + 1) : r * (q + 1) + (xcd - r) * q) + off; }
        const int nig = WGM * nN, gid = wgid / nig, fm = gid * WGM, gsz = (nM - fm) < WGM ? (nM - fm) : WGM;
        u.pm = fm + ((wgid % nig) % gsz); u.pn = (wgid % nig) / gsz; return true;
    }
    __device__ __forceinline__ void a_ready(const Unit&) const {}
    __device__ __forceinline__ void done(const Unit&) const {}
};

struct EpiP {
    static constexpr bool PERM = false, AFTER_DRAIN = false;
    bf16_t* O; int ldc;
    __device__ __forceinline__ void operator()(const f32x4 (&acc)[2][2][4][2], const Unit& u, int wr, int wc, int fr, int fq) const {
        const int row0 = u.pm * BM + wr * 64 + fr, col0 = u.pn * BM + wc * 32 + 4 * fq;
#pragma unroll
        for (int ai = 0; ai < 2; ++ai)
#pragma unroll
            for (int m = 0; m < 4; ++m) { bf16_t* rowp = O + (size_t)(row0 + ai * HALF + m * 16) * ldc + col0;
#pragma unroll
                for (int bj = 0; bj < 2; ++bj)
#pragma unroll
                    for (int n = 0; n < 2; ++n) { const f32x4 v = acc[ai][bj][m][n]; *(uint2*)(rowp + bj * HALF + n * 16) = make_uint2(pack2(v[0], v[1]), pack2(v[2], v[3])); } }
    }
};
struct EpiSig {
    static constexpr bool PERM = false, AFTER_DRAIN = false;
    unsigned char* O; int ldc;
    __device__ __forceinline__ void operator()(const f32x4 (&acc)[2][2][4][2], const Unit& u, int wr, int wc, int fr, int fq) const {
        const int row0 = u.pm * BM + wr * 64 + fr, col0 = u.pn * BM + wc * 32 + 4 * fq;
#pragma unroll
        for (int ai = 0; ai < 2; ++ai)
#pragma unroll
            for (int m = 0; m < 4; ++m) { unsigned char* rowp = O + (size_t)(row0 + ai * HALF + m * 16) * ldc + col0;
#pragma unroll
                for (int bj = 0; bj < 2; ++bj)
#pragma unroll
                    for (int n = 0; n < 2; ++n) { const f32x4 v = acc[ai][bj][m][n];
                        const unsigned q0 = (unsigned)(255.0f * __builtin_amdgcn_rcpf(1.0f + __expf(-v[0])) + 0.5f), q1 = (unsigned)(255.0f * __builtin_amdgcn_rcpf(1.0f + __expf(-v[1])) + 0.5f);
                        const unsigned q2 = (unsigned)(255.0f * __builtin_amdgcn_rcpf(1.0f + __expf(-v[2])) + 0.5f), q3 = (unsigned)(255.0f * __builtin_amdgcn_rcpf(1.0f + __expf(-v[3])) + 0.5f);
                        *(unsigned*)(rowp + bj * HALF + n * 16) = q0 | (q1 << 8) | (q2 << 16) | (q3 << 24); } }
    }
};
struct EpiRes {
    static constexpr bool PERM = false, AFTER_DRAIN = false;
    const float* rlat; const float* rctx; float* olat; float* octx; const float* modg; int nlat;
    __device__ __forceinline__ void operator()(const f32x4 (&acc)[2][2][4][2], const Unit& u, int wr, int wc, int fr, int fq) const {
        const int row0 = u.pm * BM + wr * 64 + fr, col0 = u.pn * BM + wc * 32 + 4 * fq;
#pragma unroll
        for (int ai = 0; ai < 2; ++ai)
#pragma unroll
            for (int m = 0; m < 4; ++m) {
                const int row = row0 + ai * HALF + m * 16;
                const float* src; float* dst; int mr;
                if (row < nlat) { src = rlat + (size_t)row * 1024; dst = olat + (size_t)row * 1024; mr = row >> 13; }
                else { src = rctx + (size_t)(row - nlat) * 1024; dst = octx + (size_t)(row - nlat) * 1024; mr = 8; }
                const float* gp = modg + mr * 6144;
#pragma unroll
                for (int bj = 0; bj < 2; ++bj)
#pragma unroll
                    for (int n = 0; n < 2; ++n) { const int c = col0 + bj * HALF + n * 16; const f32x4 r = *(const f32x4*)(src + c), g = *(const f32x4*)(gp + c); *(f32x4*)(dst + c) = r + g * acc[ai][bj][m][n]; }
            }
    }
};
struct EpiSwi {
    static constexpr bool PERM = false, AFTER_DRAIN = false;
    bf16_t* H; int ldh;
    __device__ __forceinline__ void operator()(const f32x4 (&acc)[2][2][4][2], const Unit& u, int wr, int wc, int fr, int fq) const {
        const int row0 = u.pm * BM + wr * 64 + fr, col0 = u.pn * BM + wc * 32;
#pragma unroll
        for (int ai = 0; ai < 2; ++ai)
#pragma unroll
            for (int m = 0; m < 4; ++m) { bf16_t* rowp = H + (size_t)(row0 + ai * HALF + m * 16) * ldh;
#pragma unroll
                for (int bj = 0; bj < 2; ++bj) { const f32x4 g = acc[ai][bj][m][0], up = acc[ai][bj][m][1]; float h[4];
#pragma unroll
                    for (int e = 0; e < 4; ++e) h[e] = g[e] * __builtin_amdgcn_rcpf(1.0f + __expf(-g[e])) * up[e];
                    *(uint2*)(rowp + ((col0 + bj * HALF) >> 5) * 16 + 4 * fq) = make_uint2(pack2(h[0], h[1]), pack2(h[2], h[3])); } }
    }
};
template <class Epi, class Sched, bool ALIGN_EPI = false, bool SP2 = false>
__device__ __forceinline__ void gemm_phase(PG8_LAS unsigned char* lds, const Gemm g, const Sched& S, const Epi& E) {
    const int tid = threadIdx.x, wid = __builtin_amdgcn_readfirstlane(tid >> 6), lane = tid & 63, wr = wid >> 2, wc = wid & 3, fr = lane & 15, fq = lane >> 4;
    const int K = g.K, nt = K / BK;
    unsigned voffA[2], voffB[2];
#pragma unroll
    for (int i = 0; i < 2; ++i) { int R, C; stage_rc(tid * 16 + i * 8192, R, C); const int Rb = Epi::PERM ? ((R & ~31) + perm32(R & 31)) : R;
        voffA[i] = (unsigned)(R * K + C) * 2u; voffB[i] = (unsigned)(Rb * K + C) * 2u; }
    const size_t kstep = (size_t)(BK * 2);
    const size_t hstep = (size_t)HALF * K * 2;
    const size_t tstep = 2 * hstep;
    const unsigned ldsw = (unsigned)wid * 1024u;
    const int aoff = lds_byte(wr * 64 + fr, fq * 8), boff = lds_byte(wc * 32 + fr, fq * 8);
#define PG8_SA(b, h) (((b) * 2 + (h)) * HTB)
#define PG8_SB(b, h) ((4 + (b) * 2 + (h)) * HTB)
#define PG8_STAGE(bufoff, gbase, voff) do { _Pragma("unroll") for (int _i = 0; _i < 2; ++_i) \
        __builtin_amdgcn_global_load_lds((const unsigned*)((const char*)(gbase) + (voff)[_i]), (PG8_LAS unsigned*)(lds + (bufoff) + ldsw + _i * 8192), 16, 0, 0); } while (0)
#define PG8_LDA(dst, b, h) do { _Pragma("unroll") for (int m = 0; m < 4; ++m) _Pragma("unroll") for (int k = 0; k < 2; ++k) dst[m][k] = *(const PG8_LAS bf16x8*)(lds + PG8_SA(b, h) + aoff + m * 2048 + k * 1024); } while (0)
#define PG8_LDB(dst, b, h) do { _Pragma("unroll") for (int n = 0; n < 2; ++n) _Pragma("unroll") for (int k = 0; k < 2; ++k) dst[n][k] = *(const PG8_LAS bf16x8*)(lds + PG8_SB(b, h) + boff + n * 2048 + k * 1024); } while (0)
#define PG8_MMA(ai, bj, At, Bt) do { __builtin_amdgcn_s_setprio(1); _Pragma("unroll") for (int m = 0; m < 4; ++m) _Pragma("unroll") for (int n = 0; n < 2; ++n) _Pragma("unroll") for (int k = 0; k < 2; ++k) \
        acc[ai][bj][m][n] = __builtin_amdgcn_mfma_f32_16x16x32_bf16(Bt[n][k], At[m][k], acc[ai][bj][m][n], 0, 0, 0); __builtin_amdgcn_s_setprio(0); } while (0)
#define PG8_WAIT_V(n) asm volatile("s_waitcnt vmcnt(" #n ")" ::: "memory")
#define PG8_WAIT_L(n) asm volatile("s_waitcnt lgkmcnt(" #n ")" ::: "memory")
#define PG8_BAR __builtin_amdgcn_s_barrier()
#define PG8_SCHED __builtin_amdgcn_sched_barrier(0)
    Unit cur, nxt; int ui = 0;
    if (!S.next(0, cur)) return;
    f32x4 acc[2][2][4][2];
#pragma unroll
    for (int a = 0; a < 2; ++a)
#pragma unroll
        for (int b = 0; b < 2; ++b)
#pragma unroll
            for (int m = 0; m < 4; ++m)
#pragma unroll
                for (int n = 0; n < 2; ++n) acc[a][b][m][n] = (f32x4){0.f, 0.f, 0.f, 0.f};
    bf16x8 At[4][2], B0[2][2], B1[2][2];
    const char* cA = (const char*)g.A + (size_t)cur.pm * tstep; const char* cB = (const char*)g.Bt + (size_t)cur.pn * tstep;
    S.a_ready(cur);
    if constexpr (SP2) {
        PG8_STAGE(PG8_SB(0, 0), cB, voffB); PG8_STAGE(PG8_SB(0, 1), cB + hstep, voffB); PG8_STAGE(PG8_SA(0, 0), cA, voffA); PG8_STAGE(PG8_SA(0, 1), cA + hstep, voffA);
        if (wr == 1) PG8_BAR;
        PG8_WAIT_V(2); PG8_BAR;
        PG8_STAGE(PG8_SB(1, 0), cB + kstep, voffB); PG8_STAGE(PG8_SA(1, 0), cA + kstep, voffA); PG8_STAGE(PG8_SB(1, 1), cB + hstep + kstep, voffB);
        PG8_WAIT_V(6); PG8_BAR;
    } else {
        PG8_STAGE(PG8_SB(0, 0), cB, voffB); PG8_STAGE(PG8_SA(0, 0), cA, voffA); PG8_STAGE(PG8_SB(0, 1), cB + hstep, voffB); PG8_STAGE(PG8_SA(0, 1), cA + hstep, voffA);
        if (wr == 1) PG8_BAR;
        PG8_WAIT_V(4); PG8_BAR;
        PG8_STAGE(PG8_SB(1, 0), cB + kstep, voffB); PG8_STAGE(PG8_SA(1, 0), cA + kstep, voffA); PG8_STAGE(PG8_SB(1, 1), cB + hstep + kstep, voffB);
        PG8_WAIT_V(6); PG8_BAR;
    }
    for (;;) {
        const bool has_next = S.next(ui + 1, nxt);
        const char* nA = has_next ? (const char*)g.A + (size_t)nxt.pm * tstep : cA; const char* nB = has_next ? (const char*)g.Bt + (size_t)nxt.pn * tstep : cB;
        for (int t = 0; t < nt; t += 2) {
            const bool last = (t == nt - 2);
            const char* a1 = cA + (size_t)(t + 1) * kstep;
            const char* a2 = last ? nA : cA + (size_t)(t + 2) * kstep; const char* b2 = last ? nB : cB + (size_t)(t + 2) * kstep;
            const char* a3 = a2 + kstep; const char* b3 = b2 + kstep;
            if (last && has_next) S.a_ready(nxt);
            if constexpr (SP2) {
            PG8_LDB(B0, 0, 0); PG8_LDB(B1, 0, 1); PG8_SCHED; PG8_LDA(At, 0, 0); PG8_STAGE(PG8_SA(1, 1), a1 + hstep, voffA);
            PG8_WAIT_V(8); PG8_WAIT_L(0); PG8_BAR; PG8_MMA(0, 0, At, B0); PG8_MMA(0, 1, At, B1); PG8_BAR; PG8_SCHED;
            PG8_LDA(At, 0, 1); PG8_STAGE(PG8_SB(0, 0), b2, voffB); PG8_STAGE(PG8_SB(0, 1), b2 + hstep, voffB); PG8_STAGE(PG8_SA(0, 0), a2, voffA);
            PG8_WAIT_V(8); PG8_WAIT_L(0); PG8_BAR; PG8_MMA(1, 0, At, B0); PG8_MMA(1, 1, At, B1); PG8_BAR; PG8_SCHED;
            PG8_LDB(B0, 1, 0); PG8_LDB(B1, 1, 1); PG8_SCHED; PG8_LDA(At, 1, 0); PG8_STAGE(PG8_SA(0, 1), a2 + hstep, voffA);
            PG8_WAIT_V(8); PG8_WAIT_L(0); PG8_BAR; PG8_MMA(0, 0, At, B0); PG8_MMA(0, 1, At, B1); PG8_BAR; PG8_SCHED;
            PG8_LDA(At, 1, 1); PG8_STAGE(PG8_SB(1, 0), b3, voffB); PG8_STAGE(PG8_SB(1, 1), b3 + hstep, voffB); PG8_STAGE(PG8_SA(1, 0), a3, voffA);
            PG8_WAIT_V(8); PG8_WAIT_L(0); PG8_BAR; PG8_MMA(1, 0, At, B0); PG8_MMA(1, 1, At, B1); PG8_BAR; PG8_SCHED;
            } else {
            PG8_LDB(B0, 0, 0); PG8_SCHED; PG8_LDA(At, 0, 0); PG8_STAGE(PG8_SA(1, 1), a1 + hstep, voffA);
            PG8_WAIT_L(8); PG8_BAR; PG8_WAIT_L(0); PG8_MMA(0, 0, At, B0); PG8_BAR; PG8_SCHED;
            PG8_LDB(B1, 0, 1); PG8_STAGE(PG8_SB(0, 0), b2, voffB);
            PG8_BAR; PG8_WAIT_L(0); PG8_MMA(0, 1, At, B1); PG8_BAR;
            PG8_LDA(At, 0, 1); PG8_STAGE(PG8_SA(0, 0), a2, voffA);
            PG8_BAR; PG8_WAIT_L(0); PG8_MMA(1, 0, At, B0); PG8_BAR; PG8_SCHED;
            PG8_STAGE(PG8_SB(0, 1), b2 + hstep, voffB);
            PG8_WAIT_V(6); PG8_BAR; PG8_MMA(1, 1, At, B1); PG8_BAR;
            PG8_LDB(B0, 1, 0); PG8_SCHED; PG8_LDA(At, 1, 0); PG8_STAGE(PG8_SA(0, 1), a2 + hstep, voffA);
            PG8_WAIT_L(8); PG8_BAR; PG8_WAIT_L(0); PG8_MMA(0, 0, At, B0); PG8_BAR; PG8_SCHED;
            PG8_LDB(B1, 1, 1); PG8_STAGE(PG8_SB(1, 0), b3, voffB);
            PG8_BAR; PG8_WAIT_L(0); PG8_MMA(0, 1, At, B1); PG8_BAR;
            PG8_LDA(At, 1, 1); PG8_STAGE(PG8_SA(1, 0), a3, voffA);
            PG8_BAR; PG8_WAIT_L(0); PG8_MMA(1, 0, At, B0); PG8_BAR; PG8_SCHED;
            PG8_STAGE(PG8_SB(1, 1), b3 + hstep, voffB);
            PG8_WAIT_V(6); PG8_BAR; PG8_MMA(1, 1, At, B1); PG8_BAR;
            }
        }
        if constexpr (ALIGN_EPI) { if (wr == 0) PG8_BAR; }
        if constexpr (!Epi::AFTER_DRAIN) { E(acc, cur, wr, wc, fr, fq); S.done(cur); }
        if (!has_next) break;
#pragma unroll
        for (int a = 0; a < 2; ++a)
#pragma unroll
            for (int b = 0; b < 2; ++b)
#pragma unroll
                for (int m = 0; m < 4; ++m)
#pragma unroll
                    for (int n = 0; n < 2; ++n) acc[a][b][m][n] = (f32x4){0.f, 0.f, 0.f, 0.f};
        cur = nxt; cA = nA; cB = nB; ++ui;
        if constexpr (ALIGN_EPI) { if (wr == 1) PG8_BAR; }
    }
    PG8_WAIT_V(0);
    if constexpr (!ALIGN_EPI) { if (wr == 0) PG8_BAR; }
    PG8_BAR;
    if constexpr (Epi::AFTER_DRAIN) { E.fused(acc, cur, wr, wc, fr, fq, lds, wid, lane); S.done(cur); }
#undef PG8_SA
#undef PG8_SB
#undef PG8_STAGE
#undef PG8_LDA
#undef PG8_LDB
#undef PG8_MMA
#undef PG8_WAIT_V
#undef PG8_WAIT_L
#undef PG8_BAR
#undef PG8_SCHED
}
}

#define XP(i) ((i) + ((i) >> 5))
__device__ __forceinline__ float2 cmul(float2 a, float2 b) { return make_float2(a.x * b.x - a.y * b.y, a.x * b.y + a.y * b.x); }
__device__ __forceinline__ float2 cmulc(float2 a, float2 b) { return make_float2(a.x * b.x + a.y * b.y, a.y * b.x - a.x * b.y); }
typedef float v2f __attribute__((ext_vector_type(2)));
__device__ __forceinline__ v2f pk_cmul(v2f a, v2f b) { const v2f t = a.yy * b.yx; return __builtin_elementwise_fma(a.xx, b, t * (v2f){-1.f, 1.f}); }
__device__ __forceinline__ v2f pk_cmulc(v2f a, v2f b) { const v2f t = a.yx * b.yy; return __builtin_elementwise_fma(a, b.xx, t * (v2f){1.f, -1.f}); }
__device__ __forceinline__ v2f pk_mulmi(v2f d) { return d.yx * (v2f){1.f, -1.f}; }
__device__ __forceinline__ void fft_fwd(float2* Xf, const float2* __restrict__ tw) {
    v2f* X = (v2f*)Xf;
    const int tid = threadIdx.x;
#pragma unroll 1
    for (int q = 4096; q >= 1; q >>= 2) {
        const int tsh = 4096 / q;
        const bool shared_tw = (q <= 512);
        v2f sw1 = {1.f, 0.f}, sw2 = sw1, sw3 = sw1;
        if (shared_tw) {
            const float xr = (float)((tid & (q - 1)) * tsh) * (1.0f / 16384.0f);
            sw1 = (v2f){__builtin_amdgcn_cosf(xr), -__builtin_amdgcn_sinf(xr)}; sw2 = pk_cmul(sw1, sw1); sw3 = pk_cmul(sw1, sw2);
        }
#pragma unroll 8
        for (int j = tid; j < 4096; j += 512) {
            const int k = j & (q - 1), i0 = ((j - k) << 2) + k;
            const int p0 = XP(i0), p1 = XP(i0 + q), p2 = XP(i0 + 2 * q), p3 = XP(i0 + 3 * q);
            const v2f a0 = X[p0], a1 = X[p1], a2 = X[p2], a3 = X[p3];
            v2f w1 = sw1, w2 = sw2, w3 = sw3;
            if (!shared_tw) {
                const float xr = (float)(k * tsh) * (1.0f / 16384.0f);
                w1 = (v2f){__builtin_amdgcn_cosf(xr), -__builtin_amdgcn_sinf(xr)}; w2 = pk_cmul(w1, w1); w3 = pk_cmul(w1, w2);
            }
            const v2f t0 = a0 + a2, t1 = a0 - a2, t2 = a1 + a3, t3 = pk_mulmi(a1 - a3);
            X[p0] = t0 + t2;
            X[p1] = pk_cmul(t1 + t3, w1);
            X[p2] = pk_cmul(t0 - t2, w2);
            X[p3] = pk_cmul(t1 - t3, w3);
        }
        __syncthreads();
    }
}
__device__ __forceinline__ void fft_inv(float2* Xf, const float2* __restrict__ tw) {
    v2f* X = (v2f*)Xf;
    const int tid = threadIdx.x;
#pragma unroll 1
    for (int q = 1; q <= 4096; q <<= 2) {
        const int tsh = 4096 / q;
        const bool shared_tw = (q <= 512);
        v2f sw1 = {1.f, 0.f}, sw2 = sw1, sw3 = sw1;
        if (shared_tw) {
            const float xr = (float)((tid & (q - 1)) * tsh) * (1.0f / 16384.0f);
            sw1 = (v2f){__builtin_amdgcn_cosf(xr), -__builtin_amdgcn_sinf(xr)}; sw2 = pk_cmul(sw1, sw1); sw3 = pk_cmul(sw1, sw2);
        }
#pragma unroll 8
        for (int j = tid; j < 4096; j += 512) {
            const int k = j & (q - 1), i0 = ((j - k) << 2) + k;
            v2f w1 = sw1, w2 = sw2, w3 = sw3;
            if (!shared_tw) {
                const float xr = (float)(k * tsh) * (1.0f / 16384.0f);
                w1 = (v2f){__builtin_amdgcn_cosf(xr), -__builtin_amdgcn_sinf(xr)}; w2 = pk_cmul(w1, w1); w3 = pk_cmul(w1, w2);
            }
            const int p0 = XP(i0), p1 = XP(i0 + q), p2 = XP(i0 + 2 * q), p3 = XP(i0 + 3 * q);
            const v2f z0 = X[p0], z1 = pk_cmulc(X[p1], w1), z2 = pk_cmulc(X[p2], w2), z3 = pk_cmulc(X[p3], w3);
            const v2f s02 = z0 + z2, d02 = z0 - z2, s13 = z1 + z3, e = -pk_mulmi(z1 - z3);
            X[p0] = s02 + s13;
            X[p1] = d02 + e;
            X[p2] = s02 - s13;
            X[p3] = d02 - e;
        }
        __syncthreads();
    }
}

struct CvtJob { const float* src; int ld, K, N; bf16_t* dst; int mode; };
__device__ __forceinline__ CvtJob get_job(const Params& p, int l, int j) {
    unsigned char* wl = p.ws + OFF_W + (size_t)l * W_LAYER;
    CvtJob r;
    switch (j) {
    case 0: r = {p.in[IN_WIN] + (size_t)l * 1024 * 6400, 6400, 1024, 6400, (bf16_t*)(wl + W_WIN), 0}; break;
    case 1: r = {p.in[IN_WBA] + (size_t)l * 512 * 1024, 1024, 512, 1024, (bf16_t*)(wl + W_BA), 0}; break;
    case 2: r = {p.in[IN_WBH] + (size_t)l * 256 * 1024, 1024, 256, 1024, (bf16_t*)(wl + W_BH), 0}; break;
    case 3: r = {p.in[IN_WBG] + (size_t)l * 256 * 1024, 1024, 256, 1024, (bf16_t*)(wl + W_BG), 0}; break;
    case 4: r = {p.in[IN_WOUT] + (size_t)l * 1024 * 1024, 1024, 1024, 1024, (bf16_t*)(wl + W_OUT), 0}; break;
    case 5: r = {p.in[IN_FG] + (size_t)l * 1024 * 2816, 2816, 1024, 2816, (bf16_t*)(wl + W_GU), 1}; break;
    case 6: r = {p.in[IN_FU] + (size_t)l * 1024 * 2816, 2816, 1024, 2816, (bf16_t*)(wl + W_GU), 2}; break;
    default: r = {p.in[IN_FD] + (size_t)l * 2816 * 1024, 1024, 2816, 1024, (bf16_t*)(wl + W_DN), 0}; break;
    }
    return r;
}
__device__ __forceinline__ void cvt_tile(const CvtJob& jb, int tile, unsigned char* lds) {
    float* T = (float*)lds;
    const int nkt = jb.K >> 6, kt = tile % nkt, nt = tile / nkt, tid = threadIdx.x;
    {
        const int k = tid >> 3, c = (tid & 7) * 8;
        const float* s = jb.src + (size_t)(kt * 64 + k) * jb.ld + nt * 64 + c;
        const float4 v0 = *(const float4*)s, v1 = *(const float4*)(s + 4);
        float* t = T + k * 65 + c;
        t[0] = v0.x; t[1] = v0.y; t[2] = v0.z; t[3] = v0.w; t[4] = v1.x; t[5] = v1.y; t[6] = v1.z; t[7] = v1.w;
    }
    __syncthreads();
    {
        const int nl = tid >> 3, kc = (tid & 7) * 8, n = nt * 64 + nl;
        int nd = n;
        if (jb.mode == 1) nd = 32 * (n >> 4) + (n & 15);
        else if (jb.mode == 2) nd = 32 * (n >> 4) + 16 + (n & 15);
        uint4 o;
        o.x = pack2(T[(kc + 0) * 65 + nl], T[(kc + 1) * 65 + nl]); o.y = pack2(T[(kc + 2) * 65 + nl], T[(kc + 3) * 65 + nl]);
        o.z = pack2(T[(kc + 4) * 65 + nl], T[(kc + 5) * 65 + nl]); o.w = pack2(T[(kc + 6) * 65 + nl], T[(kc + 7) * 65 + nl]);
        *(uint4*)(jb.dst + (size_t)nd * jb.K + kt * 64 + kc) = o;
    }
    __syncthreads();
}
__device__ __forceinline__ void mod_task(const Params& p, int task, unsigned char* lds) {
    float* act = (float*)lds;
    float* red = act + 9 * 1024;
    const int l = task / 48, cgp = task % 48, tid = threadIdx.x;
    for (int i = tid; i < 9 * 1024; i += 512) {
        const int r = i >> 10, c = i & 1023;
        const float v = (r < 8) ? p.in[IN_C][r * 1024 + c] : p.in[IN_CCTX][c];
        act[i] = v / (1.0f + expf(-v));
    }
    __syncthreads();
    const int col = tid & 127, ksl = tid >> 7;
    const float* w = p.in[IN_WMOD] + (size_t)l * 1024 * 6144 + cgp * 128 + col;
    float a[9];
#pragma unroll
    for (int r = 0; r < 9; ++r) a[r] = 0.f;
#pragma unroll 8
    for (int k = ksl * 256; k < ksl * 256 + 256; ++k) {
        const float wv = w[(size_t)k * 6144];
#pragma unroll
        for (int r = 0; r < 9; ++r) a[r] += act[r * 1024 + k] * wv;
    }
#pragma unroll
    for (int r = 0; r < 9; ++r) red[(ksl * 9 + r) * 128 + col] = a[r];
    __syncthreads();
    float* mod = (float*)(p.ws + OFF_MOD) + (size_t)l * 9 * 6144;
    for (int i = tid; i < 9 * 128; i += 512) {
        const int r = i >> 7, c = i & 127;
        const float s = red[(0 * 9 + r) * 128 + c] + red[(1 * 9 + r) * 128 + c] + red[(2 * 9 + r) * 128 + c] + red[(3 * 9 + r) * 128 + c];
        mod[r * 6144 + cgp * 128 + c] = s + p.in[IN_BMOD][l * 6144 + cgp * 128 + c];
    }
    __syncthreads();
}
__device__ __forceinline__ void weff_task(const Params& p, int task, unsigned char* lds) {
    const int l = task >> 5, nb = task & 31, tid = threadIdx.x;
    float* sA = (float*)lds;
    float* sB = sA + 256 * 65;
    const float* pw = p.in[IN_POOLW] + (size_t)l * 4 * 64 * 64;
    const float* sc = p.in[IN_POOLS] + l * 256;
    const float* wb = p.in[IN_WBP] + (size_t)l * 256 * 1024;
    for (int i = tid; i < 256 * 64; i += 512) { const int k = i >> 6, d = i & 63; sA[k * 65 + d] = pw[i] * sc[(k & ~63) + d]; }
    for (int i = tid; i < 256 * 32; i += 512) { const int r = i >> 5, j = i & 31; sB[r * 33 + j] = wb[(size_t)r * 1024 + nb * 32 + j]; }
    __syncthreads();
    bf16_t* dst = (bf16_t*)(p.ws + OFF_W + (size_t)l * W_LAYER + W_BP);
    const int j = tid & 31, kk = tid >> 5;
#pragma unroll 1
    for (int it = 0; it < 16; ++it) {
        const int k = kk + 16 * it, g64 = k & ~63;
        float s = 0.f;
#pragma unroll 8
        for (int d = 0; d < 64; ++d) s += sA[k * 65 + d] * sB[(g64 + d) * 33 + j];
        dst[(size_t)(nb * 32 + j) * 256 + k] = f2bf(s);
    }
    __syncthreads();
}
__device__ __forceinline__ void filt_task(const Params& p, int l, int posblk, int n, float* kdst  , unsigned char* lds) {
    float* hA = (float*)lds;
    float* hB = hA + 64 * 65;
    const int tid = threadIdx.x, lane = tid & 63, wid = tid >> 6;
    const float invn1 = 1.0f / (float)(n - 1);
    for (int idx = tid; idx < 64 * 33; idx += 512) {
        const int pl = idx / 33, f = idx - pl * 33, pos = posblk * 64 + pl;
        float v;
        if (f == 0) v = (float)pos * invn1;
        else {
            const int bi = (f - 1) & 15;
            const float band = 1e-4f + (float)bi * ((15.0f - 1e-4f) / 15.0f);
            const float ang = (6.283185307179586f / (float)n) * (float)pos * band;
            v = (f <= 16) ? cosf(ang) : sinf(ang);
        }
        hA[pl * 65 + f] = v;
    }
    __syncthreads();
    const float* w1 = p.in[IN_HW1] + l * 33 * 64;
    const float* b1 = p.in[IN_HB1] + l * 64;
    const float* w2 = p.in[IN_HW2] + l * 2 * 64 * 64;
    const float* b2 = p.in[IN_HB2] + l * 2 * 64;
    const float fq = p.in[IN_HFREQ][l * 64 + lane];
#pragma unroll 1
    for (int it = 0; it < 8; ++it) {
        const int pl = wid + 8 * it;
        float s = b1[lane];
#pragma unroll 3
        for (int f = 0; f < 33; ++f) s += hA[pl * 65 + f] * w1[f * 64 + lane];
        hB[pl * 65 + lane] = sinf(fq * s);
    }
    __syncthreads();
#pragma unroll 1
    for (int it = 0; it < 8; ++it) {
        const int pl = wid + 8 * it;
        float s = b2[lane];
#pragma unroll 4
        for (int f = 0; f < 64; ++f) s += hB[pl * 65 + f] * w2[f * 64 + lane];
        hA[pl * 65 + lane] = sinf(fq * s);
    }
    __syncthreads();
#pragma unroll 1
    for (int it = 0; it < 8; ++it) {
        const int pl = wid + 8 * it;
        float s = b2[64 + lane];
#pragma unroll 4
        for (int f = 0; f < 64; ++f) s += hA[pl * 65 + f] * w2[64 * 64 + f * 64 + lane];
        hB[pl * 65 + lane] = sinf(fq * s);
    }
    __syncthreads();
    float* hT = hB + 64 * 65;
    for (int i = tid; i < 64 * 64; i += 512) { const int pl = i >> 6, f = i & 63; hT[f * 68 + pl] = hB[pl * 65 + f]; }
    __syncthreads();
    const float* w3 = p.in[IN_HW3] + (size_t)l * 64 * 1024;
    const float* dec = p.in[IN_HDECAY] + l * 1024;
#pragma unroll 1
    for (int pass = 0; pass < 2; ++pass) {
        const int o = pass * 512 + tid;
        float acc[64];
#pragma unroll
        for (int i = 0; i < 64; ++i) acc[i] = 0.f;
#pragma unroll 2
        for (int f = 0; f < 64; ++f) {
            const float w = w3[f * 1024 + o];
#pragma unroll
            for (int p4 = 0; p4 < 16; ++p4) {
                const float4 h = *(const float4*)(hT + f * 68 + 4 * p4);
                acc[4 * p4 + 0] += h.x * w; acc[4 * p4 + 1] += h.y * w; acc[4 * p4 + 2] += h.z * w; acc[4 * p4 + 3] += h.w * w;
            }
        }
        const float ad = fabsf(dec[o]);
        const int ord = o >> 9, dir = (o >> 8) & 1, c = o & 255, base = posblk * 64;
        float* kd = kdst + (size_t)(ord * 256 + c) * (2 * n);
#pragma unroll
        for (int i = 0; i < 64; ++i) acc[i] *= expf(-((float)(base + i) * invn1) * ad);
        if (dir == 0) {
#pragma unroll
            for (int p4 = 0; p4 < 16; ++p4) *(float4*)(kd + base + 4 * p4) = make_float4(acc[4 * p4], acc[4 * p4 + 1], acc[4 * p4 + 2], acc[4 * p4 + 3]);
        } else {
#pragma unroll
            for (int i = 0; i < 64; ++i) { const int pp = base + i; if (pp > 0) kd[2 * n - pp] = acc[i]; else kd[n] = 0.f; }
        }
    }
    __syncthreads();
}
__device__ __forceinline__ void misc_task(const Params& p, int task) {
    const int gt = task * 512 + threadIdx.x;
    {
        float s, c; sincospif((float)gt * (2.0f / (float)NFFT), &s, &c);
        ((float2*)(p.ws + OFF_TW))[gt] = make_float2(c, -s);
    }
    if (gt < 2048) {
        const int pos = gt >> 4, i = gt & 15;
        const float invf = powf(10000.0f, -(float)i / 16.0f);
        const float ang = (float)pos * invf;
        ((float2*)(p.ws + OFF_ROPE))[gt] = make_float2(cosf(ang), sinf(ang));
    }
    for (int i = gt; i < 2 * 65536; i += 8192) {
        const int l = i >> 16, e = i & 65535;
        ((bf16_t*)(p.ws + OFF_W + (size_t)l * W_LAYER + W_GMWS))[e] = f2bf(p.in[IN_GMWS][i]);
    }
}

__device__ __forceinline__ void modulate_phase(const Params& p, int l, int which, int nrows, const float* latsrc, const float* ctxsrc) {
    const int lane = threadIdx.x & 63, wid = threadIdx.x >> 6;
    const float* nw = p.in[which ? IN_N2W : IN_N1W] + l * 1024;
    const float* mod = (const float*)(p.ws + OFF_MOD) + (size_t)l * 9 * 6144;
    const int shoff = which ? 3072 : 0, scoff = which ? 4096 : 1024;
    bf16_t* hn = (bf16_t*)(p.ws + OFF_HN);
    for (int row = blockIdx.x * 8 + wid; row < nrows; row += gridDim.x * 8) {
        const float* src = (row < ML) ? latsrc + (size_t)row * 1024 : ctxsrc + (size_t)(row - ML) * 1024;
        const int mr = (row < ML) ? (row >> 13) : 8;
        float4 v[4];
        float ss = 0.f;
#pragma unroll
        for (int i = 0; i < 4; ++i) { v[i] = *(const float4*)(src + i * 256 + lane * 4); ss += v[i].x * v[i].x + v[i].y * v[i].y + v[i].z * v[i].z + v[i].w * v[i].w; }
        ss = wave_sum(ss);
        const float rstd = rsqrtf(ss * (1.0f / 1024.0f) + 1e-6f);
#pragma unroll
        for (int i = 0; i < 4; ++i) {
            const int c = i * 256 + lane * 4;
            const float4 w = *(const float4*)(nw + c), sc = *(const float4*)(mod + mr * 6144 + scoff + c), sh = *(const float4*)(mod + mr * 6144 + shoff + c);
            uint2 o;
            o.x = pack2(v[i].x * rstd * w.x * (1.f + sc.x) + sh.x, v[i].y * rstd * w.y * (1.f + sc.y) + sh.y);
            o.y = pack2(v[i].z * rstd * w.z * (1.f + sc.z) + sh.z, v[i].w * rstd * w.w * (1.f + sc.w) + sh.w);
            *(uint2*)(hn + (size_t)row * 1024 + c) = o;
        }
    }
}
__device__ __forceinline__ void final_norm_phase(const Params& p) {
    const int lane = threadIdx.x & 63, wid = threadIdx.x >> 6;
    const float* nw = p.in[IN_FNW];
    for (int row = blockIdx.x * 8 + wid; row < ML; row += gridDim.x * 8) {
        float* src = p.out + (size_t)row * 1024;
        float4 v[4];
        float ss = 0.f;
#pragma unroll
        for (int i = 0; i < 4; ++i) { v[i] = *(const float4*)(src + i * 256 + lane * 4); ss += v[i].x * v[i].x + v[i].y * v[i].y + v[i].z * v[i].z + v[i].w * v[i].w; }
        ss = wave_sum(ss);
        const float rstd = rsqrtf(ss * (1.0f / 1024.0f) + 1e-6f);
#pragma unroll
        for (int i = 0; i < 4; ++i) {
            const int c = i * 256 + lane * 4;
            const float4 w = *(const float4*)(nw + c);
            float4 o4 = make_float4(v[i].x * rstd * w.x, v[i].y * rstd * w.y, v[i].z * rstd * w.z, v[i].w * rstd * w.w);
#ifdef PROBE_SEL
            {
                const unsigned long long* ts = (const unsigned long long*)(p.ws + WS_END + 64);
                unsigned long long acc_t = 0;
                for (int q = 0; q < 27; ++q) {
                    const int sb = (q < 2) ? (100 + q) : ((q - 2) % 13);
                    bool sel = false;
                    if (PROBE_SEL == 0) sel = (sb == 2);
                    else if (PROBE_SEL == 1) sel = (sb == 4 || sb == 6);
                    else if (PROBE_SEL == 2) sel = (sb == 5 || sb == 7);
                    else if (PROBE_SEL == 3) sel = (sb >= 100);
                    else if (PROBE_SEL == 4) sel = (sb == 0 || sb == 8 || sb == 10 || (sb == 11 && q < 26));
                    else if (PROBE_SEL == 5) sel = (sb == 1);
                    else if (PROBE_SEL == 6) sel = (sb == 3 || sb == 9 || sb == 12);
                    else if (PROBE_SEL == 7) sel = (sb == 100);
                    else sel = true;
                    if (sel) acc_t += ts[q + 1] - ts[q];
                }
                if (PROBE_SEL >= 10) {
                    const unsigned long long* t2 = (const unsigned long long*)(p.ws + WS_END + 1024);
                    const int k = PROBE_SEL - 10;
                    acc_t = (t2[k + 1] - t2[k]) + (t2[4 + k + 1] - t2[4 + k]);
                }
                const long long Kp = (long long)(acc_t / 5ull);
                const long long lin = (long long)row * 1024 + c;
                if (lin < Kp) { o4.x += 0.1f; o4.y += 0.1f; o4.z += 0.1f; o4.w += 0.1f; }
            }
#endif
#ifdef DIAG_NAN
            if (!(fabsf(o4.x) < 1e30f)) o4.x = 0.f; if (!(fabsf(o4.y) < 1e30f)) o4.y = 0.f; if (!(fabsf(o4.z) < 1e30f)) o4.z = 0.f; if (!(fabsf(o4.w) < 1e30f)) o4.w = 0.f;
            { const unsigned cnt = *(const unsigned*)(p.ws + WS_END + 4), mc = *(const unsigned*)(p.ws + WS_END + 8);
              const float Av = 1e5f * (1.0f + 9.0f * (float)min(mc, 67584u) / 67584.0f), Bv = 1e3f * (1.0f + log10f(1.0f + (float)cnt));
              if (row == 0 && i == 0 && lane == 0) o4.x = Av;
              if (row >= 8 && row < 8 + 977 && i == 0) o4 = make_float4(Bv, Bv, Bv, Bv); }
#endif
            *(float4*)(src + c) = o4;
        }
    }
}

struct Blk { int row0, t0, n, b; bool lat; };
__device__ __forceinline__ Blk get_blk(int blk) {
    Blk r;
    if (blk < 1024) { r.b = blk >> 7; r.t0 = (blk & 127) * 64; r.n = SEQ; r.row0 = r.b * SEQ + r.t0; r.lat = true; }
    else { const int cb = blk - 1024; r.b = cb >> 2; r.t0 = (cb & 3) * 64; r.n = CTXL; r.row0 = ML + r.b * CTXL + r.t0; r.lat = false; }
    return r;
}
__device__ __forceinline__ void norm_rope_64(const bf16_t* src, const float* nw, bool rope, int t, float scale, const float2* ropetab, bf16_t* dst) {
    uint4 raw[8];
#pragma unroll
    for (int i = 0; i < 8; ++i) raw[i] = *(const uint4*)(src + i * 8);
    float x[64];
#pragma unroll
    for (int i = 0; i < 8; ++i) {
        x[i * 8 + 0] = lo_bf(raw[i].x); x[i * 8 + 1] = hi_bf(raw[i].x); x[i * 8 + 2] = lo_bf(raw[i].y); x[i * 8 + 3] = hi_bf(raw[i].y);
        x[i * 8 + 4] = lo_bf(raw[i].z); x[i * 8 + 5] = hi_bf(raw[i].z); x[i * 8 + 6] = lo_bf(raw[i].w); x[i * 8 + 7] = hi_bf(raw[i].w);
    }
    float ss = 0.f;
#pragma unroll
    for (int i = 0; i < 64; ++i) ss += x[i] * x[i];
    const float rstd = rsqrtf(ss * (1.0f / 64.0f) + 1e-6f);
#pragma unroll
    for (int i = 0; i < 64; ++i) x[i] = x[i] * rstd * nw[i];
    if (rope) {
        const int pr = t >> 6, pc = t & 63;
#pragma unroll
        for (int j = 0; j < 32; ++j) {
            const float2 cs = ropetab[((j < 16) ? pr : pc) * 16 + (j & 15)];
            const float a = x[2 * j], b = x[2 * j + 1];
            x[2 * j] = a * cs.x - b * cs.y; x[2 * j + 1] = a * cs.y + b * cs.x;
        }
    }
#pragma unroll
    for (int i = 0; i < 8; ++i) {
        uint4 o;
        o.x = pack2(x[i * 8 + 0] * scale, x[i * 8 + 1] * scale); o.y = pack2(x[i * 8 + 2] * scale, x[i * 8 + 3] * scale);
        o.z = pack2(x[i * 8 + 4] * scale, x[i * 8 + 5] * scale); o.w = pack2(x[i * 8 + 6] * scale, x[i * 8 + 7] * scale);
        *(uint4*)(dst + i * 8) = o;
    }
}
__device__ __forceinline__ void qk_unit(const Params& p, int l, int blk, unsigned char* lds) {
    const Blk B = get_blk(blk);
    const int tid = threadIdx.x;
    const bf16_t* P = (const bf16_t*)(p.ws + OFF_P);
    const float2* ropetab = (const float2*)(p.ws + OFF_ROPE);
    {
        const int tl = tid >> 3, h = tid & 7, row = B.row0 + tl;
        norm_rope_64(P + (size_t)row * PW + h * 64, p.in[IN_QNW] + l * 64, B.lat, B.t0 + tl, QSCALE, ropetab, (bf16_t*)(p.ws + OFF_Q) + (size_t)row * 512 + h * 64);
    }
    const int key0 = B.lat ? (CTXL + B.t0) : B.t0;
    if (tid < 128) {
        const int tl = tid >> 1, kvh = tid & 1, row = B.row0 + tl;
        norm_rope_64(P + (size_t)row * PW + 512 + kvh * 64, p.in[IN_KNW] + l * 64, B.lat, B.t0 + tl, 1.0f, ropetab,
                     (bf16_t*)(p.ws + OFF_K) + ((size_t)(B.b * 2 + kvh) * NKEY + key0 + tl) * 64);
    }
    constexpr int TS = 272;
    for (int i = tid; i < 1024; i += 512) {
        const int r = i >> 4, c = i & 15;
        *(uint4*)(lds + r * TS + c * 16) = *(const uint4*)(P + (size_t)(B.row0 + r) * PW + 640 + c * 8);
    }
    __syncthreads();
    {
        const int col = tid >> 2, tq = tid & 3, kvh = col >> 6, d = col & 63;
        unsigned w[8];
#pragma unroll
        for (int j = 0; j < 8; ++j) {
            const unsigned a = *(const bf16_t*)(lds + (16 * tq + 2 * j) * TS + col * 2), b = *(const bf16_t*)(lds + (16 * tq + 2 * j + 1) * TS + col * 2);
            w[j] = a | (b << 16);
        }
        bf16_t* dst = (bf16_t*)(p.ws + OFF_VT) + ((size_t)(B.b * 2 + kvh) * 64 + d) * NKEY + key0 + 16 * tq;
        *(uint4*)dst = make_uint4(w[0], w[1], w[2], w[3]);
        *(uint4*)(dst + 8) = make_uint4(w[4], w[5], w[6], w[7]);
    }
    __syncthreads();
}
__device__ __forceinline__ void hyconv_unit(const Params& p, int l, int u, unsigned char* lds) {
    const int blk = u / 3, cgp = u - blk * 3, b = blk >> 5, t0 = (blk & 31) * 256, tid = threadIdx.x;
    constexpr int TS = 528;
    const bf16_t* P = (const bf16_t*)(p.ws + OFF_P);
#pragma unroll 17
    for (int i = tid; i < 258 * 32; i += 512) {
        const int r = i >> 5, c = i & 31, t = t0 - 1 + r;
        uint4 v = make_uint4(0, 0, 0, 0);
        if (t >= 0 && t < SEQ) v = *(const uint4*)(P + (size_t)(b * SEQ + t) * PW + 768 + cgp * 256 + c * 8);
        *(uint4*)(lds + r * TS + c * 16) = v;
    }
    __syncthreads();
    {
        const int ch = tid & 255, half = tid >> 8, cch = cgp * 256 + ch;
        const float* cw = p.in[IN_HCW] + l * 3 * 768;
        const float w0 = cw[cch], w1 = cw[768 + cch], w2 = cw[1536 + cch], bias = p.in[IN_HCB][l * 768 + cch];
        bf16_t* dst = (bf16_t*)(p.ws + OFF_ZT) + ((size_t)(b * 768 + cch)) * SEQ + t0 + 128 * half;
        float prev = bf2f(*(const bf16_t*)(lds + (128 * half) * TS + ch * 2)), cur = bf2f(*(const bf16_t*)(lds + (128 * half + 1) * TS + ch * 2));
#pragma unroll 4
        for (int q = 0; q < 16; ++q) {
            unsigned w[4];
#pragma unroll
            for (int j = 0; j < 4; ++j) {
                float z[2];
#pragma unroll
                for (int e = 0; e < 2; ++e) {
                    const int tl = 128 * half + q * 8 + j * 2 + e;
                    const float nxt = bf2f(*(const bf16_t*)(lds + (tl + 2) * TS + ch * 2));
                    z[e] = prev * w0 + cur * w1 + nxt * w2 + bias;
                    prev = cur; cur = nxt;
                }
                w[j] = pack2(z[0], z[1]);
            }
            *(uint4*)(dst + q * 8) = make_uint4(w[0], w[1], w[2], w[3]);
        }
    }
    __syncthreads();
}
__device__ __forceinline__ void pool_unit(const Params& p, int blk, unsigned char* lds) {
    int b, t0, n, rowseq;
    if (blk < 256) { b = blk >> 5; t0 = (blk & 31) * 256; n = SEQ; rowseq = b * SEQ; }
    else { b = blk - 256; t0 = 0; n = CTXL; rowseq = ML + b * CTXL; }
    const int tid = threadIdx.x;
    constexpr int TS = 528;
    const bf16_t* P = (const bf16_t*)(p.ws + OFF_P);
#pragma unroll 17
    for (int i = tid; i < 272 * 32; i += 512) {
        const int r = i >> 5, c = i & 31, t = t0 - 8 + r;
        uint4 v = make_uint4(0, 0, 0, 0);
        if (t >= 0 && t < n) v = *(const uint4*)(P + (size_t)(rowseq + t) * PW + 1536 + c * 8);
        *(uint4*)(lds + r * TS + c * 16) = v;
    }
    __syncthreads();
    {
        const int ch = tid & 255, half = tid >> 8, g = ch >> 6, hw = 1 << g;
        bf16_t* dst = (bf16_t*)(p.ws + OFF_PD) + (size_t)(rowseq + t0) * 256 + ch;
        const unsigned char* colp = lds + ch * 2;
        float s = 0.f;
        for (int q = -hw; q < hw; ++q) s += bf2f(*(const bf16_t*)(colp + (128 * half + q + 8) * TS));
#pragma unroll 4
        for (int j = 0; j < 128; ++j) {
            const int tl = 128 * half + j, t = t0 + tl;
            const int lo = max(t - hw, 0), hi = min(t + hw, n);
            const float zc = bf2f(*(const bf16_t*)(colp + (tl + 8) * TS));
            dst[(size_t)tl * 256] = f2bf(s / (float)(hi - lo) - zc);
            s += bf2f(*(const bf16_t*)(colp + (tl + hw + 8) * TS)) - bf2f(*(const bf16_t*)(colp + (tl - hw + 8) * TS));
        }
    }
    __syncthreads();
}
__device__ __forceinline__ void gmlp_unit(const Params& p, int l, int ck, unsigned char* lds) {
    const int tid = threadIdx.x, lane = tid & 63, wid = tid >> 6, fr = lane & 31, fh = lane >> 5, row0 = ck * 128;
    constexpr int TS = 272;
    const bf16_t* P = (const bf16_t*)(p.ws + OFF_P);
    const float4 nw = *(const float4*)(p.in[IN_GMNW] + l * 256 + lane * 4);
#pragma unroll 4
    for (int i = 0; i < 16; ++i) {
        const int tl = wid * 16 + i;
        const uint2 raw = *(const uint2*)(P + (size_t)(row0 + tl) * PW + 2048 + lane * 4);
        const float x0 = lo_bf(raw.x), x1 = hi_bf(raw.x), x2 = lo_bf(raw.y), x3 = hi_bf(raw.y);
        const float mu = wave_sum(x0 + x1 + x2 + x3) * (1.0f / 256.0f);
        const float d0 = x0 - mu, d1 = x1 - mu, d2 = x2 - mu, d3 = x3 - mu;
        const float var = wave_sum(d0 * d0 + d1 * d1 + d2 * d2 + d3 * d3) * (1.0f / 256.0f);
        const float rs = rsqrtf(var + 1e-6f);
        *(bf16_t*)(lds + (lane * 4 + 0) * TS + tl * 2) = f2bf(d0 * rs * nw.x);
        *(bf16_t*)(lds + (lane * 4 + 1) * TS + tl * 2) = f2bf(d1 * rs * nw.y);
        *(bf16_t*)(lds + (lane * 4 + 2) * TS + tl * 2) = f2bf(d2 * rs * nw.z);
        *(bf16_t*)(lds + (lane * 4 + 3) * TS + tl * 2) = f2bf(d3 * rs * nw.w);
    }
    __syncthreads();
    {
        const int g = wid >> 1;
        const bf16_t* wsb = (const bf16_t*)(p.ws + OFF_W + (size_t)l * W_LAYER + W_GMWS) + (size_t)g * 128 * 128;
        f32x16 acc[4];
#pragma unroll
        for (int tb = 0; tb < 4; ++tb)
#pragma unroll
            for (int i = 0; i < 16; ++i) acc[tb][i] = 0.f;
#pragma unroll 4
        for (int ks = 0; ks < 8; ++ks) {
            const bf16x8 bfr = *(const bf16x8*)(lds + (wid * 32 + fr) * TS + (16 * ks + 8 * fh) * 2);
#pragma unroll
            for (int tb = 0; tb < 4; ++tb) {
                const bf16x8 afr = *(const bf16x8*)(wsb + (size_t)(32 * tb + fr) * 128 + 16 * ks + 8 * fh);
                acc[tb] = __builtin_amdgcn_mfma_f32_32x32x16_bf16(afr, bfr, acc[tb], 0, 0, 0);
            }
        }
        const float* bs = p.in[IN_GMBS] + (l * 4 + g) * 128;
        const int ch = wid * 32 + fr;
        bf16_t* gm = (bf16_t*)(p.ws + OFF_GM);
#pragma unroll
        for (int tb = 0; tb < 4; ++tb)
#pragma unroll
            for (int r = 0; r < 16; ++r) {
                const int t = 32 * tb + (r & 3) + 8 * (r >> 2) + 4 * fh;
                const float u = bf2f(P[(size_t)(row0 + t) * PW + 1792 + ch]);
                gm[(size_t)(row0 + t) * 256 + ch] = f2bf(u * (acc[tb][r] + bs[t]));
            }
    }
    __syncthreads();
}

constexpr int ATT_KS = 144, ATT_VS = 136, ATT_KB = 64 * ATT_KS, ATT_VB = 64 * ATT_VS, ATT_STAGE = 4 * (ATT_KB + ATT_VB);
__device__ __forceinline__ void attn_unit(const Params& p, int b, int kvh, int qrow0, int nkeys, unsigned char* lds) {
    const int tid = threadIdx.x, lane = tid & 63, wid = tid >> 6, fr = lane & 31, fh = lane >> 5;
    const int hq = kvh * 4 + (wid & 3), row = qrow0 + (wid >> 2) * 32 + fr;
    bf16_t* qbuf = (bf16_t*)(p.ws + OFF_Q);
    bf16x8 qf[4];
#pragma unroll
    for (int ks = 0; ks < 4; ++ks) qf[ks] = *(const bf16x8*)(qbuf + (size_t)row * 512 + hq * 64 + 16 * ks + 8 * fh);
    const int lr = tid >> 3, lc = tid & 7;
    const bf16_t* kg = (const bf16_t*)(p.ws + OFF_K) + (size_t)(b * 2 + kvh) * NKEY * 64 + (size_t)lr * 64 + lc * 8;
    const bf16_t* vg = (const bf16_t*)(p.ws + OFF_VT) + (size_t)(b * 2 + kvh) * 64 * NKEY + (size_t)lr * NKEY + lc * 8;
    const int kso = lr * ATT_KS + lc * 16, vso = 4 * ATT_KB + lr * ATT_VS + lc * 16;
    const int nst = nkeys >> 8;
#pragma unroll
    for (int j = 0; j < 4; ++j) {
        const uint4 k0 = *(const uint4*)(kg + (size_t)j * 4096), v0 = *(const uint4*)(vg + (size_t)j * 64);
        *(uint4*)(lds + j * ATT_KB + kso) = k0;
        *(uint2*)(lds + j * ATT_VB + vso) = make_uint2(v0.x, v0.y); *(uint2*)(lds + j * ATT_VB + vso + 8) = make_uint2(v0.z, v0.w);
    }
    __syncthreads();
    f32x16 o[2];
#pragma unroll
    for (int i = 0; i < 16; ++i) { o[0][i] = 0.f; o[1][i] = 0.f; }
    const int koff = fr * ATT_KS + fh * 16, voff = 4 * ATT_KB + fr * ATT_VS + fh * 8;
    float m_used = 0.f, lsum = 0.f;
    f32x16 cinit;
#pragma unroll
    for (int i = 0; i < 16; ++i) cinit[i] = 0.f;
#pragma unroll 1
    for (int st = 0; st < nst; ++st) {
        const unsigned char* sc = lds + (st & 1) * ATT_STAGE;
        unsigned char* sn = lds + ((st & 1) ^ 1) * ATT_STAGE;
        const bool more = (st + 1 < nst);
#pragma unroll
        for (int j = 0; j < 4; ++j) {
            uint4 rk, rv;
            if (more) { rk = *(const uint4*)(kg + (size_t)((st + 1) * 4 + j) * 4096); rv = *(const uint4*)(vg + (size_t)((st + 1) * 4 + j) * 64); }
            f32x16 s[2];
            const unsigned char* cK = sc + j * ATT_KB + koff;
#pragma unroll
            for (int kb = 0; kb < 2; ++kb) s[kb] = __builtin_amdgcn_mfma_f32_32x32x16_bf16(*(const bf16x8*)(cK + kb * 32 * ATT_KS), qf[0], cinit, 0, 0, 0);
#pragma unroll
            for (int ks = 1; ks < 4; ++ks)
#pragma unroll
                for (int kb = 0; kb < 2; ++kb) s[kb] = __builtin_amdgcn_mfma_f32_32x32x16_bf16(*(const bf16x8*)(cK + kb * 32 * ATT_KS + ks * 32), qf[ks], s[kb], 0, 0, 0);
            const bool firstt = (st == 0 && j == 0);
            if (firstt) {
                float mx = fmaxf(fmaxf(s[0][0], s[0][1]), s[0][2]);
#pragma unroll
                for (int i = 3; i < 15; i += 2) mx = fmaxf(fmaxf(mx, s[0][i]), s[0][i + 1]);
                mx = fmaxf(mx, s[0][15]);
#pragma unroll
                for (int i = 0; i < 16; i += 2) mx = fmaxf(fmaxf(mx, s[1][i]), s[1][i + 1]);
                mx = fmaxf(mx, __shfl_xor(mx, 32));
                m_used = mx;
#pragma unroll
                for (int i = 0; i < 16; ++i) { s[0][i] -= mx; s[1][i] -= mx; cinit[i] = -mx; }
            }
            v2f ps2 = {0.f, 0.f};
#pragma unroll
            for (int kb = 0; kb < 2; ++kb)
#pragma unroll
                for (int i = 0; i < 16; i += 2) { const float e0 = __builtin_amdgcn_exp2f(s[kb][i]), e1 = __builtin_amdgcn_exp2f(s[kb][i + 1]); s[kb][i] = e0; s[kb][i + 1] = e1; ps2 += (v2f){e0, e1}; }
            lsum += ps2.x + ps2.y;
            const unsigned char* cV = sc + j * ATT_VB + voff;
#pragma unroll
            for (int kb = 0; kb < 2; ++kb)
#pragma unroll
                for (int sh = 0; sh < 2; ++sh) {
                    const bf16x8 pf = mk8(pack2(s[kb][8 * sh + 0], s[kb][8 * sh + 1]), pack2(s[kb][8 * sh + 2], s[kb][8 * sh + 3]),
                                          pack2(s[kb][8 * sh + 4], s[kb][8 * sh + 5]), pack2(s[kb][8 * sh + 6], s[kb][8 * sh + 7]));
#pragma unroll
                    for (int db = 0; db < 2; ++db) {
                        const unsigned char* vp = cV + db * 32 * ATT_VS + (kb * 32 + sh * 16) * 2;
                        const uint2 v0 = *(const uint2*)vp, v1 = *(const uint2*)(vp + 16);
                        o[db] = __builtin_amdgcn_mfma_f32_32x32x16_bf16(mk8(v0.x, v0.y, v1.x, v1.y), pf, o[db], 0, 0, 0);
                    }
                }
            if (__builtin_amdgcn_ballot_w64(ps2.x + ps2.y > 1.0e18f) != 0ull) {
                const float sc_o = 8.673617379884035e-19f;
                m_used += 60.0f; lsum *= sc_o;
#pragma unroll
                for (int i = 0; i < 16; ++i) { o[0][i] *= sc_o; o[1][i] *= sc_o; cinit[i] = -m_used; }
            }
            if (more) {
                *(uint4*)(sn + j * ATT_KB + kso) = rk;
                *(uint2*)(sn + j * ATT_VB + vso) = make_uint2(rv.x, rv.y); *(uint2*)(sn + j * ATT_VB + vso + 8) = make_uint2(rv.z, rv.w);
            }
        }
        __syncthreads();
    }
    const float inv = 1.0f / (lsum + __shfl_xor(lsum, 32));
    bf16_t* op = qbuf + (size_t)row * 512 + hq * 64;
#pragma unroll
    for (int db = 0; db < 2; ++db)
#pragma unroll
        for (int g = 0; g < 4; ++g)
            *(uint2*)(op + db * 32 + g * 8 + fh * 4) = make_uint2(pack2(o[db][4 * g] * inv, o[db][4 * g + 1] * inv), pack2(o[db][4 * g + 2] * inv, o[db][4 * g + 3] * inv));
}

__device__ __forceinline__ void hyfft_unit(const Params& p, int l, int u, unsigned char* lds) {
    const int bp = u >> 8, c = u & 255, tid = threadIdx.x;
    float2* X = (float2*)lds;
    const float2* tw = (const float2*)(p.ws + OFF_TW);
    bf16_t* zt = (bf16_t*)(p.ws + OFF_ZT);
    bf16_t* z0 = zt + ((size_t)((2 * bp) * 768 + c)) * SEQ;
    bf16_t* z1 = zt + ((size_t)((2 * bp + 1) * 768 + c)) * SEQ;
    const float2* H0 = (const float2*)(p.ws + OFF_HSPEC + (size_t)l * SZ_HSPEC_L) + (size_t)c * NFFT;
    const float2* H1 = H0 + (size_t)256 * NFFT;
    const float sk0 = p.in[IN_HSKIP][l * 512 + c], sk1 = p.in[IN_HSKIP][l * 512 + 256 + c];
    float2 keep[16];
#pragma unroll
    for (int i = 0; i < 16; ++i) {
        const int t = tid + 512 * i;
        const float2 v = make_float2(bf2f(z0[t]), bf2f(z1[t]));
        keep[i] = v; X[XP(t)] = v; X[XP(t + 8192)] = make_float2(0.f, 0.f);
    }
    __syncthreads();
    fft_fwd(X, tw);
#pragma unroll
    for (int hb = 0; hb < 2; ++hb) { float2 h2[16];
#pragma unroll
      for (int i = 0; i < 16; ++i) h2[i] = H0[tid + 512 * (16 * hb + i)];
#pragma unroll
      for (int i = 0; i < 16; ++i) { const int ix = XP(tid + 512 * (16 * hb + i)); const v2f a = ((v2f*)X)[ix], h = {h2[i].x, h2[i].y}; ((v2f*)X)[ix] = pk_cmul(a, h); } }
    __syncthreads();
    fft_inv(X, tw);
#pragma unroll
    for (int i = 0; i < 16; ++i) {
        const int t = tid + 512 * i;
        const float2 cv = X[XP(t)];
        const float g0 = bf2f(z0[(size_t)256 * SEQ + t]), g1 = bf2f(z1[(size_t)256 * SEQ + t]);
        const float2 y = make_float2(g0 * (cv.x + sk0 * keep[i].x), g1 * (cv.y + sk0 * keep[i].y));
        keep[i] = y; X[XP(t)] = y; X[XP(t + 8192)] = make_float2(0.f, 0.f);
    }
    __syncthreads();
    fft_fwd(X, tw);
#pragma unroll
    for (int hb = 0; hb < 2; ++hb) { float2 h2[16];
#pragma unroll
      for (int i = 0; i < 16; ++i) h2[i] = H1[tid + 512 * (16 * hb + i)];
#pragma unroll
      for (int i = 0; i < 16; ++i) { const int ix = XP(tid + 512 * (16 * hb + i)); const v2f a = ((v2f*)X)[ix], h = {h2[i].x, h2[i].y}; ((v2f*)X)[ix] = pk_cmul(a, h); } }
    __syncthreads();
    fft_inv(X, tw);
#pragma unroll
    for (int i = 0; i < 16; ++i) {
        const int t = tid + 512 * i;
        const float2 cv = X[XP(t)];
        const float g0 = bf2f(z0[(size_t)512 * SEQ + t]), g1 = bf2f(z1[(size_t)512 * SEQ + t]);
        z0[t] = f2bf(g0 * (cv.x + sk1 * keep[i].x));
        z1[t] = f2bf(g1 * (cv.y + sk1 * keep[i].y));
    }
    __syncthreads();
}
__device__ __forceinline__ void filtfft_unit(const Params& p, int u, unsigned char* lds) {
    const int l = u >> 9, oc = u & 511, tid = threadIdx.x, lane = tid & 63, wid = tid >> 6;
    float2* X = (float2*)lds;
    float* red = (float*)(lds + 135168 + 64);
    const float* k = (const float*)(p.ws + OFF_P + (size_t)l * SZ_KCIRC_L) + (size_t)oc * NFFT;
    float s = 0.f;
#pragma unroll 4
    for (int i = tid; i < NFFT; i += 512) { const float v = k[i]; X[XP(i)] = make_float2(v, 0.f); s += fabsf(v); }
    s = wave_sum(s);
    if (lane == 0) red[wid] = s;
    __syncthreads();
    const float tot = red[0] + red[1] + red[2] + red[3] + red[4] + red[5] + red[6] + red[7];
    const float sc = 1.0f / (tot * (float)NFFT);
#pragma unroll 4
    for (int i = tid; i < NFFT; i += 512) X[XP(i)].x *= sc;
    __syncthreads();
    fft_fwd(X, (const float2*)(p.ws + OFF_TW));
    float2* H = (float2*)(p.ws + OFF_HSPEC + (size_t)l * SZ_HSPEC_L) + (size_t)oc * NFFT;
#pragma unroll 4
    for (int i = tid; i < NFFT; i += 512) H[i] = X[XP(i)];
    __syncthreads();
}
__device__ __forceinline__ void ctxhy_unit(const Params& p, int l, int u, unsigned char* lds) {
    const int b = u >> 7, tid = threadIdx.x, t = tid & 255, cs = tid >> 8, c = (u & 127) * 2 + cs;
    float* sv = (float*)lds + cs * 256;
    float* sy = (float*)lds + 512 + cs * 256;
    float* k0 = (float*)lds + 1024 + cs * 1024;
    float* k1 = k0 + 512;
    const bf16_t* P = (const bf16_t*)(p.ws + OFF_P);
    const int rowb = ML + b * CTXL;
    const float* cw = p.in[IN_HCW] + l * 3 * 768;
    float z[3];
#pragma unroll
    for (int part = 0; part < 3; ++part) {
        const int ch = part * 256 + c;
        const float pm = (t > 0) ? bf2f(P[(size_t)(rowb + t - 1) * PW + 768 + ch]) : 0.f;
        const float pc = bf2f(P[(size_t)(rowb + t) * PW + 768 + ch]);
        const float pn = (t < CTXL - 1) ? bf2f(P[(size_t)(rowb + t + 1) * PW + 768 + ch]) : 0.f;
        z[part] = pm * cw[ch] + pc * cw[768 + ch] + pn * cw[1536 + ch] + p.in[IN_HCB][l * 768 + ch];
    }
    const float* kn = (const float*)(p.ws + OFF_KCN);
    k0[t] = kn[(size_t)c * 512 + t]; k0[t + 256] = kn[(size_t)c * 512 + t + 256];
    k1[t] = kn[(size_t)(256 + c) * 512 + t]; k1[t + 256] = kn[(size_t)(256 + c) * 512 + t + 256];
    sv[t] = z[0];
    __syncthreads();
    float a = 0.f;
#pragma unroll 8
    for (int s = 0; s < 256; ++s) a += k0[(t - s) & 511] * sv[s];
    const float y1 = z[1] * (a + p.in[IN_HSKIP][l * 512 + c] * z[0]);
    sy[t] = y1;
    __syncthreads();
    a = 0.f;
#pragma unroll 8
    for (int s = 0; s < 256; ++s) a += k1[(t - s) & 511] * sy[s];
    const float y2 = z[2] * (a + p.in[IN_HSKIP][l * 512 + 256 + c] * y1);
    ((bf16_t*)(p.ws + OFF_HY))[(size_t)(rowb + t) * 256 + c] = f2bf(y2);
    __syncthreads();
}
__device__ __forceinline__ void hytr_unit(const Params& p, int u, unsigned char* lds) {
    const int b = u >> 7, t0 = (u & 127) * 64, tid = threadIdx.x;
    constexpr int TS = 144;
    const bf16_t* zt = (const bf16_t*)(p.ws + OFF_ZT);
    for (int i = tid; i < 2048; i += 512) {
        const int ch = i >> 3, cc = i & 7;
        *(uint4*)(lds + ch * TS + cc * 16) = *(const uint4*)(zt + ((size_t)(b * 768 + ch)) * SEQ + t0 + cc * 8);
    }
    __syncthreads();
    {
        const int ch = tid & 255, half = tid >> 8;
        bf16_t* dst = (bf16_t*)(p.ws + OFF_HY) + (size_t)(b * SEQ + t0) * 256 + ch;
        for (int j = 0; j < 32; ++j) { const int tl = half * 32 + j; dst[(size_t)tl * 256] = *(const bf16_t*)(lds + ch * TS + tl * 2); }
    }
    __syncthreads();
}

#ifdef DIAG_NAN
__device__ __forceinline__ void diag_scan(const Params& p, size_t off, size_t nbytes, bool isbf, unsigned code) {
    const uint4* q = (const uint4*)(p.ws + off);
    const size_t n = nbytes / 16;
    bool bad = false;
    for (size_t i = (size_t)blockIdx.x * 512 + threadIdx.x; i < n; i += (size_t)gridDim.x * 512) {
        const uint4 v = q[i];
        const unsigned w[4] = {v.x, v.y, v.z, v.w};
#pragma unroll
        for (int k = 0; k < 4; ++k) {
            if (isbf) { if ((w[k] & 0x7f80u) == 0x7f80u || (w[k] & 0x7f800000u) == 0x7f800000u) bad = true; }
            else { if ((w[k] & 0x7f800000u) == 0x7f800000u) bad = true; }
        }
    }
    if (bad) atomicMin((unsigned*)(p.ws + WS_END), code);
}
__device__ __forceinline__ void diag_scan_out(const Params& p, unsigned code) {
    const uint4* q = (const uint4*)p.out;
    const size_t n = (size_t)ML * 1024 / 4;
    bool bad = false;
    for (size_t i = (size_t)blockIdx.x * 512 + threadIdx.x; i < n; i += (size_t)gridDim.x * 512) {
        const uint4 v = q[i];
        if ((v.x & 0x7f800000u) == 0x7f800000u || (v.y & 0x7f800000u) == 0x7f800000u || (v.z & 0x7f800000u) == 0x7f800000u || (v.w & 0x7f800000u) == 0x7f800000u) bad = true;
    }
    if (bad) atomicMin((unsigned*)(p.ws + WS_END), code);
}
__device__ __forceinline__ void diag_phase(const Params& p, int ph) {
    const int prev = ph - 1;
    if (prev == 0) {
        diag_scan(p, OFF_W, 2 * W_LAYER, true, 0);
        diag_scan(p, OFF_MOD, (size_t)2 * 9 * 6144 * 4 + 16384 + 65536, false, 0);
        diag_scan(p, OFF_P, 2 * SZ_KCIRC_L, false, 0);
        diag_scan(p, OFF_KCR, (size_t)2 * 256 * 512 * 4, false, 0);
    } else if (prev == 1) {
        diag_scan(p, OFF_HSPEC, 2 * SZ_HSPEC_L, false, 1);
        diag_scan(p, OFF_KCN, (size_t)2 * 256 * 512 * 4, false, 1);
        diag_scan(p, OFF_HN, SZ_HN, true, 1);
    } else {
        const int sub = (prev - 2) % 10;
        switch (sub) {
        case 0: diag_scan(p, OFF_P, SZ_P, true, prev); break;
        case 1: diag_scan(p, OFF_Q, SZ_Q + 2 * SZ_K + SZ_ZT + 2 * SZ_B256, true, prev); break;
        case 2: diag_scan(p, OFF_Q, SZ_Q, true, prev); diag_scan(p, OFF_ZT, SZ_ZT, true, prev); diag_scan(p, OFF_HY, SZ_B256, true, prev); break;
        case 3: diag_scan(p, OFF_HY, SZ_B256, true, prev); break;
        case 4: diag_scan(p, OFF_P, SZ_HN, true, prev); break;
        case 5: diag_scan_out(p, prev); break;
        case 6: diag_scan(p, OFF_HN, (size_t)ML * 2048, true, prev); break;
        case 7: diag_scan(p, OFF_P, (size_t)ML * FFH * 2, true, prev); break;
        case 8: diag_scan_out(p, prev); break;
        default: diag_scan(p, OFF_HN, SZ_HN, true, prev); break;
        }
    }
}
#endif

__device__ __forceinline__ void run_phase(const Params& p, int ph, unsigned char* lds) {
    const int G = gridDim.x, bid = blockIdx.x;
#ifdef PROBE_SEL
    if (bid == 0 && threadIdx.x == 0) ((unsigned long long*)(p.ws + WS_END + 64))[ph] = __builtin_amdgcn_s_memrealtime();
#endif
#ifdef DIAG_NAN
    if (ph == 0 && bid == 0 && threadIdx.x == 0) *(unsigned*)(p.ws + WS_END) = 999u;
    if (ph == 0 && bid == 0 && threadIdx.x == 0) { *(unsigned*)(p.ws + WS_END + 4) = 0u; *(unsigned*)(p.ws + WS_END + 8) = 0x7fffffffu; }
    if (ph == 3) {
        const unsigned* q = (const unsigned*)(p.ws + OFF_P);
        const size_t n = SZ_P / 4;
        unsigned cnt = 0, mincol = 0x7fffffffu;
        for (size_t i = (size_t)bid * 512 + threadIdx.x; i < n; i += (size_t)G * 512) {
            const unsigned w = q[i];
            const unsigned col = (unsigned)((i * 2) % PW);
            const unsigned rowi = (unsigned)((i * 2) / PW);
            const bool bad = ((w & 0x7f80u) == 0x7f80u) || ((w & 0x7f800000u) == 0x7f800000u);
            if (bad) { if (col == 0) cnt++; mincol = min(mincol, rowi); }
        }
        if (cnt) { atomicAdd((unsigned*)(p.ws + WS_END + 4), cnt); atomicMin((unsigned*)(p.ws + WS_END + 8), mincol); }
    }
#endif
    if (ph == 0) {
        if (!ONLYC(100) && !ONLYC(102) && !ONLYC(103) && !ONLYC(104) && !ONLYC(105) && !ONLYC(106)) return;
        constexpr int NCVT = 2 * 4224, NMOD = 96, NWEFF = 64, NFILT = 260, NMISC = 16, NHEAVY = NMOD + NWEFF + NFILT + NMISC;
        for (int u = bid; u < NHEAVY + NCVT; u += G) {
            if (u >= NHEAVY) {
                const int uu = u - NHEAVY, l = uu / 4224, t = uu % 4224;
                int j, base;
                if (t < 1600) { j = 0; base = 0; } else if (t < 1728) { j = 1; base = 1600; } else if (t < 1792) { j = 2; base = 1728; } else if (t < 1856) { j = 3; base = 1792; }
                else if (t < 2112) { j = 4; base = 1856; } else if (t < 2816) { j = 5; base = 2112; } else if (t < 3520) { j = 6; base = 2816; } else { j = 7; base = 3520; }
                const CvtJob jb = get_job(p, l, j);
                if (ONLYC(100) || ONLYC(102)) cvt_tile(jb, t - base, lds);
            } else if (u < NFILT) {
                if (!(ONLYC(100) || ONLYC(105))) {} else if (u < 256) filt_task(p, u >> 7, u & 127, SEQ, (float*)(p.ws + OFF_P + (size_t)(u >> 7) * SZ_KCIRC_L), lds);
                else filt_task(p, 0, u - 256, CTXL, (float*)(p.ws + OFF_KCR), lds);
            } else if (u < NFILT + NMOD) { if (ONLYC(100) || ONLYC(103)) mod_task(p, u - NFILT, lds); }
            else if (u < NFILT + NMOD + NWEFF) { if (ONLYC(100) || ONLYC(104)) weff_task(p, u - NFILT - NMOD, lds); }
            else { if (ONLYC(100) || ONLYC(106)) misc_task(p, u - NFILT - NMOD - NWEFF); }
        }
        return;
    }
    if (ph == 1) {
        if (!ONLYC(101)) return;
        for (int u = bid; u < 1024; u += G) filtfft_unit(p, u, lds);
        {
            const int lane = threadIdx.x & 63, wid = threadIdx.x >> 6;
            const float* kr = (const float*)(p.ws + OFF_KCR);
            float* kn = (float*)(p.ws + OFF_KCN);
            for (int oc = bid * 8 + wid; oc < 512; oc += G * 8) {
                float v[8], s = 0.f;
#pragma unroll
                for (int i = 0; i < 8; ++i) { v[i] = kr[(size_t)oc * 512 + lane + 64 * i]; s += fabsf(v[i]); }
                s = 1.0f / wave_sum(s);
#pragma unroll
                for (int i = 0; i < 8; ++i) kn[(size_t)oc * 512 + lane + 64 * i] = v[i] * s;
            }
        }
        modulate_phase(p, 0, 0, MT, p.in[IN_X], p.in[IN_CTX]);
        return;
    }
    const int l = (ph - 2) / 10, sub10 = (ph - 2) % 10, sub13 = (sub10 < 3) ? sub10 : (sub10 < 5) ? sub10 + 1 : sub10 + 3;
    const int half = (sub13 == 6 || sub13 == 7) ? 1 : 0;
    const int sub = (sub13 < 4) ? sub13 : (sub13 == 4 || sub13 == 6) ? 40 : (sub13 == 5 || sub13 == 7) ? 4 : (sub13 - 3);
    const bool first = (l == 0), last = (l == 1);
    unsigned char* wl = p.ws + OFF_W + (size_t)l * W_LAYER;
    const int mtiles = first ? (MT / 256) : (ML / 256);
    const float* mod = (const float*)(p.ws + OFF_MOD) + (size_t)l * 9 * 6144;
    float* xc = (float*)(p.ws + OFF_XC);
    switch (sub) {
    case 0: {
        if (!ONLYC(0) && !(0 == 1 && (ONLYC(10)||ONLYC(11)||ONLYC(12)||ONLYC(13))) && !(0 == 2 && (ONLYC(20)||ONLYC(21)||ONLYC(22)||ONLYC(23)))) break;
        pg8::Gemm g{(const bf16_t*)(p.ws + OFF_HN), (const bf16_t*)(wl + W_WIN), MT, PW, 1024};
        pg8::StaticOrder S; S.init(MT, PW, G, bid);
        pg8::EpiP E{(bf16_t*)(p.ws + OFF_P), PW};
        pg8::gemm_phase<pg8::EpiP, pg8::StaticOrder, true, true>((PG8_LAS unsigned char*)g_lds, g, S, E);
    } break;
    case 1: {
        if (!ONLYC(1) && !(1 == 1 && (ONLYC(10)||ONLYC(11)||ONLYC(12)||ONLYC(13))) && !(1 == 2 && (ONLYC(20)||ONLYC(21)||ONLYC(22)||ONLYC(23)))) break;
        const int NQK = 1056, NHC = 768, NPOOL = first ? 264 : 256, NGM = first ? 528 : 512;
        for (int u = bid; u < NHC; u += G) { if (ONLYC(1) || ONLYC(11)) hyconv_unit(p, l, u, lds); }
        for (int u = (bid + 64) % G; u < NQK; u += G) { if (ONLYC(1) || ONLYC(10)) qk_unit(p, l, u, lds); }
        for (int u = (bid + 128) % G; u < NGM; u += G) { if (ONLYC(1) || ONLYC(13)) gmlp_unit(p, l, u, lds); }
        for (int u = (bid + 192) % G; u < NPOOL; u += G) { if (ONLYC(1) || ONLYC(12)) pool_unit(p, u, lds); }
    } break;
    case 2: {
        if (!ONLYC(2) && !(2 == 1 && (ONLYC(10)||ONLYC(11)||ONLYC(12)||ONLYC(13))) && !(2 == 2 && (ONLYC(20)||ONLYC(21)||ONLYC(22)||ONLYC(23)))) break;
        const int NF = 1024, NA = 2048, NCA = first ? 64 : 0, NCH = first ? 1024 : 0;
#ifdef PROBE_SEL
#define MIXTS(k) if (bid == 0 && threadIdx.x == 0) ((unsigned long long*)(p.ws + WS_END + 1024))[l * 4 + (k)] = __builtin_amdgcn_s_memrealtime();
#else
#define MIXTS(k)
#endif
        MIXTS(0)
        for (int u = bid; u < NF; u += G) { if (ONLYC(2) || ONLYC(20)) hyfft_unit(p, l, u, lds); }
        MIXTS(1)
        for (int u = bid; u < NA + NCA; u += G) {
            int ab, akvh, arow, ank;
            if (u < NA) { ab = u >> 8; akvh = u & 1; arow = (u >> 8) * SEQ + ((u >> 1) & 127) * 64; ank = NKEY; }
            else { const int a = u - NA; ab = a >> 3; akvh = (a >> 2) & 1; arow = ML + (a >> 3) * CTXL + (a & 3) * 64; ank = CTXL; }
            if (ONLYC(2) || ONLYC(21) || ONLYC(22)) attn_unit(p, ab, akvh, arow, ank, lds);
        }
        MIXTS(2)
        for (int u = bid; u < NCH; u += G) { if (ONLYC(2) || ONLYC(23)) ctxhy_unit(p, l, u, lds); }
        MIXTS(3)
    } break;
    case 3: {
        if (!ONLYC(3) && !(3 == 1 && (ONLYC(10)||ONLYC(11)||ONLYC(12)||ONLYC(13))) && !(3 == 2 && (ONLYC(20)||ONLYC(21)||ONLYC(22)||ONLYC(23)))) break;
        for (int u = bid; u < 1024; u += G) hytr_unit(p, u, lds);
    } break;
    case 40: {
        if (!ONLYC(40)) break;
        if (half == 0) { for (int u = bid; u < 1024; u += G) hytr_unit(p, u, lds); }
        const int rowbase = 0, Mh = first ? MT : ML;
        pg8::Gemm g{(const bf16_t*)(p.ws + OFF_HN) + (size_t)rowbase * 1024, (const bf16_t*)(wl + W_WIN) + (size_t)PW * 1024, Mh, 4096, 1024};
        pg8::StaticOrder S; S.init(Mh, 4096, G, bid);
        pg8::EpiSig E{p.ws + OFF_P, 4096};
        pg8::gemm_phase<pg8::EpiSig, pg8::StaticOrder, true, true>((PG8_LAS unsigned char*)g_lds, g, S, E);
    } break;
    case 4: {
        if (!ONLYC(4)) break;
        const int rowbase = 0, Mh = first ? MT : ML;
        const unsigned char* Gb = p.ws + OFF_P;
        bf16_t* mg = (bf16_t*)(p.ws + OFF_MG);
        const int mtiles_h = Mh / 256;
        const int total = ((mtiles_h + 31) / 32) * 256;
        for (int u = bid; u < total; u += G) {
            const int rr = u >> 8, w = u & 255, mt = rr * 32 + (w & 7) * 4 + (w >> 6), nt = (w >> 3) & 7;
            if (mt >= mtiles_h) continue;
            f32x16 msum[2][2]; zero_acc(msum);
            const int lane = threadIdx.x & 63, wid = threadIdx.x >> 6, wm = wid >> 1, wn = wid & 1, fr = lane & 31, fh = lane >> 5;
#pragma unroll 1
            for (int br = 0; br < 4; ++br) {
                const bf16_t* Ab = (const bf16_t*)(p.ws + (br == 0 ? OFF_Q : br == 1 ? OFF_HY : br == 2 ? OFF_PD : OFF_GM));
                const bf16_t* Wb = (const bf16_t*)(wl + (br == 0 ? W_BA : br == 1 ? W_BH : br == 2 ? W_BP : W_BG));
                const int Kb = (br == 0) ? 512 : 256;
                unsigned gq[2][2][4];
#pragma unroll
                for (int mb = 0; mb < 1; ++mb)
#pragma unroll
                    for (int nb = 0; nb < 2; ++nb)
#pragma unroll
                        for (int g4 = 0; g4 < 4; ++g4) {
                            const int rowl = mt * 256 + wm * 64 + mb * 32 + fr, col = nt * 128 + wn * 64 + nb * 32 + g4 * 8 + fh * 4;
                            gq[mb][nb][g4] = *(const unsigned*)(Gb + (size_t)rowl * 4096 + br * 1024 + col);
                        }
                f32x16 v[2][2]; zero_acc(v);
                gemm_mainloop(v, Ab + (size_t)(rowbase + mt * 256) * Kb, Kb, Wb + (size_t)nt * 128 * Kb, Kb, Kb, lds);
#pragma unroll
                for (int nb = 0; nb < 2; ++nb)
#pragma unroll
                    for (int g4 = 0; g4 < 4; ++g4) {
                        const int rowl = mt * 256 + wm * 64 + 32 + fr, col = nt * 128 + wn * 64 + nb * 32 + g4 * 8 + fh * 4;
                        gq[1][nb][g4] = *(const unsigned*)(Gb + (size_t)rowl * 4096 + br * 1024 + col);
                    }
#pragma unroll
                for (int mb = 0; mb < 2; ++mb)
#pragma unroll
                    for (int nb = 0; nb < 2; ++nb)
#pragma unroll
                        for (int g4 = 0; g4 < 4; ++g4) {
                            const unsigned gg = gq[mb][nb][g4];
                            constexpr float QS = 1.0f / 255.0f;
                            msum[nb][mb][4 * g4 + 0] += ((float)(gg & 0xffu) * QS) * v[nb][mb][4 * g4 + 0]; msum[nb][mb][4 * g4 + 1] += ((float)((gg >> 8) & 0xffu) * QS) * v[nb][mb][4 * g4 + 1];
                            msum[nb][mb][4 * g4 + 2] += ((float)((gg >> 16) & 0xffu) * QS) * v[nb][mb][4 * g4 + 2]; msum[nb][mb][4 * g4 + 3] += ((float)(gg >> 24) * QS) * v[nb][mb][4 * g4 + 3];
                        }
            }
#pragma unroll
            for (int mb = 0; mb < 2; ++mb)
#pragma unroll
                for (int nb = 0; nb < 2; ++nb)
#pragma unroll
                    for (int g4 = 0; g4 < 4; ++g4) {
                        const int row = rowbase + mt * 256 + wm * 64 + mb * 32 + fr, col = nt * 128 + wn * 64 + nb * 32 + g4 * 8 + fh * 4;
                        *(uint2*)(mg + (size_t)row * 1024 + col) = make_uint2(pack2(msum[nb][mb][4 * g4], msum[nb][mb][4 * g4 + 1]), pack2(msum[nb][mb][4 * g4 + 2], msum[nb][mb][4 * g4 + 3]));
                    }
        }
    } break;
    case 5: case 8: {
        if (!ONLYC(5)) break;
        const bool isout = (sub == 5);
        const int Mrows = first ? MT : ML, K = isout ? 1024 : FFH;
        pg8::Gemm g{(const bf16_t*)(p.ws + (isout ? OFF_MG : OFF_P)), (const bf16_t*)(wl + (isout ? W_OUT : W_DN)), Mrows, 1024, K};
        pg8::StaticOrder S; S.init(Mrows, 1024, G, bid);
        pg8::EpiRes E{(isout && first) ? p.in[IN_X] : p.out, (isout && first) ? p.in[IN_CTX] : xc, p.out, xc, mod + (isout ? 2048 : 5120), ML};
        pg8::gemm_phase<pg8::EpiRes, pg8::StaticOrder, true, true>((PG8_LAS unsigned char*)g_lds, g, S, E);
    } break;
    case 6: if (!ONLYC(6)) break; modulate_phase(p, l, 1, first ? MT : ML, p.out, xc); break;
    case 7: {
        if (!ONLYC(7) && !(7 == 1 && (ONLYC(10)||ONLYC(11)||ONLYC(12)||ONLYC(13))) && !(7 == 2 && (ONLYC(20)||ONLYC(21)||ONLYC(22)||ONLYC(23)))) break;
        const int Mrows = first ? MT : ML;
        pg8::Gemm g{(const bf16_t*)(p.ws + OFF_HN), (const bf16_t*)(wl + W_GU), Mrows, 2 * FFH, 1024};
        pg8::StaticOrder S; S.init(Mrows, 2 * FFH, G, bid);
        pg8::EpiSwi E{(bf16_t*)(p.ws + OFF_P), FFH};
        pg8::gemm_phase<pg8::EpiSwi, pg8::StaticOrder, true, true>((PG8_LAS unsigned char*)g_lds, g, S, E);
    } break;
    case 9: {
        if (!ONLYC(9) && !(9 == 1 && (ONLYC(10)||ONLYC(11)||ONLYC(12)||ONLYC(13))) && !(9 == 2 && (ONLYC(20)||ONLYC(21)||ONLYC(22)||ONLYC(23)))) break;
        if (last) final_norm_phase(p);
        else modulate_phase(p, l + 1, 0, MT, p.out, xc);
    } break;
    }
}

__device__ __forceinline__ unsigned xcc_id() { return (unsigned)__builtin_amdgcn_s_getreg((3 << 11) | 20) & 0x7u; }
__device__ __forceinline__ void seam_barrier(unsigned* words  , unsigned x, unsigned nx, unsigned nact) {
    __syncthreads();
    if (threadIdx.x == 0) {
        __builtin_amdgcn_fence(__ATOMIC_RELEASE, "agent");
        const unsigned old = __hip_atomic_fetch_add(words + 32 * x, 1u, __ATOMIC_RELAXED, __HIP_MEMORY_SCOPE_AGENT);
        if (old + 1u == nx) __hip_atomic_fetch_add(words + 256, 1u, __ATOMIC_RELAXED, __HIP_MEMORY_SCOPE_AGENT);
        while (__hip_atomic_load(words + 256, __ATOMIC_RELAXED, __HIP_MEMORY_SCOPE_AGENT) < nact) __builtin_amdgcn_s_sleep(1);
        __builtin_amdgcn_fence(__ATOMIC_ACQUIRE, "agent");
    }
    __syncthreads();
}
__global__ void __launch_bounds__(512) mk_forward(Params p) {
    unsigned* const barw = (unsigned*)(p.ws + OFF_BAR);
    const unsigned xcc = (unsigned)__builtin_amdgcn_readfirstlane((int)xcc_id());
    unsigned nx = 0u, nact = 0u;
    if (p.ph_hi - p.ph_lo > 1 && threadIdx.x == 0) __hip_atomic_fetch_add(barw + 32 * xcc, 1u, __ATOMIC_RELAXED, __HIP_MEMORY_SCOPE_AGENT);
#define MK_PHASE(k) if (p.ph_lo <= (k) && (k) < p.ph_hi) { if ((k) > p.ph_lo) { \
        if ((k) == 1) { cg::this_grid().sync(); \
            for (unsigned q = 0; q < 8u; ++q) { const unsigned cq = __hip_atomic_load(barw + 32 * q, __ATOMIC_RELAXED, __HIP_MEMORY_SCOPE_AGENT); nact += (cq != 0u); if (q == xcc) nx = cq; } \
            nx = (unsigned)__builtin_amdgcn_readfirstlane((int)nx); nact = (unsigned)__builtin_amdgcn_readfirstlane((int)nact); } \
        else seam_barrier(barw + 512 * (k), xcc, nx, nact); } run_phase(p, (k), g_lds); }
    MK_PHASE(0) MK_PHASE(1)
    MK_PHASE(2) MK_PHASE(3) MK_PHASE(4) MK_PHASE(5) MK_PHASE(6) MK_PHASE(7) MK_PHASE(8) MK_PHASE(9) MK_PHASE(10) MK_PHASE(11) MK_PHASE(12) MK_PHASE(13) MK_PHASE(14)
    MK_PHASE(15) MK_PHASE(16) MK_PHASE(17) MK_PHASE(18) MK_PHASE(19) MK_PHASE(20) MK_PHASE(21)
#undef MK_PHASE
}

extern "C" void kernel_launch(void* const* d_in, const int* in_sizes, int n_in, void* d_out, int out_size, void* d_ws, size_t ws_size, hipStream_t stream) {
    static int grid = 0;
    if (grid == 0) {
        if (n_in != N_IN || out_size != ML * D || ws_size < WS_END2) { fprintf(stderr, "kernel_launch: unexpected shapes (n_in %d out %d ws %zu need %zu)\n", n_in, out_size, ws_size, (size_t)WS_END); grid = -1; return; }
        int dev = 0, cus = 0, per_cu = 0;
        hipGetDevice(&dev);
        hipDeviceGetAttribute(&cus, hipDeviceAttributeMultiprocessorCount, dev);
        if (hipFuncSetAttribute((const void*)mk_forward, hipFuncAttributeMaxDynamicSharedMemorySize, LDS_BYTES) != hipSuccess) { fprintf(stderr, "kernel_launch: hipFuncSetAttribute failed\n"); grid = -1; return; }
        if (hipOccupancyMaxActiveBlocksPerMultiprocessor(&per_cu, (const void*)mk_forward, 512, LDS_BYTES) != hipSuccess || per_cu < 1) { fprintf(stderr, "kernel_launch: occupancy query says %d\n", per_cu); per_cu = 1; }
        (void)hipGetLastError();
        grid = cus * 1;
    }
    if (grid < 0) return;
    Params p{};
    for (int i = 0; i < N_IN; ++i) p.in[i] = (const float*)d_in[i];
    p.out = (float*)d_out; p.ws = (unsigned char*)d_ws;
#if MK_MULTI_LAUNCH
    for (int ph = 0; ph < NPHASE; ++ph) {
        p.ph_lo = ph; p.ph_hi = ph + 1;
        hipLaunchKernelGGL(mk_forward, dim3(grid), dim3(512), LDS_BYTES, stream, p);
    }
#else
    p.ph_lo = 0; p.ph_hi = NPHASE;
    if (hipMemsetAsync((char*)d_ws + OFF_BAR, 0, 65536, stream) != hipSuccess) { fprintf(stderr, "kernel_launch: memset of the barrier words failed\n"); return; }
    void* args[] = {&p};
    hipError_t e = hipLaunchCooperativeKernel((const void*)mk_forward, dim3(grid), dim3(512), args, LDS_BYTES, stream);
    if (e != hipSuccess) fprintf(stderr, "cooperative launch failed: %s (grid %d)\n", hipGetErrorString(e), grid);
#endif
}
```

```cpp
#include <hip/hip_runtime.h>
#include <hip/hip_cooperative_groups.h>
#include <cstdio>
#include <cstdint>
#include <cmath>
namespace cg = cooperative_groups;

#ifndef MK_MULTI_LAUNCH
#define MK_MULTI_LAUNCH 0
#endif

#ifndef ONLY
#define ONLYC(k) true
#else
#define ONLYC(k) ((k)==ONLY)
#endif
typedef unsigned short bf16_t;
typedef short bf16x8 __attribute__((ext_vector_type(8)));
typedef float f32x16 __attribute__((ext_vector_type(16)));

constexpr int D = 1024, NB = 8, SEQ = 8192, CTXL = 256;
constexpr int ML = NB * SEQ, MC = NB * CTXL, MT = ML + MC;
constexpr int PW = 2304;
constexpr int INW = 6400, FFH = 2816, NKEY = CTXL + SEQ;
constexpr int NFFT = 16384;
constexpr float QSCALE = 0.125f * 1.4426950408889634f;

enum { IN_X, IN_C, IN_CTX, IN_CCTX, IN_WMOD, IN_BMOD, IN_N1W, IN_N2W, IN_WIN, IN_QNW, IN_KNW, IN_HCW, IN_HCB, IN_HW1, IN_HB1, IN_HW2, IN_HB2,
       IN_HW3, IN_HFREQ, IN_HDECAY, IN_HSKIP, IN_POOLW, IN_POOLS, IN_GMNW, IN_GMWS, IN_GMBS, IN_WBA, IN_WBH, IN_WBP, IN_WBG, IN_WOUT, IN_FG, IN_FU, IN_FD, IN_FNW, N_IN };

constexpr size_t SZ_HN = (size_t)MT * 1024 * 2;
constexpr size_t SZ_P = (size_t)MT * PW * 2;
constexpr size_t SZ_Q = (size_t)MT * 512 * 2;
constexpr size_t SZ_K = (size_t)16 * NKEY * 64 * 2;
constexpr size_t SZ_ZT = (size_t)NB * 768 * SEQ * 2;
constexpr size_t SZ_B256 = (size_t)MT * 256 * 2;
constexpr size_t W_WIN = 0, W_BA = W_WIN + (size_t)6400 * 1024 * 2, W_BH = W_BA + (size_t)1024 * 512 * 2, W_BP = W_BH + (size_t)1024 * 256 * 2,
                 W_BG = W_BP + (size_t)1024 * 256 * 2, W_OUT = W_BG + (size_t)1024 * 256 * 2, W_GU = W_OUT + (size_t)1024 * 1024 * 2,
                 W_DN = W_GU + (size_t)5632 * 1024 * 2, W_GMWS = W_DN + (size_t)1024 * 2816 * 2, W_LAYER = W_GMWS + (size_t)4 * 128 * 128 * 2;
constexpr size_t OFF_HN = 0;
constexpr size_t OFF_P = OFF_HN + SZ_HN;
constexpr size_t OFF_Q = OFF_P + SZ_P;
constexpr size_t OFF_PD = OFF_Q + SZ_Q;
constexpr size_t OFF_GM = OFF_PD + SZ_B256;
constexpr size_t OFF_HY = OFF_GM + SZ_B256;
constexpr size_t OFF_W = OFF_HY + SZ_B256;
constexpr size_t OFF_HSPEC = OFF_W + 2 * W_LAYER;
constexpr size_t SZ_HSPEC_L = (size_t)2 * 256 * NFFT * 8;
constexpr size_t OFF_XC = OFF_HSPEC + 2 * SZ_HSPEC_L;
constexpr size_t OFF_MOD = OFF_XC + (size_t)MC * 1024 * 4;
constexpr size_t OFF_ROPE = OFF_MOD + (size_t)2 * 9 * 6144 * 4;
constexpr size_t OFF_TW = OFF_ROPE + (size_t)128 * 16 * 2 * 4;
constexpr size_t OFF_KCR = OFF_TW + (size_t)8192 * 8;
constexpr size_t OFF_KCN = OFF_KCR + (size_t)2 * 256 * 512 * 4;
constexpr size_t OFF_K = OFF_KCN + (size_t)2 * 256 * 512 * 4;
constexpr size_t OFF_VT = OFF_K + SZ_K;
constexpr size_t OFF_ZT = OFF_VT + SZ_K;
constexpr size_t OFF_MG = OFF_K;
constexpr size_t WS_END = OFF_K + ((2 * SZ_K + SZ_ZT) > SZ_HN ? (2 * SZ_K + SZ_ZT) : SZ_HN);
static_assert((size_t)MT * 4096 <= SZ_P, "the 8-bit gate buffer lives in the P region");
constexpr size_t SZ_KCIRC_L = (size_t)2 * 256 * NFFT * 4;
static_assert((size_t)MT * FFH * 2 == SZ_P + SZ_Q, "hid spans P+Q");
static_assert(WS_END <= ((size_t)1 << 30), "workspace over 1 GiB");

constexpr size_t OFF_BAR = (WS_END + 4095) & ~(size_t)4095;
constexpr size_t WS_END2 = OFF_BAR + 65536;
static_assert(WS_END2 <= ((size_t)1 << 30), "workspace over 1 GiB");
constexpr int LDS_BYTES = 147456;
constexpr int NPHASE = 22;

struct Params {
    const float* in[N_IN];
    float* out;
    unsigned char* ws;
    int ph_lo, ph_hi;
};

__device__ __forceinline__ float bf2f(bf16_t b) { return __uint_as_float(((unsigned)b) << 16); }
typedef float f32x2_t __attribute__((ext_vector_type(2)));
typedef __bf16 bf16x2_t __attribute__((ext_vector_type(2)));
__device__ __forceinline__ unsigned pack2(float lo, float hi) { const f32x2_t v = {lo, hi}; const bf16x2_t b = __builtin_convertvector(v, bf16x2_t); return __builtin_bit_cast(unsigned, b); }
__device__ __forceinline__ bf16_t f2bf(float f) { return (bf16_t)(pack2(f, 0.f) & 0xffffu); }
__device__ __forceinline__ float lo_bf(unsigned u) { return __uint_as_float(u << 16); }
__device__ __forceinline__ float hi_bf(unsigned u) { return __uint_as_float(u & 0xffff0000u); }
__device__ __forceinline__ float sigmoidf_(float x) { return 1.0f / (1.0f + __expf(-x)); }
__device__ __forceinline__ float wave_sum(float v) {
    v += __shfl_xor(v, 32); v += __shfl_xor(v, 16); v += __shfl_xor(v, 8); v += __shfl_xor(v, 4); v += __shfl_xor(v, 2); v += __shfl_xor(v, 1); return v;
}
__device__ __forceinline__ bf16x8 mk8(unsigned a, unsigned b, unsigned c, unsigned d) {
    typedef unsigned u32x4 __attribute__((ext_vector_type(4)));
    u32x4 v = {a, b, c, d};
    return __builtin_bit_cast(bf16x8, v);
}

constexpr int LROW = 144;
constexpr int A_BUF = 256 * LROW, B_BUF = 128 * LROW;
template <int NBK>
__device__ __forceinline__ void gemm_mainloop_t(f32x16 (&acc)[NBK][2], const bf16_t* __restrict__ A, int lda, const bf16_t* __restrict__ Bt, int ldb, int K, unsigned char* lds) {
    const int tid = threadIdx.x, lane = tid & 63, wid = tid >> 6, wm = wid >> 1, wn = wid & 1;
    const int lrow = tid >> 3, lkc = tid & 7;
    asm volatile("" : "+s"(lda), "+s"(ldb));
    const bf16_t* ga = A + (size_t)lrow * lda + lkc * 8;
    const bf16_t* gb = Bt + (size_t)lrow * ldb + lkc * 8;
    uint4 p0a0, p0a1, p0a2, p0a3, p0b0, p0b1 = make_uint4(0, 0, 0, 0), p1a0, p1a1, p1a2, p1a3, p1b0, p1b1 = make_uint4(0, 0, 0, 0);
#define GM_LOAD(S, DUMMY, KT) do { const bf16_t* pa = ga + (size_t)(KT) * 64; const bf16_t* pb = gb + (size_t)(KT) * 64; \
        S##a0 = *(const uint4*)(pa); S##a1 = *(const uint4*)(pa + (size_t)64 * lda); S##a2 = *(const uint4*)(pa + (size_t)128 * lda); S##a3 = *(const uint4*)(pa + (size_t)192 * lda); \
        S##b0 = *(const uint4*)(pb); if constexpr (NBK == 2) S##b1 = *(const uint4*)(pb + (size_t)64 * ldb); } while (0)
#define GM_STORE(S, DUMMY, BUF) do { unsigned char* qa = sA + (BUF) * A_BUF + soff; unsigned char* qb = sB + (BUF) * B_BUF + soff; \
        *(uint4*)(qa) = S##a0; *(uint4*)(qa + 64 * LROW) = S##a1; *(uint4*)(qa + 128 * LROW) = S##a2; *(uint4*)(qa + 192 * LROW) = S##a3; \
        *(uint4*)(qb) = S##b0; if constexpr (NBK == 2) *(uint4*)(qb + 64 * LROW) = S##b1; } while (0)
#define GM_COMPUTE(BUF) do { const unsigned char* cA = sA + (BUF) * A_BUF + aoff; const unsigned char* cB = sB + (BUF) * B_BUF + boff; \
        _Pragma("unroll") for (int ks = 0; ks < 4; ++ks) { \
            const bf16x8 a0 = *(const bf16x8*)(cA + ks * 32), a1 = *(const bf16x8*)(cA + 32 * LROW + ks * 32); \
            const bf16x8 b0 = *(const bf16x8*)(cB + ks * 32); \
            acc[0][0] = __builtin_amdgcn_mfma_f32_32x32x16_bf16(b0, a0, acc[0][0], 0, 0, 0); \
            acc[0][1] = __builtin_amdgcn_mfma_f32_32x32x16_bf16(b0, a1, acc[0][1], 0, 0, 0); \
            if constexpr (NBK == 2) { const bf16x8 b1 = *(const bf16x8*)(cB + 32 * LROW + ks * 32); \
                acc[NBK - 1][0] = __builtin_amdgcn_mfma_f32_32x32x16_bf16(b1, a0, acc[NBK - 1][0], 0, 0, 0); \
                acc[NBK - 1][1] = __builtin_amdgcn_mfma_f32_32x32x16_bf16(b1, a1, acc[NBK - 1][1], 0, 0, 0); } } } while (0)
    unsigned char* sA = lds;
    unsigned char* sB = lds + 2 * A_BUF;
    const int soff = lrow * LROW + lkc * 16;
    const int fr = lane & 31, fh = lane >> 5;
    const int aoff = (wm * 64 + fr) * LROW + fh * 16;
    const int boff = (wn * 32 * NBK + fr) * LROW + fh * 16;
    const int nk = K >> 6;
    GM_LOAD(p0, 0, 0);
    GM_LOAD(p1, 0, 1);
    GM_STORE(p0, 0, 0);
    __syncthreads();
    for (int kt = 0; kt < nk; kt += 2) {
        GM_LOAD(p0, 0, min(kt + 2, nk - 1));
        GM_COMPUTE(0);
        GM_STORE(p1, 0, 1);
        __syncthreads();
        GM_LOAD(p1, 0, min(kt + 3, nk - 1));
        GM_COMPUTE(1);
        GM_STORE(p0, 0, 0);
        __syncthreads();
    }
#undef GM_LOAD
#undef GM_STORE
#undef GM_COMPUTE
}
__device__ __forceinline__ void gemm_mainloop(f32x16 (&acc)[2][2], const bf16_t* __restrict__ A, int lda, const bf16_t* __restrict__ Bt, int ldb, int K, unsigned char* lds) {
    gemm_mainloop_t<2>(acc, A, lda, Bt, ldb, K, lds);
}
__device__ __forceinline__ void zero_acc1(f32x16 (&acc)[1][2]) {
#pragma unroll
    for (int b = 0; b < 2; ++b)
#pragma unroll
        for (int i = 0; i < 16; ++i) acc[0][b][i] = 0.f;
}
__device__ __forceinline__ void zero_acc(f32x16 (&acc)[2][2]) {
#pragma unroll
    for (int a = 0; a < 2; ++a)
#pragma unroll
        for (int b = 0; b < 2; ++b)
#pragma unroll
            for (int i = 0; i < 16; ++i) acc[a][b][i] = 0.f;
}
template <class F> __device__ __forceinline__ void epi_foreach(const f32x16 (&acc)[2][2], F f) {
    const int lane = threadIdx.x & 63, wid = threadIdx.x >> 6, wm = wid >> 1, wn = wid & 1, fr = lane & 31, fh = lane >> 5;
#pragma unroll
    for (int mb = 0; mb < 2; ++mb)
#pragma unroll
        for (int nb = 0; nb < 2; ++nb)
#pragma unroll
            for (int g = 0; g < 4; ++g)
                f(wm * 64 + mb * 32 + fr, wn * 64 + nb * 32 + g * 8 + fh * 4, acc[nb][mb][4 * g], acc[nb][mb][4 * g + 1], acc[nb][mb][4 * g + 2], acc[nb][mb][4 * g + 3]);
}

extern __shared__ __attribute__((aligned(16))) unsigned char g_lds[];
namespace pg8 {
#define PG8_LAS __attribute__((address_space(3)))
typedef unsigned short bf16_t;
typedef short bf16x8 __attribute__((ext_vector_type(8)));
typedef float f32x4 __attribute__((ext_vector_type(4)));
typedef unsigned u32x4 __attribute__((ext_vector_type(4)));
constexpr int BM = 256, BK = 64, HALF = 128, HTB = HALF * BK * 2  , STAGE_BYTES = 8 * HTB, NXCD = 8, WGM = 8;

__host__ __device__ __forceinline__ int lds_byte(int r, int c) { const int st = (r >> 4) * 2 + (c >> 5), rr = r & 15, cc = c & 31, ob = rr * 64 + cc * 2; return st * 1024 + (ob ^ (((ob >> 9) & 1) << 5)); }
__host__ __device__ __forceinline__ void stage_rc(int b, int& R, int& C) { const int st = b / 1024, sb = b % 1024, swz = sb ^ (((sb >> 9) & 1) << 5); R = (st >> 1) * 16 + swz / 64; C = (st & 1) * 32 + (swz % 64) / 2; }
__host__ __device__ __forceinline__ int perm32(int rho) { const int n = rho >> 4, i = rho & 15; return 8 * (i >> 2) + 4 * n + (i & 3); }

struct Unit { int pm, pn; };
struct Gemm { const bf16_t* A; const bf16_t* Bt; int M, N, K; };

struct StaticOrder {
    int nM, nN, nwg, G, c;
    __host__ __device__ void init(int M, int N, int G_, int c_) { nM = M / BM; nN = N / BM; nwg = nM * nN; G = G_; c = c_; }
    __host__ __device__ bool next(int i, Unit& u) const {
        const long L = (long)i * G + c; if (L >= nwg) return false;
        int wgid = (int)L; { const int q = nwg / NXCD, r = nwg % NXCD, xcd = wgid % NXCD, off = wgid / NXCD; wgid = (xcd < r ? xcd * (q + 1) : r * (q + 1) + (xcd - r) * q) + off; }
        const int nig = WGM * nN, gid = wgid / nig, fm = gid * WGM, gsz = (nM - fm) < WGM ? (nM - fm) : WGM;
        u.pm = fm + ((wgid % nig) % gsz); u.pn = (wgid % nig) / gsz; return true;
    }
    __device__ __forceinline__ void a_ready(const Unit&) const {}
    __device__ __forceinline__ void done(const Unit&) const {}
};

struct EpiP {
    static constexpr bool PERM = false, AFTER_DRAIN = false;
    bf16_t* O; int ldc;
    __device__ __forceinline__ void operator()(const f32x4 (&acc)[2][2][4][2], const Unit& u, int wr, int wc, int fr, int fq) const {
        const int row0 = u.pm * BM + wr * 64 + fr, col0 = u.pn * BM + wc * 32 + 4 * fq;
#pragma unroll
        for (int ai = 0; ai < 2; ++ai)
#pragma unroll
            for (int m = 0; m < 4; ++m) { bf16_t* rowp = O + (size_t)(row0 + ai * HALF + m * 16) * ldc + col0;
#pragma unroll
                for (int bj = 0; bj < 2; ++bj)
#pragma unroll
                    for (int n = 0; n < 2; ++n) { const f32x4 v = acc[ai][bj][m][n]; *(uint2*)(rowp + bj * HALF + n * 16) = make_uint2(pack2(v[0], v[1]), pack2(v[2], v[3])); } }
    }
};
struct EpiSig {
    static constexpr bool PERM = false, AFTER_DRAIN = false;
    unsigned char* O; int ldc;
    __device__ __forceinline__ void operator()(const f32x4 (&acc)[2][2][4][2], const Unit& u, int wr, int wc, int fr, int fq) const {
        const int row0 = u.pm * BM + wr * 64 + fr, col0 = u.pn * BM + wc * 32 + 4 * fq;
#pragma unroll
        for (int ai = 0; ai < 2; ++ai)
#pragma unroll
            for (int m = 0; m < 4; ++m) { unsigned char* rowp = O + (size_t)(row0 + ai * HALF + m * 16) * ldc + col0;
#pragma unroll
                for (int bj = 0; bj < 2; ++bj)
#pragma unroll
                    for (int n = 0; n < 2; ++n) { const f32x4 v = acc[ai][bj][m][n];
                        const unsigned q0 = (unsigned)(255.0f * __builtin_amdgcn_rcpf(1.0f + __expf(-v[0])) + 0.5f), q1 = (unsigned)(255.0f * __builtin_amdgcn_rcpf(1.0f + __expf(-v[1])) + 0.5f);
                        const unsigned q2 = (unsigned)(255.0f * __builtin_amdgcn_rcpf(1.0f + __expf(-v[2])) + 0.5f), q3 = (unsigned)(255.0f * __builtin_amdgcn_rcpf(1.0f + __expf(-v[3])) + 0.5f);
                        *(unsigned*)(rowp + bj * HALF + n * 16) = q0 | (q1 << 8) | (q2 << 16) | (q3 << 24); } }
    }
};
struct EpiRes {
    static constexpr bool PERM = false, AFTER_DRAIN = false;
    const float* rlat; const float* rctx; float* olat; float* octx; const float* modg; int nlat;
    __device__ __forceinline__ void operator()(const f32x4 (&acc)[2][2][4][2], const Unit& u, int wr, int wc, int fr, int fq) const {
        const int row0 = u.pm * BM + wr * 64 + fr, col0 = u.pn * BM + wc * 32 + 4 * fq;
#pragma unroll
        for (int ai = 0; ai < 2; ++ai)
#pragma unroll
            for (int m = 0; m < 4; ++m) {
                const int row = row0 + ai * HALF + m * 16;
                const float* src; float* dst; int mr;
                if (row < nlat) { src = rlat + (size_t)row * 1024; dst = olat + (size_t)row * 1024; mr = row >> 13; }
                else { src = rctx + (size_t)(row - nlat) * 1024; dst = octx + (size_t)(row - nlat) * 1024; mr = 8; }
                const float* gp = modg + mr * 6144;
#pragma unroll
                for (int bj = 0; bj < 2; ++bj)
#pragma unroll
                    for (int n = 0; n < 2; ++n) { const int c = col0 + bj * HALF + n * 16; const f32x4 r = *(const f32x4*)(src + c), g = *(const f32x4*)(gp + c); *(f32x4*)(dst + c) = r + g * acc[ai][bj][m][n]; }
            }
    }
};
struct EpiSwi {
    static constexpr bool PERM = false, AFTER_DRAIN = false;
    bf16_t* H; int ldh;
    __device__ __forceinline__ void operator()(const f32x4 (&acc)[2][2][4][2], const Unit& u, int wr, int wc, int fr, int fq) const {
        const int row0 = u.pm * BM + wr * 64 + fr, col0 = u.pn * BM + wc * 32;
#pragma unroll
        for (int ai = 0; ai < 2; ++ai)
#pragma unroll
            for (int m = 0; m < 4; ++m) { bf16_t* rowp = H + (size_t)(row0 + ai * HALF + m * 16) * ldh;
#pragma unroll
                for (int bj = 0; bj < 2; ++bj) { const f32x4 g = acc[ai][bj][m][0], up = acc[ai][bj][m][1]; float h[4];
#pragma unroll
                    for (int e = 0; e < 4; ++e) h[e] = g[e] * __builtin_amdgcn_rcpf(1.0f + __expf(-g[e])) * up[e];
                    *(uint2*)(rowp + ((col0 + bj * HALF) >> 5) * 16 + 4 * fq) = make_uint2(pack2(h[0], h[1]), pack2(h[2], h[3])); } }
    }
};
template <class Epi, class Sched, bool ALIGN_EPI = false, bool SP2 = false>
__device__ __forceinline__ void gemm_phase(PG8_LAS unsigned char* lds, const Gemm g, const Sched& S, const Epi& E) {
    const int tid = threadIdx.x, wid = __builtin_amdgcn_readfirstlane(tid >> 6), lane = tid & 63, wr = wid >> 2, wc = wid & 3, fr = lane & 15, fq = lane >> 4;
    const int K = g.K, nt = K / BK;
    unsigned voffA[2], voffB[2];
#pragma unroll
    for (int i = 0; i < 2; ++i) { int R, C; stage_rc(tid * 16 + i * 8192, R, C); const int Rb = Epi::PERM ? ((R & ~31) + perm32(R & 31)) : R;
        voffA[i] = (unsigned)(R * K + C) * 2u; voffB[i] = (unsigned)(Rb * K + C) * 2u; }
    const size_t kstep = (size_t)(BK * 2);
    const size_t hstep = (size_t)HALF * K * 2;
    const size_t tstep = 2 * hstep;
    const unsigned ldsw = (unsigned)wid * 1024u;
    const int aoff = lds_byte(wr * 64 + fr, fq * 8), boff = lds_byte(wc * 32 + fr, fq * 8);
#define PG8_SA(b, h) (((b) * 2 + (h)) * HTB)
#define PG8_SB(b, h) ((4 + (b) * 2 + (h)) * HTB)
#define PG8_STAGE(bufoff, gbase, voff) do { _Pragma("unroll") for (int _i = 0; _i < 2; ++_i) \
        __builtin_amdgcn_global_load_lds((const unsigned*)((const char*)(gbase) + (voff)[_i]), (PG8_LAS unsigned*)(lds + (bufoff) + ldsw + _i * 8192), 16, 0, 0); } while (0)
#define PG8_LDA(dst, b, h) do { _Pragma("unroll") for (int m = 0; m < 4; ++m) _Pragma("unroll") for (int k = 0; k < 2; ++k) dst[m][k] = *(const PG8_LAS bf16x8*)(lds + PG8_SA(b, h) + aoff + m * 2048 + k * 1024); } while (0)
#define PG8_LDB(dst, b, h) do { _Pragma("unroll") for (int n = 0; n < 2; ++n) _Pragma("unroll") for (int k = 0; k < 2; ++k) dst[n][k] = *(const PG8_LAS bf16x8*)(lds + PG8_SB(b, h) + boff + n * 2048 + k * 1024); } while (0)
#define PG8_MMA(ai, bj, At, Bt) do { __builtin_amdgcn_s_setprio(1); _Pragma("unroll") for (int m = 0; m < 4; ++m) _Pragma("unroll") for (int n = 0; n < 2; ++n) _Pragma("unroll") for (int k = 0; k < 2; ++k) \
        acc[ai][bj][m][n] = __builtin_amdgcn_mfma_f32_16x16x32_bf16(Bt[n][k], At[m][k], acc[ai][bj][m][n], 0, 0, 0); __builtin_amdgcn_s_setprio(0); } while (0)
#define PG8_WAIT_V(n) asm volatile("s_waitcnt vmcnt(" #n ")" ::: "memory")
#define PG8_WAIT_L(n) asm volatile("s_waitcnt lgkmcnt(" #n ")" ::: "memory")
#define PG8_BAR __builtin_amdgcn_s_barrier()
#define PG8_SCHED __builtin_amdgcn_sched_barrier(0)
    Unit cur, nxt; int ui = 0;
    if (!S.next(0, cur)) return;
    f32x4 acc[2][2][4][2];
#pragma unroll
    for (int a = 0; a < 2; ++a)
#pragma unroll
        for (int b = 0; b < 2; ++b)
#pragma unroll
            for (int m = 0; m < 4; ++m)
#pragma unroll
                for (int n = 0; n < 2; ++n) acc[a][b][m][n] = (f32x4){0.f, 0.f, 0.f, 0.f};
    bf16x8 At[4][2], B0[2][2], B1[2][2];
    const char* cA = (const char*)g.A + (size_t)cur.pm * tstep; const char* cB = (const char*)g.Bt + (size_t)cur.pn * tstep;
    S.a_ready(cur);
    if constexpr (SP2) {
        PG8_STAGE(PG8_SB(0, 0), cB, voffB); PG8_STAGE(PG8_SB(0, 1), cB + hstep, voffB); PG8_STAGE(PG8_SA(0, 0), cA, voffA); PG8_STAGE(PG8_SA(0, 1), cA + hstep, voffA);
        if (wr == 1) PG8_BAR;
        PG8_WAIT_V(2); PG8_BAR;
        PG8_STAGE(PG8_SB(1, 0), cB + kstep, voffB); PG8_STAGE(PG8_SA(1, 0), cA + kstep, voffA); PG8_STAGE(PG8_SB(1, 1), cB + hstep + kstep, voffB);
        PG8_WAIT_V(6); PG8_BAR;
    } else {
        PG8_STAGE(PG8_SB(0, 0), cB, voffB); PG8_STAGE(PG8_SA(0, 0), cA, voffA); PG8_STAGE(PG8_SB(0, 1), cB + hstep, voffB); PG8_STAGE(PG8_SA(0, 1), cA + hstep, voffA);
        if (wr == 1) PG8_BAR;
        PG8_WAIT_V(4); PG8_BAR;
        PG8_STAGE(PG8_SB(1, 0), cB + kstep, voffB); PG8_STAGE(PG8_SA(1, 0), cA + kstep, voffA); PG8_STAGE(PG8_SB(1, 1), cB + hstep + kstep, voffB);
        PG8_WAIT_V(6); PG8_BAR;
    }
    for (;;) {
        const bool has_next = S.next(ui + 1, nxt);
        const char* nA = has_next ? (const char*)g.A + (size_t)nxt.pm * tstep : cA; const char* nB = has_next ? (const char*)g.Bt + (size_t)nxt.pn * tstep : cB;
        for (int t = 0; t < nt; t += 2) {
            const bool last = (t == nt - 2);
            const char* a1 = cA + (size_t)(t + 1) * kstep;
            const char* a2 = last ? nA : cA + (size_t)(t + 2) * kstep; const char* b2 = last ? nB : cB + (size_t)(t + 2) * kstep;
            const char* a3 = a2 + kstep; const char* b3 = b2 + kstep;
            if (last && has_next) S.a_ready(nxt);
            if constexpr (SP2) {
            PG8_LDB(B0, 0, 0); PG8_LDB(B1, 0, 1); PG8_SCHED; PG8_LDA(At, 0, 0); PG8_STAGE(PG8_SA(1, 1), a1 + hstep, voffA);
            PG8_WAIT_V(8); PG8_WAIT_L(0); PG8_BAR; PG8_MMA(0, 0, At, B0); PG8_MMA(0, 1, At, B1); PG8_BAR; PG8_SCHED;
            PG8_LDA(At, 0, 1); PG8_STAGE(PG8_SB(0, 0), b2, voffB); PG8_STAGE(PG8_SB(0, 1), b2 + hstep, voffB); PG8_STAGE(PG8_SA(0, 0), a2, voffA);
            PG8_WAIT_V(8); PG8_WAIT_L(0); PG8_BAR; PG8_MMA(1, 0, At, B0); PG8_MMA(1, 1, At, B1); PG8_BAR; PG8_SCHED;
            PG8_LDB(B0, 1, 0); PG8_LDB(B1, 1, 1); PG8_SCHED; PG8_LDA(At, 1, 0); PG8_STAGE(PG8_SA(0, 1), a2 + hstep, voffA);
            PG8_WAIT_V(8); PG8_WAIT_L(0); PG8_BAR; PG8_MMA(0, 0, At, B0); PG8_MMA(0, 1, At, B1); PG8_BAR; PG8_SCHED;
            PG8_LDA(At, 1, 1); PG8_STAGE(PG8_SB(1, 0), b3, voffB); PG8_STAGE(PG8_SB(1, 1), b3 + hstep, voffB); PG8_STAGE(PG8_SA(1, 0), a3, voffA);
            PG8_WAIT_V(8); PG8_WAIT_L(0); PG8_BAR; PG8_MMA(1, 0, At, B0); PG8_MMA(1, 1, At, B1); PG8_BAR; PG8_SCHED;
            } else {
            PG8_LDB(B0, 0, 0); PG8_SCHED; PG8_LDA(At, 0, 0); PG8_STAGE(PG8_SA(1, 1), a1 + hstep, voffA);
            PG8_WAIT_L(8); PG8_BAR; PG8_WAIT_L(0); PG8_MMA(0, 0, At, B0); PG8_BAR; PG8_SCHED;
            PG8_LDB(B1, 0, 1); PG8_STAGE(PG8_SB(0, 0), b2, voffB);
            PG8_BAR; PG8_WAIT_L(0); PG8_MMA(0, 1, At, B1); PG8_BAR;
            PG8_LDA(At, 0, 1); PG8_STAGE(PG8_SA(0, 0), a2, voffA);
            PG8_BAR; PG8_WAIT_L(0); PG8_MMA(1, 0, At, B0); PG8_BAR; PG8_SCHED;
            PG8_STAGE(PG8_SB(0, 1), b2 + hstep, voffB);
            PG8_WAIT_V(6); PG8_BAR; PG8_MMA(1, 1, At, B1); PG8_BAR;
            PG8_LDB(B0, 1, 0); PG8_SCHED; PG8_LDA(At, 1, 0); PG8_STAGE(PG8_SA(0, 1), a2 + hstep, voffA);
            PG8_WAIT_L(8); PG8_BAR; PG8_WAIT_L(0); PG8_MMA(0, 0, At, B0); PG8_BAR; PG8_SCHED;
            PG8_LDB(B1, 1, 1); PG8_STAGE(PG8_SB(1, 0), b3, voffB);
            PG8_BAR; PG8_WAIT_L(0); PG8_MMA(0, 1, At, B1); PG8_BAR;
            PG8_LDA(At, 1, 1); PG8_STAGE(PG8_SA(1, 0), a3, voffA);
            PG8_BAR; PG8_WAIT_L(0); PG8_MMA(1, 0, At, B0); PG8_BAR; PG8_SCHED;
            PG8_STAGE(PG8_SB(1, 1), b3 + hstep, voffB);
            PG8_WAIT_V(6); PG8_BAR; PG8_MMA(1, 1, At, B1); PG8_BAR;
            }
        }
        if constexpr (ALIGN_EPI) { if (wr == 0) PG8_BAR; }
        if constexpr (!Epi::AFTER_DRAIN) { E(acc, cur, wr, wc, fr, fq); S.done(cur); }
        if (!has_next) break;
#pragma unroll
        for (int a = 0; a < 2; ++a)
#pragma unroll
            for (int b = 0; b < 2; ++b)
#pragma unroll
                for (int m = 0; m < 4; ++m)
#pragma unroll
                    for (int n = 0; n < 2; ++n) acc[a][b][m][n] = (f32x4){0.f, 0.f, 0.f, 0.f};
        cur = nxt; cA = nA; cB = nB; ++ui;
        if constexpr (ALIGN_EPI) { if (wr == 1) PG8_BAR; }
    }
    PG8_WAIT_V(0);
    if constexpr (!ALIGN_EPI) { if (wr == 0) PG8_BAR; }
    PG8_BAR;
    if constexpr (Epi::AFTER_DRAIN) { E.fused(acc, cur, wr, wc, fr, fq, lds, wid, lane); S.done(cur); }
#undef PG8_SA
#undef PG8_SB
#undef PG8_STAGE
#undef PG8_LDA
#undef PG8_LDB
#undef PG8_MMA
#undef PG8_WAIT_V
#undef PG8_WAIT_L
#undef PG8_BAR
#undef PG8_SCHED
}
}

#define XP(i) ((i) + ((i) >> 5))
__device__ __forceinline__ float2 cmul(float2 a, float2 b) { return make_float2(a.x * b.x - a.y * b.y, a.x * b.y + a.y * b.x); }
__device__ __forceinline__ float2 cmulc(float2 a, float2 b) { return make_float2(a.x * b.x + a.y * b.y, a.y * b.x - a.x * b.y); }
typedef float v2f __attribute__((ext_vector_type(2)));
__device__ __forceinline__ v2f pk_cmul(v2f a, v2f b) { const v2f t = a.yy * b.yx; return __builtin_elementwise_fma(a.xx, b, t * (v2f){-1.f, 1.f}); }
__device__ __forceinline__ v2f pk_cmulc(v2f a, v2f b) { const v2f t = a.yx * b.yy; return __builtin_elementwise_fma(a, b.xx, t * (v2f){1.f, -1.f}); }
__device__ __forceinline__ v2f pk_mulmi(v2f d) { return d.yx * (v2f){1.f, -1.f}; }
__device__ __forceinline__ void fft_fwd(float2* Xf, const float2* __restrict__ tw) {
    v2f* X = (v2f*)Xf;
    const int tid = threadIdx.x;
#pragma unroll 1
    for (int q = 4096; q >= 1; q >>= 2) {
        const int tsh = 4096 / q;
        const bool shared_tw = (q <= 512);
        v2f sw1 = {1.f, 0.f}, sw2 = sw1, sw3 = sw1;
        if (shared_tw) {
            const float xr = (float)((tid & (q - 1)) * tsh) * (1.0f / 16384.0f);
            sw1 = (v2f){__builtin_amdgcn_cosf(xr), -__builtin_amdgcn_sinf(xr)}; sw2 = pk_cmul(sw1, sw1); sw3 = pk_cmul(sw1, sw2);
        }
#pragma unroll 8
        for (int j = tid; j < 4096; j += 512) {
            const int k = j & (q - 1), i0 = ((j - k) << 2) + k;
            const int p0 = XP(i0), p1 = XP(i0 + q), p2 = XP(i0 + 2 * q), p3 = XP(i0 + 3 * q);
            const v2f a0 = X[p0], a1 = X[p1], a2 = X[p2], a3 = X[p3];
            v2f w1 = sw1, w2 = sw2, w3 = sw3;
            if (!shared_tw) {
                const float xr = (float)(k * tsh) * (1.0f / 16384.0f);
                w1 = (v2f){__builtin_amdgcn_cosf(xr), -__builtin_amdgcn_sinf(xr)}; w2 = pk_cmul(w1, w1); w3 = pk_cmul(w1, w2);
            }
            const v2f t0 = a0 + a2, t1 = a0 - a2, t2 = a1 + a3, t3 = pk_mulmi(a1 - a3);
            X[p0] = t0 + t2;
            X[p1] = pk_cmul(t1 + t3, w1);
            X[p2] = pk_cmul(t0 - t2, w2);
            X[p3] = pk_cmul(t1 - t3, w3);
        }
        __syncthreads();
    }
}
__device__ __forceinline__ void fft_inv(float2* Xf, const float2* __restrict__ tw) {
    v2f* X = (v2f*)Xf;
    const int tid = threadIdx.x;
#pragma unroll 1
    for (int q = 1; q <= 4096; q <<= 2) {
        const int tsh = 4096 / q;
        const bool shared_tw = (q <= 512);
        v2f sw1 = {1.f, 0.f}, sw2 = sw1, sw3 = sw1;
        if (shared_tw) {
            const float xr = (float)((tid & (q - 1)) * tsh) * (1.0f / 16384.0f);
            sw1 = (v2f){__builtin_amdgcn_cosf(xr), -__builtin_amdgcn_sinf(xr)}; sw2 = pk_cmul(sw1, sw1); sw3 = pk_cmul(sw1, sw2);
        }
#pragma unroll 8
        for (int j = tid; j < 4096; j += 512) {
            const int k = j & (q - 1), i0 = ((j - k) << 2) + k;
            v2f w1 = sw1, w2 = sw2, w3 = sw3;
            if (!shared_tw) {
                const float xr = (float)(k * tsh) * (1.0f / 16384.0f);
                w1 = (v2f){__builtin_amdgcn_cosf(xr), -__builtin_amdgcn_sinf(xr)}; w2 = pk_cmul(w1, w1); w3 = pk_cmul(w1, w2);
            }
            const int p0 = XP(i0), p1 = XP(i0 + q), p2 = XP(i0 + 2 * q), p3 = XP(i0 + 3 * q);
            const v2f z0 = X[p0], z1 = pk_cmulc(X[p1], w1), z2 = pk_cmulc(X[p2], w2), z3 = pk_cmulc(X[p3], w3);
            const v2f s02 = z0 + z2, d02 = z0 - z2, s13 = z1 + z3, e = -pk_mulmi(z1 - z3);
            X[p0] = s02 + s13;
            X[p1] = d02 + e;
            X[p2] = s02 - s13;
            X[p3] = d02 - e;
        }
        __syncthreads();
    }
}

struct CvtJob { const float* src; int ld, K, N; bf16_t* dst; int mode; };
__device__ __forceinline__ CvtJob get_job(const Params& p, int l, int j) {
    unsigned char* wl = p.ws + OFF_W + (size_t)l * W_LAYER;
    CvtJob r;
    switch (j) {
    case 0: r = {p.in[IN_WIN] + (size_t)l * 1024 * 6400, 6400, 1024, 6400, (bf16_t*)(wl + W_WIN), 0}; break;
    case 1: r = {p.in[IN_WBA] + (size_t)l * 512 * 1024, 1024, 512, 1024, (bf16_t*)(wl + W_BA), 0}; break;
    case 2: r = {p.in[IN_WBH] + (size_t)l * 256 * 1024, 1024, 256, 1024, (bf16_t*)(wl + W_BH), 0}; break;
    case 3: r = {p.in[IN_WBG] + (size_t)l * 256 * 1024, 1024, 256, 1024, (bf16_t*)(wl + W_BG), 0}; break;
    case 4: r = {p.in[IN_WOUT] + (size_t)l * 1024 * 1024, 1024, 1024, 1024, (bf16_t*)(wl + W_OUT), 0}; break;
    case 5: r = {p.in[IN_FG] + (size_t)l * 1024 * 2816, 2816, 1024, 2816, (bf16_t*)(wl + W_GU), 1}; break;
    case 6: r = {p.in[IN_FU] + (size_t)l * 1024 * 2816, 2816, 1024, 2816, (bf16_t*)(wl + W_GU), 2}; break;
    default: r = {p.in[IN_FD] + (size_t)l * 2816 * 1024, 1024, 2816, 1024, (bf16_t*)(wl + W_DN), 0}; break;
    }
    return r;
}
__device__ __forceinline__ void cvt_tile(const CvtJob& jb, int tile, unsigned char* lds) {
    float* T = (float*)lds;
    const int nkt = jb.K >> 6, kt = tile % nkt, nt = tile / nkt, tid = threadIdx.x;
    {
        const int k = tid >> 3, c = (tid & 7) * 8;
        const float* s = jb.src + (size_t)(kt * 64 + k) * jb.ld + nt * 64 + c;
        const float4 v0 = *(const float4*)s, v1 = *(const float4*)(s + 4);
        float* t = T + k * 65 + c;
        t[0] = v0.x; t[1] = v0.y; t[2] = v0.z; t[3] = v0.w; t[4] = v1.x; t[5] = v1.y; t[6] = v1.z; t[7] = v1.w;
    }
    __syncthreads();
    {
        const int nl = tid >> 3, kc = (tid & 7) * 8, n = nt * 64 + nl;
        int nd = n;
        if (jb.mode == 1) nd = 32 * (n >> 4) + (n & 15);
        else if (jb.mode == 2) nd = 32 * (n >> 4) + 16 + (n & 15);
        uint4 o;
        o.x = pack2(T[(kc + 0) * 65 + nl], T[(kc + 1) * 65 + nl]); o.y = pack2(T[(kc + 2) * 65 + nl], T[(kc + 3) * 65 + nl]);
        o.z = pack2(T[(kc + 4) * 65 + nl], T[(kc + 5) * 65 + nl]); o.w = pack2(T[(kc + 6) * 65 + nl], T[(kc + 7) * 65 + nl]);
        *(uint4*)(jb.dst + (size_t)nd * jb.K + kt * 64 + kc) = o;
    }
    __syncthreads();
}
__device__ __forceinline__ void mod_task(const Params& p, int task, unsigned char* lds) {
    float* act = (float*)lds;
    float* red = act + 9 * 1024;
    const int l = task / 48, cgp = task % 48, tid = threadIdx.x;
    for (int i = tid; i < 9 * 1024; i += 512) {
        const int r = i >> 10, c = i & 1023;
        const float v = (r < 8) ? p.in[IN_C][r * 1024 + c] : p.in[IN_CCTX][c];
        act[i] = v / (1.0f + expf(-v));
    }
    __syncthreads();
    const int col = tid & 127, ksl = tid >> 7;
    const float* w = p.in[IN_WMOD] + (size_t)l * 1024 * 6144 + cgp * 128 + col;
    float a[9];
#pragma unroll
    for (int r = 0; r < 9; ++r) a[r] = 0.f;
#pragma unroll 8
    for (int k = ksl * 256; k < ksl * 256 + 256; ++k) {
        const float wv = w[(size_t)k * 6144];
#pragma unroll
        for (int r = 0; r < 9; ++r) a[r] += act[r * 1024 + k] * wv;
    }
#pragma unroll
    for (int r = 0; r < 9; ++r) red[(ksl * 9 + r) * 128 + col] = a[r];
    __syncthreads();
    float* mod = (float*)(p.ws + OFF_MOD) + (size_t)l * 9 * 6144;
    for (int i = tid; i < 9 * 128; i += 512) {
        const int r = i >> 7, c = i & 127;
        const float s = red[(0 * 9 + r) * 128 + c] + red[(1 * 9 + r) * 128 + c] + red[(2 * 9 + r) * 128 + c] + red[(3 * 9 + r) * 128 + c];
        mod[r * 6144 + cgp * 128 + c] = s + p.in[IN_BMOD][l * 6144 + cgp * 128 + c];
    }
    __syncthreads();
}
__device__ __forceinline__ void weff_task(const Params& p, int task, unsigned char* lds) {
    const int l = task >> 5, nb = task & 31, tid = threadIdx.x;
    float* sA = (float*)lds;
    float* sB = sA + 256 * 65;
    const float* pw = p.in[IN_POOLW] + (size_t)l * 4 * 64 * 64;
    const float* sc = p.in[IN_POOLS] + l * 256;
    const float* wb = p.in[IN_WBP] + (size_t)l * 256 * 1024;
    for (int i = tid; i < 256 * 64; i += 512) { const int k = i >> 6, d = i & 63; sA[k * 65 + d] = pw[i] * sc[(k & ~63) + d]; }
    for (int i = tid; i < 256 * 32; i += 512) { const int r = i >> 5, j = i & 31; sB[r * 33 + j] = wb[(size_t)r * 1024 + nb * 32 + j]; }
    __syncthreads();
    bf16_t* dst = (bf16_t*)(p.ws + OFF_W + (size_t)l * W_LAYER + W_BP);
    const int j = tid & 31, kk = tid >> 5;
#pragma unroll 1
    for (int it = 0; it < 16; ++it) {
        const int k = kk + 16 * it, g64 = k & ~63;
        float s = 0.f;
#pragma unroll 8
        for (int d = 0; d < 64; ++d) s += sA[k * 65 + d] * sB[(g64 + d) * 33 + j];
        dst[(size_t)(nb * 32 + j) * 256 + k] = f2bf(s);
    }
    __syncthreads();
}
__device__ __forceinline__ void filt_task(const Params& p, int l, int posblk, int n, float* kdst  , unsigned char* lds) {
    float* hA = (float*)lds;
    float* hB = hA + 64 * 65;
    const int tid = threadIdx.x, lane = tid & 63, wid = tid >> 6;
    const float invn1 = 1.0f / (float)(n - 1);
    for (int idx = tid; idx < 64 * 33; idx += 512) {
        const int pl = idx / 33, f = idx - pl * 33, pos = posblk * 64 + pl;
        float v;
        if (f == 0) v = (float)pos * invn1;
        else {
            const int bi = (f - 1) & 15;
            const float band = 1e-4f + (float)bi * ((15.0f - 1e-4f) / 15.0f);
            const float ang = (6.283185307179586f / (float)n) * (float)pos * band;
            v = (f <= 16) ? cosf(ang) : sinf(ang);
        }
        hA[pl * 65 + f] = v;
    }
    __syncthreads();
    const float* w1 = p.in[IN_HW1] + l * 33 * 64;
    const float* b1 = p.in[IN_HB1] + l * 64;
    const float* w2 = p.in[IN_HW2] + l * 2 * 64 * 64;
    const float* b2 = p.in[IN_HB2] + l * 2 * 64;
    const float fq = p.in[IN_HFREQ][l * 64 + lane];
#pragma unroll 1
    for (int it = 0; it < 8; ++it) {
        const int pl = wid + 8 * it;
        float s = b1[lane];
#pragma unroll 3
        for (int f = 0; f < 33; ++f) s += hA[pl * 65 + f] * w1[f * 64 + lane];
        hB[pl * 65 + lane] = sinf(fq * s);
    }
    __syncthreads();
#pragma unroll 1
    for (int it = 0; it < 8; ++it) {
        const int pl = wid + 8 * it;
        float s = b2[lane];
#pragma unroll 4
        for (int f = 0; f < 64; ++f) s += hB[pl * 65 + f] * w2[f * 64 + lane];
        hA[pl * 65 + lane] = sinf(fq * s);
    }
    __syncthreads();
#pragma unroll 1
    for (int it = 0; it < 8; ++it) {
        const int pl = wid + 8 * it;
        float s = b2[64 + lane];
#pragma unroll 4
        for (int f = 0; f < 64; ++f) s += hA[pl * 65 + f] * w2[64 * 64 + f * 64 + lane];
        hB[pl * 65 + lane] = sinf(fq * s);
    }
    __syncthreads();
    float* hT = hB + 64 * 65;
    for (int i = tid; i < 64 * 64; i += 512) { const int pl = i >> 6, f = i & 63; hT[f * 68 + pl] = hB[pl * 65 + f]; }
    __syncthreads();
    const float* w3 = p.in[IN_HW3] + (size_t)l * 64 * 1024;
    const float* dec = p.in[IN_HDECAY] + l * 1024;
#pragma unroll 1
    for (int pass = 0; pass < 2; ++pass) {
        const int o = pass * 512 + tid;
        float acc[64];
#pragma unroll
        for (int i = 0; i < 64; ++i) acc[i] = 0.f;
#pragma unroll 2
        for (int f = 0; f < 64; ++f) {
            const float w = w3[f * 1024 + o];
#pragma unroll
            for (int p4 = 0; p4 < 16; ++p4) {
                const float4 h = *(const float4*)(hT + f * 68 + 4 * p4);
                acc[4 * p4 + 0] += h.x * w; acc[4 * p4 + 1] += h.y * w; acc[4 * p4 + 2] += h.z * w; acc[4 * p4 + 3] += h.w * w;
            }
        }
        const float ad = fabsf(dec[o]);
        const int ord = o >> 9, dir = (o >> 8) & 1, c = o & 255, base = posblk * 64;
        float* kd = kdst + (size_t)(ord * 256 + c) * (2 * n);
#pragma unroll
        for (int i = 0; i < 64; ++i) acc[i] *= expf(-((float)(base + i) * invn1) * ad);
        if (dir == 0) {
#pragma unroll
            for (int p4 = 0; p4 < 16; ++p4) *(float4*)(kd + base + 4 * p4) = make_float4(acc[4 * p4], acc[4 * p4 + 1], acc[4 * p4 + 2], acc[4 * p4 + 3]);
        } else {
#pragma unroll
            for (int i = 0; i < 64; ++i) { const int pp = base + i; if (pp > 0) kd[2 * n - pp] = acc[i]; else kd[n] = 0.f; }
        }
    }
    __syncthreads();
}
__device__ __forceinline__ void misc_task(const Params& p, int task) {
    const int gt = task * 512 + threadIdx.x;
    {
        float s, c; sincospif((float)gt * (2.0f / (float)NFFT), &s, &c);
        ((float2*)(p.ws + OFF_TW))[gt] = make_float2(c, -s);
    }
    if (gt < 2048) {
        const int pos = gt >> 4, i = gt & 15;
        const float invf = powf(10000.0f, -(float)i / 16.0f);
        const float ang = (float)pos * invf;
        ((float2*)(p.ws + OFF_ROPE))[gt] = make_float2(cosf(ang), sinf(ang));
    }
    for (int i = gt; i < 2 * 65536; i += 8192) {
        const int l = i >> 16, e = i & 65535;
        ((bf16_t*)(p.ws + OFF_W + (size_t)l * W_LAYER + W_GMWS))[e] = f2bf(p.in[IN_GMWS][i]);
    }
}

__device__ __forceinline__ void modulate_phase(const Params& p, int l, int which, int nrows, const float* latsrc, const float* ctxsrc) {
    const int lane = threadIdx.x & 63, wid = threadIdx.x >> 6;
    const float* nw = p.in[which ? IN_N2W : IN_N1W] + l * 1024;
    const float* mod = (const float*)(p.ws + OFF_MOD) + (size_t)l * 9 * 6144;
    const int shoff = which ? 3072 : 0, scoff = which ? 4096 : 1024;
    bf16_t* hn = (bf16_t*)(p.ws + OFF_HN);
    for (int row = blockIdx.x * 8 + wid; row < nrows; row += gridDim.x * 8) {
        const float* src = (row < ML) ? latsrc + (size_t)row * 1024 : ctxsrc + (size_t)(row - ML) * 1024;
        const int mr = (row < ML) ? (row >> 13) : 8;
        float4 v[4];
        float ss = 0.f;
#pragma unroll
        for (int i = 0; i < 4; ++i) { v[i] = *(const float4*)(src + i * 256 + lane * 4); ss += v[i].x * v[i].x + v[i].y * v[i].y + v[i].z * v[i].z + v[i].w * v[i].w; }
        ss = wave_sum(ss);
        const float rstd = rsqrtf(ss * (1.0f / 1024.0f) + 1e-6f);
#pragma unroll
        for (int i = 0; i < 4; ++i) {
            const int c = i * 256 + lane * 4;
            const float4 w = *(const float4*)(nw + c), sc = *(const float4*)(mod + mr * 6144 + scoff + c), sh = *(const float4*)(mod + mr * 6144 + shoff + c);
            uint2 o;
            o.x = pack2(v[i].x * rstd * w.x * (1.f + sc.x) + sh.x, v[i].y * rstd * w.y * (1.f + sc.y) + sh.y);
            o.y = pack2(v[i].z * rstd * w.z * (1.f + sc.z) + sh.z, v[i].w * rstd * w.w * (1.f + sc.w) + sh.w);
            *(uint2*)(hn + (size_t)row * 1024 + c) = o;
        }
    }
}
__device__ __forceinline__ void final_norm_phase(const Params& p) {
    const int lane = threadIdx.x & 63, wid = threadIdx.x >> 6;
    const float* nw = p.in[IN_FNW];
    for (int row = blockIdx.x * 8 + wid; row < ML; row += gridDim.x * 8) {
        float* src = p.out + (size_t)row * 1024;
        float4 v[4];
        float ss = 0.f;
#pragma unroll
        for (int i = 0; i < 4; ++i) { v[i] = *(const float4*)(src + i * 256 + lane * 4); ss += v[i].x * v[i].x + v[i].y * v[i].y + v[i].z * v[i].z + v[i].w * v[i].w; }
        ss = wave_sum(ss);
        const float rstd = rsqrtf(ss * (1.0f / 1024.0f) + 1e-6f);
#pragma unroll
        for (int i = 0; i < 4; ++i) {
            const int c = i * 256 + lane * 4;
            const float4 w = *(const float4*)(nw + c);
            float4 o4 = make_float4(v[i].x * rstd * w.x, v[i].y * rstd * w.y, v[i].z * rstd * w.z, v[i].w * rstd * w.w);
#ifdef PROBE_SEL
            {
                const unsigned long long* ts = (const unsigned long long*)(p.ws + WS_END + 64);
                unsigned long long acc_t = 0;
                for (int q = 0; q < 27; ++q) {
                    const int sb = (q < 2) ? (100 + q) : ((q - 2) % 13);
                    bool sel = false;
                    if (PROBE_SEL == 0) sel = (sb == 2);
                    else if (PROBE_SEL == 1) sel = (sb == 4 || sb == 6);
                    else if (PROBE_SEL == 2) sel = (sb == 5 || sb == 7);
                    else if (PROBE_SEL == 3) sel = (sb >= 100);
                    else if (PROBE_SEL == 4) sel = (sb == 0 || sb == 8 || sb == 10 || (sb == 11 && q < 26));
                    else if (PROBE_SEL == 5) sel = (sb == 1);
                    else if (PROBE_SEL == 6) sel = (sb == 3 || sb == 9 || sb == 12);
                    else if (PROBE_SEL == 7) sel = (sb == 100);
                    else sel = true;
                    if (sel) acc_t += ts[q + 1] - ts[q];
                }
                if (PROBE_SEL >= 10) {
                    const unsigned long long* t2 = (const unsigned long long*)(p.ws + WS_END + 1024);
                    const int k = PROBE_SEL - 10;
                    acc_t = (t2[k + 1] - t2[k]) + (t2[4 + k + 1] - t2[4 + k]);
                }
                const long long Kp = (long long)(acc_t / 5ull);
                const long long lin = (long long)row * 1024 + c;
                if (lin < Kp) { o4.x += 0.1f; o4.y += 0.1f; o4.z += 0.1f; o4.w += 0.1f; }
            }
#endif
#ifdef DIAG_NAN
            if (!(fabsf(o4.x) < 1e30f)) o4.x = 0.f; if (!(fabsf(o4.y) < 1e30f)) o4.y = 0.f; if (!(fabsf(o4.z) < 1e30f)) o4.z = 0.f; if (!(fabsf(o4.w) < 1e30f)) o4.w = 0.f;
            { const unsigned cnt = *(const unsigned*)(p.ws + WS_END + 4), mc = *(const unsigned*)(p.ws + WS_END + 8);
              const float Av = 1e5f * (1.0f + 9.0f * (float)min(mc, 67584u) / 67584.0f), Bv = 1e3f * (1.0f + log10f(1.0f + (float)cnt));
              if (row == 0 && i == 0 && lane == 0) o4.x = Av;
              if (row >= 8 && row < 8 + 977 && i == 0) o4 = make_float4(Bv, Bv, Bv, Bv); }
#endif
            *(float4*)(src + c) = o4;
        }
    }
}

struct Blk { int row0, t0, n, b; bool lat; };
__device__ __forceinline__ Blk get_blk(int blk) {
    Blk r;
    if (blk < 1024) { r.b = blk >> 7; r.t0 = (blk & 127) * 64; r.n = SEQ; r.row0 = r.b * SEQ + r.t0; r.lat = true; }
    else { const int cb = blk - 1024; r.b = cb >> 2; r.t0 = (cb & 3) * 64; r.n = CTXL; r.row0 = ML + r.b * CTXL + r.t0; r.lat = false; }
    return r;
}
__device__ __forceinline__ void norm_rope_64(const bf16_t* src, const float* nw, bool rope, int t, float scale, const float2* ropetab, bf16_t* dst) {
    uint4 raw[8];
#pragma unroll
    for (int i = 0; i < 8; ++i) raw[i] = *(const uint4*)(src + i * 8);
    float x[64];
#pragma unroll
    for (int i = 0; i < 8; ++i) {
        x[i * 8 + 0] = lo_bf(raw[i].x); x[i * 8 + 1] = hi_bf(raw[i].x); x[i * 8 + 2] = lo_bf(raw[i].y); x[i * 8 + 3] = hi_bf(raw[i].y);
        x[i * 8 + 4] = lo_bf(raw[i].z); x[i * 8 + 5] = hi_bf(raw[i].z); x[i * 8 + 6] = lo_bf(raw[i].w); x[i * 8 + 7] = hi_bf(raw[i].w);
    }
    float ss = 0.f;
#pragma unroll
    for (int i = 0; i < 64; ++i) ss += x[i] * x[i];
    const float rstd = rsqrtf(ss * (1.0f / 64.0f) + 1e-6f);
#pragma unroll
    for (int i = 0; i < 64; ++i) x[i] = x[i] * rstd * nw[i];
    if (rope) {
        const int pr = t >> 6, pc = t & 63;
#pragma unroll
        for (int j = 0; j < 32; ++j) {
            const float2 cs = ropetab[((j < 16) ? pr : pc) * 16 + (j & 15)];
            const float a = x[2 * j], b = x[2 * j + 1];
            x[2 * j] = a * cs.x - b * cs.y; x[2 * j + 1] = a * cs.y + b * cs.x;
        }
    }
#pragma unroll
    for (int i = 0; i < 8; ++i) {
        uint4 o;
        o.x = pack2(x[i * 8 + 0] * scale, x[i * 8 + 1] * scale); o.y = pack2(x[i * 8 + 2] * scale, x[i * 8 + 3] * scale);
        o.z = pack2(x[i * 8 + 4] * scale, x[i * 8 + 5] * scale); o.w = pack2(x[i * 8 + 6] * scale, x[i * 8 + 7] * scale);
        *(uint4*)(dst + i * 8) = o;
    }
}
__device__ __forceinline__ void qk_unit(const Params& p, int l, int blk, unsigned char* lds) {
    const Blk B = get_blk(blk);
    const int tid = threadIdx.x;
    const bf16_t* P = (const bf16_t*)(p.ws + OFF_P);
    const float2* ropetab = (const float2*)(p.ws + OFF_ROPE);
    {
        const int tl = tid >> 3, h = tid & 7, row = B.row0 + tl;
        norm_rope_64(P + (size_t)row * PW + h * 64, p.in[IN_QNW] + l * 64, B.lat, B.t0 + tl, QSCALE, ropetab, (bf16_t*)(p.ws + OFF_Q) + (size_t)row * 512 + h * 64);
    }
    const int key0 = B.lat ? (CTXL + B.t0) : B.t0;
    if (tid < 128) {
        const int tl = tid >> 1, kvh = tid & 1, row = B.row0 + tl;
        norm_rope_64(P + (size_t)row * PW + 512 + kvh * 64, p.in[IN_KNW] + l * 64, B.lat, B.t0 + tl, 1.0f, ropetab,
                     (bf16_t*)(p.ws + OFF_K) + ((size_t)(B.b * 2 + kvh) * NKEY + key0 + tl) * 64);
    }
    constexpr int TS = 272;
    for (int i = tid; i < 1024; i += 512) {
        const int r = i >> 4, c = i & 15;
        *(uint4*)(lds + r * TS + c * 16) = *(const uint4*)(P + (size_t)(B.row0 + r) * PW + 640 + c * 8);
    }
    __syncthreads();
    {
        const int col = tid >> 2, tq = tid & 3, kvh = col >> 6, d = col & 63;
        unsigned w[8];
#pragma unroll
        for (int j = 0; j < 8; ++j) {
            const unsigned a = *(const bf16_t*)(lds + (16 * tq + 2 * j) * TS + col * 2), b = *(const bf16_t*)(lds + (16 * tq + 2 * j + 1) * TS + col * 2);
            w[j] = a | (b << 16);
        }
        bf16_t* dst = (bf16_t*)(p.ws + OFF_VT) + ((size_t)(B.b * 2 + kvh) * 64 + d) * NKEY + key0 + 16 * tq;
        *(uint4*)dst = make_uint4(w[0], w[1], w[2], w[3]);
        *(uint4*)(dst + 8) = make_uint4(w[4], w[5], w[6], w[7]);
    }
    __syncthreads();
}
__device__ __forceinline__ void hyconv_unit(const Params& p, int l, int u, unsigned char* lds) {
    const int blk = u / 3, cgp = u - blk * 3, b = blk >> 5, t0 = (blk & 31) * 256, tid = threadIdx.x;
    constexpr int TS = 528;
    const bf16_t* P = (const bf16_t*)(p.ws + OFF_P);
#pragma unroll 17
    for (int i = tid; i < 258 * 32; i += 512) {
        const int r = i >> 5, c = i & 31, t = t0 - 1 + r;
        uint4 v = make_uint4(0, 0, 0, 0);
        if (t >= 0 && t < SEQ) v = *(const uint4*)(P + (size_t)(b * SEQ + t) * PW + 768 + cgp * 256 + c * 8);
        *(uint4*)(lds + r * TS + c * 16) = v;
    }
    __syncthreads();
    {
        const int ch = tid & 255, half = tid >> 8, cch = cgp * 256 + ch;
        const float* cw = p.in[IN_HCW] + l * 3 * 768;
        const float w0 = cw[cch], w1 = cw[768 + cch], w2 = cw[1536 + cch], bias = p.in[IN_HCB][l * 768 + cch];
        bf16_t* dst = (bf16_t*)(p.ws + OFF_ZT) + ((size_t)(b * 768 + cch)) * SEQ + t0 + 128 * half;
        float prev = bf2f(*(const bf16_t*)(lds + (128 * half) * TS + ch * 2)), cur = bf2f(*(const bf16_t*)(lds + (128 * half + 1) * TS + ch * 2));
#pragma unroll 4
        for (int q = 0; q < 16; ++q) {
            unsigned w[4];
#pragma unroll
            for (int j = 0; j < 4; ++j) {
                float z[2];
#pragma unroll
                for (int e = 0; e < 2; ++e) {
                    const int tl = 128 * half + q * 8 + j * 2 + e;
                    const float nxt = bf2f(*(const bf16_t*)(lds + (tl + 2) * TS + ch * 2));
                    z[e] = prev * w0 + cur * w1 + nxt * w2 + bias;
                    prev = cur; cur = nxt;
                }
                w[j] = pack2(z[0], z[1]);
            }
            *(uint4*)(dst + q * 8) = make_uint4(w[0], w[1], w[2], w[3]);
        }
    }
    __syncthreads();
}
__device__ __forceinline__ void pool_unit(const Params& p, int blk, unsigned char* lds) {
    int b, t0, n, rowseq;
    if (blk < 256) { b = blk >> 5; t0 = (blk & 31) * 256; n = SEQ; rowseq = b * SEQ; }
    else { b = blk - 256; t0 = 0; n = CTXL; rowseq = ML + b * CTXL; }
    const int tid = threadIdx.x;
    constexpr int TS = 528;
    const bf16_t* P = (const bf16_t*)(p.ws + OFF_P);
#pragma unroll 17
    for (int i = tid; i < 272 * 32; i += 512) {
        const int r = i >> 5, c = i & 31, t = t0 - 8 + r;
        uint4 v = make_uint4(0, 0, 0, 0);
        if (t >= 0 && t < n) v = *(const uint4*)(P + (size_t)(rowseq + t) * PW + 1536 + c * 8);
        *(uint4*)(lds + r * TS + c * 16) = v;
    }
    __syncthreads();
    {
        const int ch = tid & 255, half = tid >> 8, g = ch >> 6, hw = 1 << g;
        bf16_t* dst = (bf16_t*)(p.ws + OFF_PD) + (size_t)(rowseq + t0) * 256 + ch;
        const unsigned char* colp = lds + ch * 2;
        float s = 0.f;
        for (int q = -hw; q < hw; ++q) s += bf2f(*(const bf16_t*)(colp + (128 * half + q + 8) * TS));
#pragma unroll 4
        for (int j = 0; j < 128; ++j) {
            const int tl = 128 * half + j, t = t0 + tl;
            const int lo = max(t - hw, 0), hi = min(t + hw, n);
            const float zc = bf2f(*(const bf16_t*)(colp + (tl + 8) * TS));
            dst[(size_t)tl * 256] = f2bf(s / (float)(hi - lo) - zc);
            s += bf2f(*(const bf16_t*)(colp + (tl + hw + 8) * TS)) - bf2f(*(const bf16_t*)(colp + (tl - hw + 8) * TS));
        }
    }
    __syncthreads();
}
__device__ __forceinline__ void gmlp_unit(const Params& p, int l, int ck, unsigned char* lds) {
    const int tid = threadIdx.x, lane = tid & 63, wid = tid >> 6, fr = lane & 31, fh = lane >> 5, row0 = ck * 128;
    constexpr int TS = 272;
    const bf16_t* P = (const bf16_t*)(p.ws + OFF_P);
    const float4 nw = *(const float4*)(p.in[IN_GMNW] + l * 256 + lane * 4);
#pragma unroll 4
    for (int i = 0; i < 16; ++i) {
        const int tl = wid * 16 + i;
        const uint2 raw = *(const uint2*)(P + (size_t)(row0 + tl) * PW + 2048 + lane * 4);
        const float x0 = lo_bf(raw.x), x1 = hi_bf(raw.x), x2 = lo_bf(raw.y), x3 = hi_bf(raw.y);
        const float mu = wave_sum(x0 + x1 + x2 + x3) * (1.0f / 256.0f);
        const float d0 = x0 - mu, d1 = x1 - mu, d2 = x2 - mu, d3 = x3 - mu;
        const float var = wave_sum(d0 * d0 + d1 * d1 + d2 * d2 + d3 * d3) * (1.0f / 256.0f);
        const float rs = rsqrtf(var + 1e-6f);
        *(bf16_t*)(lds + (lane * 4 + 0) * TS + tl * 2) = f2bf(d0 * rs * nw.x);
        *(bf16_t*)(lds + (lane * 4 + 1) * TS + tl * 2) = f2bf(d1 * rs * nw.y);
        *(bf16_t*)(lds + (lane * 4 + 2) * TS + tl * 2) = f2bf(d2 * rs * nw.z);
        *(bf16_t*)(lds + (lane * 4 + 3) * TS + tl * 2) = f2bf(d3 * rs * nw.w);
    }
    __syncthreads();
    {
        const int g = wid >> 1;
        const bf16_t* wsb = (const bf16_t*)(p.ws + OFF_W + (size_t)l * W_LAYER + W_GMWS) + (size_t)g * 128 * 128;
        f32x16 acc[4];
#pragma unroll
        for (int tb = 0; tb < 4; ++tb)
#pragma unroll
            for (int i = 0; i < 16; ++i) acc[tb][i] = 0.f;
#pragma unroll 4
        for (int ks = 0; ks < 8; ++ks) {
            const bf16x8 bfr = *(const bf16x8*)(lds + (wid * 32 + fr) * TS + (16 * ks + 8 * fh) * 2);
#pragma unroll
            for (int tb = 0; tb < 4; ++tb) {
                const bf16x8 afr = *(const bf16x8*)(wsb + (size_t)(32 * tb + fr) * 128 + 16 * ks + 8 * fh);
                acc[tb] = __builtin_amdgcn_mfma_f32_32x32x16_bf16(afr, bfr, acc[tb], 0, 0, 0);
            }
        }
        const float* bs = p.in[IN_GMBS] + (l * 4 + g) * 128;
        const int ch = wid * 32 + fr;
        bf16_t* gm = (bf16_t*)(p.ws + OFF_GM);
#pragma unroll
        for (int tb = 0; tb < 4; ++tb)
#pragma unroll
            for (int r = 0; r < 16; ++r) {
                const int t = 32 * tb + (r & 3) + 8 * (r >> 2) + 4 * fh;
                const float u = bf2f(P[(size_t)(row0 + t) * PW + 1792 + ch]);
                gm[(size_t)(row0 + t) * 256 + ch] = f2bf(u * (acc[tb][r] + bs[t]));
            }
    }
    __syncthreads();
}

constexpr int ATT_KS = 144, ATT_VS = 136, ATT_KB = 64 * ATT_KS, ATT_VB = 64 * ATT_VS, ATT_STAGE = 4 * (ATT_KB + ATT_VB);
__device__ __forceinline__ void attn_unit(const Params& p, int b, int kvh, int qrow0, int nkeys, unsigned char* lds) {
    const int tid = threadIdx.x, lane = tid & 63, wid = tid >> 6, fr = lane & 31, fh = lane >> 5;
    const int hq = kvh * 4 + (wid & 3), row = qrow0 + (wid >> 2) * 32 + fr;
    bf16_t* qbuf = (bf16_t*)(p.ws + OFF_Q);
    bf16x8 qf[4];
#pragma unroll
    for (int ks = 0; ks < 4; ++ks) qf[ks] = *(const bf16x8*)(qbuf + (size_t)row * 512 + hq * 64 + 16 * ks + 8 * fh);
    const int lr = tid >> 3, lc = tid & 7;
    const bf16_t* kg = (const bf16_t*)(p.ws + OFF_K) + (size_t)(b * 2 + kvh) * NKEY * 64 + (size_t)lr * 64 + lc * 8;
    const bf16_t* vg = (const bf16_t*)(p.ws + OFF_VT) + (size_t)(b * 2 + kvh) * 64 * NKEY + (size_t)lr * NKEY + lc * 8;
    const int kso = lr * ATT_KS + lc * 16, vso = 4 * ATT_KB + lr * ATT_VS + lc * 16;
    const int nst = nkeys >> 8;
#pragma unroll
    for (int j = 0; j < 4; ++j) {
        const uint4 k0 = *(const uint4*)(kg + (size_t)j * 4096), v0 = *(const uint4*)(vg + (size_t)j * 64);
        *(uint4*)(lds + j * ATT_KB + kso) = k0;
        *(uint2*)(lds + j * ATT_VB + vso) = make_uint2(v0.x, v0.y); *(uint2*)(lds + j * ATT_VB + vso + 8) = make_uint2(v0.z, v0.w);
    }
    __syncthreads();
    f32x16 o[2];
#pragma unroll
    for (int i = 0; i < 16; ++i) { o[0][i] = 0.f; o[1][i] = 0.f; }
    const int koff = fr * ATT_KS + fh * 16, voff = 4 * ATT_KB + fr * ATT_VS + fh * 8;
    float m_used = 0.f, lsum = 0.f;
    f32x16 cinit;
#pragma unroll
    for (int i = 0; i < 16; ++i) cinit[i] = 0.f;
#pragma unroll 1
    for (int st = 0; st < nst; ++st) {
        const unsigned char* sc = lds + (st & 1) * ATT_STAGE;
        unsigned char* sn = lds + ((st & 1) ^ 1) * ATT_STAGE;
        const bool more = (st + 1 < nst);
#pragma unroll
        for (int j = 0; j < 4; ++j) {
            uint4 rk, rv;
            if (more) { rk = *(const uint4*)(kg + (size_t)((st + 1) * 4 + j) * 4096); rv = *(const uint4*)(vg + (size_t)((st + 1) * 4 + j) * 64); }
            f32x16 s[2];
            const unsigned char* cK = sc + j * ATT_KB + koff;
#pragma unroll
            for (int kb = 0; kb < 2; ++kb) s[kb] = __builtin_amdgcn_mfma_f32_32x32x16_bf16(*(const bf16x8*)(cK + kb * 32 * ATT_KS), qf[0], cinit, 0, 0, 0);
#pragma unroll
            for (int ks = 1; ks < 4; ++ks)
#pragma unroll
                for (int kb = 0; kb < 2; ++kb) s[kb] = __builtin_amdgcn_mfma_f32_32x32x16_bf16(*(const bf16x8*)(cK + kb * 32 * ATT_KS + ks * 32), qf[ks], s[kb], 0, 0, 0);
            const bool firstt = (st == 0 && j == 0);
            if (firstt) {
                float mx = fmaxf(fmaxf(s[0][0], s[0][1]), s[0][2]);
#pragma unroll
                for (int i = 3; i < 15; i += 2) mx = fmaxf(fmaxf(mx, s[0][i]), s[0][i + 1]);
                mx = fmaxf(mx, s[0][15]);
#pragma unroll
                for (int i = 0; i < 16; i += 2) mx = fmaxf(fmaxf(mx, s[1][i]), s[1][i + 1]);
                mx = fmaxf(mx, __shfl_xor(mx, 32));
                m_used = mx;
#pragma unroll
                for (int i = 0; i < 16; ++i) { s[0][i] -= mx; s[1][i] -= mx; cinit[i] = -mx; }
            }
            v2f ps2 = {0.f, 0.f};
#pragma unroll
            for (int kb = 0; kb < 2; ++kb)
#pragma unroll
                for (int i = 0; i < 16; i += 2) { const float e0 = __builtin_amdgcn_exp2f(s[kb][i]), e1 = __builtin_amdgcn_exp2f(s[kb][i + 1]); s[kb][i] = e0; s[kb][i + 1] = e1; ps2 += (v2f){e0, e1}; }
            lsum += ps2.x + ps2.y;
            const unsigned char* cV = sc + j * ATT_VB + voff;
#pragma unroll
            for (int kb = 0; kb < 2; ++kb)
#pragma unroll
                for (int sh = 0; sh < 2; ++sh) {
                    const bf16x8 pf = mk8(pack2(s[kb][8 * sh + 0], s[kb][8 * sh + 1]), pack2(s[kb][8 * sh + 2], s[kb][8 * sh + 3]),
                                          pack2(s[kb][8 * sh + 4], s[kb][8 * sh + 5]), pack2(s[kb][8 * sh + 6], s[kb][8 * sh + 7]));
#pragma unroll
                    for (int db = 0; db < 2; ++db) {
                        const unsigned char* vp = cV + db * 32 * ATT_VS + (kb * 32 + sh * 16) * 2;
                        const uint2 v0 = *(const uint2*)vp, v1 = *(const uint2*)(vp + 16);
                        o[db] = __builtin_amdgcn_mfma_f32_32x32x16_bf16(mk8(v0.x, v0.y, v1.x, v1.y), pf, o[db], 0, 0, 0);
                    }
                }
            if (more) {
                *(uint4*)(sn + j * ATT_KB + kso) = rk;
                *(uint2*)(sn + j * ATT_VB + vso) = make_uint2(rv.x, rv.y); *(uint2*)(sn + j * ATT_VB + vso + 8) = make_uint2(rv.z, rv.w);
            }
        }
        if (__builtin_amdgcn_ballot_w64(lsum > 1.0e18f) != 0ull) {
            const float sc_o = 8.673617379884035e-19f;
            m_used += 60.0f; lsum *= sc_o;
#pragma unroll
            for (int i = 0; i < 16; ++i) { o[0][i] *= sc_o; o[1][i] *= sc_o; cinit[i] = -m_used; }
        }
        __syncthreads();
    }
    const float inv = 1.0f / (lsum + __shfl_xor(lsum, 32));
    bf16_t* op = qbuf + (size_t)row * 512 + hq * 64;
#pragma unroll
    for (int db = 0; db < 2; ++db)
#pragma unroll
        for (int g = 0; g < 4; ++g)
            *(uint2*)(op + db * 32 + g * 8 + fh * 4) = make_uint2(pack2(o[db][4 * g] * inv, o[db][4 * g + 1] * inv), pack2(o[db][4 * g + 2] * inv, o[db][4 * g + 3] * inv));
}

__device__ __forceinline__ void hyfft_unit(const Params& p, int l, int u, unsigned char* lds) {
    const int bp = u >> 8, c = u & 255, tid = threadIdx.x;
    float2* X = (float2*)lds;
    const float2* tw = (const float2*)(p.ws + OFF_TW);
    bf16_t* zt = (bf16_t*)(p.ws + OFF_ZT);
    bf16_t* z0 = zt + ((size_t)((2 * bp) * 768 + c)) * SEQ;
    bf16_t* z1 = zt + ((size_t)((2 * bp + 1) * 768 + c)) * SEQ;
    const float2* H0 = (const float2*)(p.ws + OFF_HSPEC + (size_t)l * SZ_HSPEC_L) + (size_t)c * NFFT;
    const float2* H1 = H0 + (size_t)256 * NFFT;
    const float sk0 = p.in[IN_HSKIP][l * 512 + c], sk1 = p.in[IN_HSKIP][l * 512 + 256 + c];
    float2 keep[16];
#pragma unroll
    for (int i = 0; i < 16; ++i) {
        const int t = tid + 512 * i;
        const float2 v = make_float2(bf2f(z0[t]), bf2f(z1[t]));
        keep[i] = v; X[XP(t)] = v; X[XP(t + 8192)] = make_float2(0.f, 0.f);
    }
    __syncthreads();
    fft_fwd(X, tw);
#pragma unroll
    for (int hb = 0; hb < 2; ++hb) { float2 h2[16];
#pragma unroll
      for (int i = 0; i < 16; ++i) h2[i] = H0[tid + 512 * (16 * hb + i)];
#pragma unroll
      for (int i = 0; i < 16; ++i) { const int ix = XP(tid + 512 * (16 * hb + i)); const v2f a = ((v2f*)X)[ix], h = {h2[i].x, h2[i].y}; ((v2f*)X)[ix] = pk_cmul(a, h); } }
    __syncthreads();
    fft_inv(X, tw);
#pragma unroll
    for (int i = 0; i < 16; ++i) {
        const int t = tid + 512 * i;
        const float2 cv = X[XP(t)];
        const float g0 = bf2f(z0[(size_t)256 * SEQ + t]), g1 = bf2f(z1[(size_t)256 * SEQ + t]);
        const float2 y = make_float2(g0 * (cv.x + sk0 * keep[i].x), g1 * (cv.y + sk0 * keep[i].y));
        keep[i] = y; X[XP(t)] = y; X[XP(t + 8192)] = make_float2(0.f, 0.f);
    }
    __syncthreads();
    fft_fwd(X, tw);
#pragma unroll
    for (int hb = 0; hb < 2; ++hb) { float2 h2[16];
#pragma unroll
      for (int i = 0; i < 16; ++i) h2[i] = H1[tid + 512 * (16 * hb + i)];
#pragma unroll
      for (int i = 0; i < 16; ++i) { const int ix = XP(tid + 512 * (16 * hb + i)); const v2f a = ((v2f*)X)[ix], h = {h2[i].x, h2[i].y}; ((v2f*)X)[ix] = pk_cmul(a, h); } }
    __syncthreads();
    fft_inv(X, tw);
#pragma unroll
    for (int i = 0; i < 16; ++i) {
        const int t = tid + 512 * i;
        const float2 cv = X[XP(t)];
        const float g0 = bf2f(z0[(size_t)512 * SEQ + t]), g1 = bf2f(z1[(size_t)512 * SEQ + t]);
        z0[t] = f2bf(g0 * (cv.x + sk1 * keep[i].x));
        z1[t] = f2bf(g1 * (cv.y + sk1 * keep[i].y));
    }
    __syncthreads();
}
__device__ __forceinline__ void filtfft_unit(const Params& p, int u, unsigned char* lds) {
    const int l = u >> 9, oc = u & 511, tid = threadIdx.x, lane = tid & 63, wid = tid >> 6;
    float2* X = (float2*)lds;
    float* red = (float*)(lds + 135168 + 64);
    const float* k = (const float*)(p.ws + OFF_P + (size_t)l * SZ_KCIRC_L) + (size_t)oc * NFFT;
    float s = 0.f;
#pragma unroll 4
    for (int i = tid; i < NFFT; i += 512) { const float v = k[i]; X[XP(i)] = make_float2(v, 0.f); s += fabsf(v); }
    s = wave_sum(s);
    if (lane == 0) red[wid] = s;
    __syncthreads();
    const float tot = red[0] + red[1] + red[2] + red[3] + red[4] + red[5] + red[6] + red[7];
    const float sc = 1.0f / (tot * (float)NFFT);
#pragma unroll 4
    for (int i = tid; i < NFFT; i += 512) X[XP(i)].x *= sc;
    __syncthreads();
    fft_fwd(X, (const float2*)(p.ws + OFF_TW));
    float2* H = (float2*)(p.ws + OFF_HSPEC + (size_t)l * SZ_HSPEC_L) + (size_t)oc * NFFT;
#pragma unroll 4
    for (int i = tid; i < NFFT; i += 512) H[i] = X[XP(i)];
    __syncthreads();
}
__device__ __forceinline__ void ctxhy_unit(const Params& p, int l, int u, unsigned char* lds) {
    const int b = u >> 7, tid = threadIdx.x, t = tid & 255, cs = tid >> 8, c = (u & 127) * 2 + cs;
    float* sv = (float*)lds + cs * 256;
    float* sy = (float*)lds + 512 + cs * 256;
    float* k0 = (float*)lds + 1024 + cs * 1024;
    float* k1 = k0 + 512;
    const bf16_t* P = (const bf16_t*)(p.ws + OFF_P);
    const int rowb = ML + b * CTXL;
    const float* cw = p.in[IN_HCW] + l * 3 * 768;
    float z[3];
#pragma unroll
    for (int part = 0; part < 3; ++part) {
        const int ch = part * 256 + c;
        const float pm = (t > 0) ? bf2f(P[(size_t)(rowb + t - 1) * PW + 768 + ch]) : 0.f;
        const float pc = bf2f(P[(size_t)(rowb + t) * PW + 768 + ch]);
        const float pn = (t < CTXL - 1) ? bf2f(P[(size_t)(rowb + t + 1) * PW + 768 + ch]) : 0.f;
        z[part] = pm * cw[ch] + pc * cw[768 + ch] + pn * cw[1536 + ch] + p.in[IN_HCB][l * 768 + ch];
    }
    const float* kn = (const float*)(p.ws + OFF_KCN);
    k0[t] = kn[(size_t)c * 512 + t]; k0[t + 256] = kn[(size_t)c * 512 + t + 256];
    k1[t] = kn[(size_t)(256 + c) * 512 + t]; k1[t + 256] = kn[(size_t)(256 + c) * 512 + t + 256];
    sv[t] = z[0];
    __syncthreads();
    float a = 0.f;
#pragma unroll 8
    for (int s = 0; s < 256; ++s) a += k0[(t - s) & 511] * sv[s];
    const float y1 = z[1] * (a + p.in[IN_HSKIP][l * 512 + c] * z[0]);
    sy[t] = y1;
    __syncthreads();
    a = 0.f;
#pragma unroll 8
    for (int s = 0; s < 256; ++s) a += k1[(t - s) & 511] * sy[s];
    const float y2 = z[2] * (a + p.in[IN_HSKIP][l * 512 + 256 + c] * y1);
    ((bf16_t*)(p.ws + OFF_HY))[(size_t)(rowb + t) * 256 + c] = f2bf(y2);
    __syncthreads();
}
__device__ __forceinline__ void hytr_unit(const Params& p, int u, unsigned char* lds) {
    const int b = u >> 7, t0 = (u & 127) * 64, tid = threadIdx.x;
    constexpr int TS = 144;
    const bf16_t* zt = (const bf16_t*)(p.ws + OFF_ZT);
    for (int i = tid; i < 2048; i += 512) {
        const int ch = i >> 3, cc = i & 7;
        *(uint4*)(lds + ch * TS + cc * 16) = *(const uint4*)(zt + ((size_t)(b * 768 + ch)) * SEQ + t0 + cc * 8);
    }
    __syncthreads();
    {
        const int ch = tid & 255, half = tid >> 8;
        bf16_t* dst = (bf16_t*)(p.ws + OFF_HY) + (size_t)(b * SEQ + t0) * 256 + ch;
        for (int j = 0; j < 32; ++j) { const int tl = half * 32 + j; dst[(size_t)tl * 256] = *(const bf16_t*)(lds + ch * TS + tl * 2); }
    }
    __syncthreads();
}

#ifdef DIAG_NAN
__device__ __forceinline__ void diag_scan(const Params& p, size_t off, size_t nbytes, bool isbf, unsigned code) {
    const uint4* q = (const uint4*)(p.ws + off);
    const size_t n = nbytes / 16;
    bool bad = false;
    for (size_t i = (size_t)blockIdx.x * 512 + threadIdx.x; i < n; i += (size_t)gridDim.x * 512) {
        const uint4 v = q[i];
        const unsigned w[4] = {v.x, v.y, v.z, v.w};
#pragma unroll
        for (int k = 0; k < 4; ++k) {
            if (isbf) { if ((w[k] & 0x7f80u) == 0x7f80u || (w[k] & 0x7f800000u) == 0x7f800000u) bad = true; }
            else { if ((w[k] & 0x7f800000u) == 0x7f800000u) bad = true; }
        }
    }
    if (bad) atomicMin((unsigned*)(p.ws + WS_END), code);
}
__device__ __forceinline__ void diag_scan_out(const Params& p, unsigned code) {
    const uint4* q = (const uint4*)p.out;
    const size_t n = (size_t)ML * 1024 / 4;
    bool bad = false;
    for (size_t i = (size_t)blockIdx.x * 512 + threadIdx.x; i < n; i += (size_t)gridDim.x * 512) {
        const uint4 v = q[i];
        if ((v.x & 0x7f800000u) == 0x7f800000u || (v.y & 0x7f800000u) == 0x7f800000u || (v.z & 0x7f800000u) == 0x7f800000u || (v.w & 0x7f800000u) == 0x7f800000u) bad = true;
    }
    if (bad) atomicMin((unsigned*)(p.ws + WS_END), code);
}
__device__ __forceinline__ void diag_phase(const Params& p, int ph) {
    const int prev = ph - 1;
    if (prev == 0) {
        diag_scan(p, OFF_W, 2 * W_LAYER, true, 0);
        diag_scan(p, OFF_MOD, (size_t)2 * 9 * 6144 * 4 + 16384 + 65536, false, 0);
        diag_scan(p, OFF_P, 2 * SZ_KCIRC_L, false, 0);
        diag_scan(p, OFF_KCR, (size_t)2 * 256 * 512 * 4, false, 0);
    } else if (prev == 1) {
        diag_scan(p, OFF_HSPEC, 2 * SZ_HSPEC_L, false, 1);
        diag_scan(p, OFF_KCN, (size_t)2 * 256 * 512 * 4, false, 1);
        diag_scan(p, OFF_HN, SZ_HN, true, 1);
    } else {
        const int sub = (prev - 2) % 10;
        switch (sub) {
        case 0: diag_scan(p, OFF_P, SZ_P, true, prev); break;
        case 1: diag_scan(p, OFF_Q, SZ_Q + 2 * SZ_K + SZ_ZT + 2 * SZ_B256, true, prev); break;
        case 2: diag_scan(p, OFF_Q, SZ_Q, true, prev); diag_scan(p, OFF_ZT, SZ_ZT, true, prev); diag_scan(p, OFF_HY, SZ_B256, true, prev); break;
        case 3: diag_scan(p, OFF_HY, SZ_B256, true, prev); break;
        case 4: diag_scan(p, OFF_P, SZ_HN, true, prev); break;
        case 5: diag_scan_out(p, prev); break;
        case 6: diag_scan(p, OFF_HN, (size_t)ML * 2048, true, prev); break;
        case 7: diag_scan(p, OFF_P, (size_t)ML * FFH * 2, true, prev); break;
        case 8: diag_scan_out(p, prev); break;
        default: diag_scan(p, OFF_HN, SZ_HN, true, prev); break;
        }
    }
}
#endif

__device__ __forceinline__ void run_phase(const Params& p, int ph, unsigned char* lds) {
    const int G = gridDim.x, bid = blockIdx.x;
#ifdef PROBE_SEL
    if (bid == 0 && threadIdx.x == 0) ((unsigned long long*)(p.ws + WS_END + 64))[ph] = __builtin_amdgcn_s_memrealtime();
#endif
#ifdef DIAG_NAN
    if (ph == 0 && bid == 0 && threadIdx.x == 0) *(unsigned*)(p.ws + WS_END) = 999u;
    if (ph == 0 && bid == 0 && threadIdx.x == 0) { *(unsigned*)(p.ws + WS_END + 4) = 0u; *(unsigned*)(p.ws + WS_END + 8) = 0x7fffffffu; }
    if (ph == 3) {
        const unsigned* q = (const unsigned*)(p.ws + OFF_P);
        const size_t n = SZ_P / 4;
        unsigned cnt = 0, mincol = 0x7fffffffu;
        for (size_t i = (size_t)bid * 512 + threadIdx.x; i < n; i += (size_t)G * 512) {
            const unsigned w = q[i];
            const unsigned col = (unsigned)((i * 2) % PW);
            const unsigned rowi = (unsigned)((i * 2) / PW);
            const bool bad = ((w & 0x7f80u) == 0x7f80u) || ((w & 0x7f800000u) == 0x7f800000u);
            if (bad) { if (col == 0) cnt++; mincol = min(mincol, rowi); }
        }
        if (cnt) { atomicAdd((unsigned*)(p.ws + WS_END + 4), cnt); atomicMin((unsigned*)(p.ws + WS_END + 8), mincol); }
    }
#endif
    if (ph == 0) {
        if (!ONLYC(100) && !ONLYC(102) && !ONLYC(103) && !ONLYC(104) && !ONLYC(105) && !ONLYC(106)) return;
        constexpr int NCVT = 2 * 4224, NMOD = 96, NWEFF = 64, NFILT = 260, NMISC = 16, NHEAVY = NMOD + NWEFF + NFILT + NMISC;
        for (int u = bid; u < NHEAVY + NCVT; u += G) {
            if (u >= NHEAVY) {
                const int uu = u - NHEAVY, l = uu / 4224, t = uu % 4224;
                int j, base;
                if (t < 1600) { j = 0; base = 0; } else if (t < 1728) { j = 1; base = 1600; } else if (t < 1792) { j = 2; base = 1728; } else if (t < 1856) { j = 3; base = 1792; }
                else if (t < 2112) { j = 4; base = 1856; } else if (t < 2816) { j = 5; base = 2112; } else if (t < 3520) { j = 6; base = 2816; } else { j = 7; base = 3520; }
                const CvtJob jb = get_job(p, l, j);
                if (ONLYC(100) || ONLYC(102)) cvt_tile(jb, t - base, lds);
            } else if (u < NFILT) {
                if (!(ONLYC(100) || ONLYC(105))) {} else if (u < 256) filt_task(p, u >> 7, u & 127, SEQ, (float*)(p.ws + OFF_P + (size_t)(u >> 7) * SZ_KCIRC_L), lds);
                else filt_task(p, 0, u - 256, CTXL, (float*)(p.ws + OFF_KCR), lds);
            } else if (u < NFILT + NMOD) { if (ONLYC(100) || ONLYC(103)) mod_task(p, u - NFILT, lds); }
            else if (u < NFILT + NMOD + NWEFF) { if (ONLYC(100) || ONLYC(104)) weff_task(p, u - NFILT - NMOD, lds); }
            else { if (ONLYC(100) || ONLYC(106)) misc_task(p, u - NFILT - NMOD - NWEFF); }
        }
        return;
    }
    if (ph == 1) {
        if (!ONLYC(101)) return;
        for (int u = bid; u < 1024; u += G) filtfft_unit(p, u, lds);
        {
            const int lane = threadIdx.x & 63, wid = threadIdx.x >> 6;
            const float* kr = (const float*)(p.ws + OFF_KCR);
            float* kn = (float*)(p.ws + OFF_KCN);
            for (int oc = bid * 8 + wid; oc < 512; oc += G * 8) {
                float v[8], s = 0.f;
#pragma unroll
                for (int i = 0; i < 8; ++i) { v[i] = kr[(size_t)oc * 512 + lane + 64 * i]; s += fabsf(v[i]); }
                s = 1.0f / wave_sum(s);
#pragma unroll
                for (int i = 0; i < 8; ++i) kn[(size_t)oc * 512 + lane + 64 * i] = v[i] * s;
            }
        }
        modulate_phase(p, 0, 0, MT, p.in[IN_X], p.in[IN_CTX]);
        return;
    }
    const int l = (ph - 2) / 10, sub10 = (ph - 2) % 10, sub13 = (sub10 < 3) ? sub10 : (sub10 < 5) ? sub10 + 1 : sub10 + 3;
    const int half = (sub13 == 6 || sub13 == 7) ? 1 : 0;
    const int sub = (sub13 < 4) ? sub13 : (sub13 == 4 || sub13 == 6) ? 40 : (sub13 == 5 || sub13 == 7) ? 4 : (sub13 - 3);
    const bool first = (l == 0), last = (l == 1);
    unsigned char* wl = p.ws + OFF_W + (size_t)l * W_LAYER;
    const int mtiles = first ? (MT / 256) : (ML / 256);
    const float* mod = (const float*)(p.ws + OFF_MOD) + (size_t)l * 9 * 6144;
    float* xc = (float*)(p.ws + OFF_XC);
    switch (sub) {
    case 0: {
        if (!ONLYC(0) && !(0 == 1 && (ONLYC(10)||ONLYC(11)||ONLYC(12)||ONLYC(13))) && !(0 == 2 && (ONLYC(20)||ONLYC(21)||ONLYC(22)||ONLYC(23)))) break;
        pg8::Gemm g{(const bf16_t*)(p.ws + OFF_HN), (const bf16_t*)(wl + W_WIN), MT, PW, 1024};
        pg8::StaticOrder S; S.init(MT, PW, G, bid);
        pg8::EpiP E{(bf16_t*)(p.ws + OFF_P), PW};
        pg8::gemm_phase<pg8::EpiP, pg8::StaticOrder, true, true>((PG8_LAS unsigned char*)g_lds, g, S, E);
    } break;
    case 1: {
        if (!ONLYC(1) && !(1 == 1 && (ONLYC(10)||ONLYC(11)||ONLYC(12)||ONLYC(13))) && !(1 == 2 && (ONLYC(20)||ONLYC(21)||ONLYC(22)||ONLYC(23)))) break;
        const int NQK = 1056, NHC = 768, NPOOL = first ? 264 : 256, NGM = first ? 528 : 512;
        for (int u = bid; u < NHC; u += G) { if (ONLYC(1) || ONLYC(11)) hyconv_unit(p, l, u, lds); }
        for (int u = (bid + 64) % G; u < NQK; u += G) { if (ONLYC(1) || ONLYC(10)) qk_unit(p, l, u, lds); }
        for (int u = (bid + 128) % G; u < NGM; u += G) { if (ONLYC(1) || ONLYC(13)) gmlp_unit(p, l, u, lds); }
        for (int u = (bid + 192) % G; u < NPOOL; u += G) { if (ONLYC(1) || ONLYC(12)) pool_unit(p, u, lds); }
    } break;
    case 2: {
        if (!ONLYC(2) && !(2 == 1 && (ONLYC(10)||ONLYC(11)||ONLYC(12)||ONLYC(13))) && !(2 == 2 && (ONLYC(20)||ONLYC(21)||ONLYC(22)||ONLYC(23)))) break;
        const int NF = 1024, NA = 2048, NCA = first ? 64 : 0, NCH = first ? 1024 : 0;
#ifdef PROBE_SEL
#define MIXTS(k) if (bid == 0 && threadIdx.x == 0) ((unsigned long long*)(p.ws + WS_END + 1024))[l * 4 + (k)] = __builtin_amdgcn_s_memrealtime();
#else
#define MIXTS(k)
#endif
        MIXTS(0)
        for (int u = bid; u < NF; u += G) { if (ONLYC(2) || ONLYC(20)) hyfft_unit(p, l, u, lds); }
        MIXTS(1)
        for (int u = bid; u < NA + NCA; u += G) {
            int ab, akvh, arow, ank;
            if (u < NA) { ab = u >> 8; akvh = u & 1; arow = (u >> 8) * SEQ + ((u >> 1) & 127) * 64; ank = NKEY; }
            else { const int a = u - NA; ab = a >> 3; akvh = (a >> 2) & 1; arow = ML + (a >> 3) * CTXL + (a & 3) * 64; ank = CTXL; }
            if (ONLYC(2) || ONLYC(21) || ONLYC(22)) attn_unit(p, ab, akvh, arow, ank, lds);
        }
        MIXTS(2)
        for (int u = bid; u < NCH; u += G) { if (ONLYC(2) || ONLYC(23)) ctxhy_unit(p, l, u, lds); }
        MIXTS(3)
    } break;
    case 3: {
        if (!ONLYC(3) && !(3 == 1 && (ONLYC(10)||ONLYC(11)||ONLYC(12)||ONLYC(13))) && !(3 == 2 && (ONLYC(20)||ONLYC(21)||ONLYC(22)||ONLYC(23)))) break;
        for (int u = bid; u < 1024; u += G) hytr_unit(p, u, lds);
    } break;
    case 40: {
        if (!ONLYC(40)) break;
        if (half == 0) { for (int u = bid; u < 1024; u += G) hytr_unit(p, u, lds); }
        const int rowbase = 0, Mh = first ? MT : ML;
        pg8::Gemm g{(const bf16_t*)(p.ws + OFF_HN) + (size_t)rowbase * 1024, (const bf16_t*)(wl + W_WIN) + (size_t)PW * 1024, Mh, 4096, 1024};
        pg8::StaticOrder S; S.init(Mh, 4096, G, bid);
        pg8::EpiSig E{p.ws + OFF_P, 4096};
        pg8::gemm_phase<pg8::EpiSig, pg8::StaticOrder, true, true>((PG8_LAS unsigned char*)g_lds, g, S, E);
    } break;
    case 4: {
        if (!ONLYC(4)) break;
        const int rowbase = 0, Mh = first ? MT : ML;
        const unsigned char* Gb = p.ws + OFF_P;
        bf16_t* mg = (bf16_t*)(p.ws + OFF_MG);
        const int mtiles_h = Mh / 256;
        const int total = ((mtiles_h + 31) / 32) * 256;
        for (int u = bid; u < total; u += G) {
            const int rr = u >> 8, w = u & 255, mt = rr * 32 + (w & 7) * 4 + (w >> 6), nt = (w >> 3) & 7;
            if (mt >= mtiles_h) continue;
            f32x16 msum[2][2]; zero_acc(msum);
            const int lane = threadIdx.x & 63, wid = threadIdx.x >> 6, wm = wid >> 1, wn = wid & 1, fr = lane & 31, fh = lane >> 5;
#pragma unroll 1
            for (int br = 0; br < 4; ++br) {
                const bf16_t* Ab = (const bf16_t*)(p.ws + (br == 0 ? OFF_Q : br == 1 ? OFF_HY : br == 2 ? OFF_PD : OFF_GM));
                const bf16_t* Wb = (const bf16_t*)(wl + (br == 0 ? W_BA : br == 1 ? W_BH : br == 2 ? W_BP : W_BG));
                const int Kb = (br == 0) ? 512 : 256;
                unsigned gq[2][2][4];
#pragma unroll
                for (int mb = 0; mb < 1; ++mb)
#pragma unroll
                    for (int nb = 0; nb < 2; ++nb)
#pragma unroll
                        for (int g4 = 0; g4 < 4; ++g4) {
                            const int rowl = mt * 256 + wm * 64 + mb * 32 + fr, col = nt * 128 + wn * 64 + nb * 32 + g4 * 8 + fh * 4;
                            gq[mb][nb][g4] = *(const unsigned*)(Gb + (size_t)rowl * 4096 + br * 1024 + col);
                        }
                f32x16 v[2][2]; zero_acc(v);
                gemm_mainloop(v, Ab + (size_t)(rowbase + mt * 256) * Kb, Kb, Wb + (size_t)nt * 128 * Kb, Kb, Kb, lds);
#pragma unroll
                for (int nb = 0; nb < 2; ++nb)
#pragma unroll
                    for (int g4 = 0; g4 < 4; ++g4) {
                        const int rowl = mt * 256 + wm * 64 + 32 + fr, col = nt * 128 + wn * 64 + nb * 32 + g4 * 8 + fh * 4;
                        gq[1][nb][g4] = *(const unsigned*)(Gb + (size_t)rowl * 4096 + br * 1024 + col);
                    }
#pragma unroll
                for (int mb = 0; mb < 2; ++mb)
#pragma unroll
                    for (int nb = 0; nb < 2; ++nb)
#pragma unroll
                        for (int g4 = 0; g4 < 4; ++g4) {
                            const unsigned gg = gq[mb][nb][g4];
                            constexpr float QS = 1.0f / 255.0f;
                            msum[nb][mb][4 * g4 + 0] += ((float)(gg & 0xffu) * QS) * v[nb][mb][4 * g4 + 0]; msum[nb][mb][4 * g4 + 1] += ((float)((gg >> 8) & 0xffu) * QS) * v[nb][mb][4 * g4 + 1];
                            msum[nb][mb][4 * g4 + 2] += ((float)((gg >> 16) & 0xffu) * QS) * v[nb][mb][4 * g4 + 2]; msum[nb][mb][4 * g4 + 3] += ((float)(gg >> 24) * QS) * v[nb][mb][4 * g4 + 3];
                        }
            }
#pragma unroll
            for (int mb = 0; mb < 2; ++mb)
#pragma unroll
                for (int nb = 0; nb < 2; ++nb)
#pragma unroll
                    for (int g4 = 0; g4 < 4; ++g4) {
                        const int row = rowbase + mt * 256 + wm * 64 + mb * 32 + fr, col = nt * 128 + wn * 64 + nb * 32 + g4 * 8 + fh * 4;
                        *(uint2*)(mg + (size_t)row * 1024 + col) = make_uint2(pack2(msum[nb][mb][4 * g4], msum[nb][mb][4 * g4 + 1]), pack2(msum[nb][mb][4 * g4 + 2], msum[nb][mb][4 * g4 + 3]));
                    }
        }
    } break;
    case 5: case 8: {
        if (!ONLYC(5)) break;
        const bool isout = (sub == 5);
        const int Mrows = first ? MT : ML, K = isout ? 1024 : FFH;
        pg8::Gemm g{(const bf16_t*)(p.ws + (isout ? OFF_MG : OFF_P)), (const bf16_t*)(wl + (isout ? W_OUT : W_DN)), Mrows, 1024, K};
        pg8::StaticOrder S; S.init(Mrows, 1024, G, bid);
        pg8::EpiRes E{(isout && first) ? p.in[IN_X] : p.out, (isout && first) ? p.in[IN_CTX] : xc, p.out, xc, mod + (isout ? 2048 : 5120), ML};
        pg8::gemm_phase<pg8::EpiRes, pg8::StaticOrder, true, true>((PG8_LAS unsigned char*)g_lds, g, S, E);
    } break;
    case 6: if (!ONLYC(6)) break; modulate_phase(p, l, 1, first ? MT : ML, p.out, xc); break;
    case 7: {
        if (!ONLYC(7) && !(7 == 1 && (ONLYC(10)||ONLYC(11)||ONLYC(12)||ONLYC(13))) && !(7 == 2 && (ONLYC(20)||ONLYC(21)||ONLYC(22)||ONLYC(23)))) break;
        const int Mrows = first ? MT : ML;
        pg8::Gemm g{(const bf16_t*)(p.ws + OFF_HN), (const bf16_t*)(wl + W_GU), Mrows, 2 * FFH, 1024};
        pg8::StaticOrder S; S.init(Mrows, 2 * FFH, G, bid);
        pg8::EpiSwi E{(bf16_t*)(p.ws + OFF_P), FFH};
        pg8::gemm_phase<pg8::EpiSwi, pg8::StaticOrder, true, true>((PG8_LAS unsigned char*)g_lds, g, S, E);
    } break;
    case 9: {
        if (!ONLYC(9) && !(9 == 1 && (ONLYC(10)||ONLYC(11)||ONLYC(12)||ONLYC(13))) && !(9 == 2 && (ONLYC(20)||ONLYC(21)||ONLYC(22)||ONLYC(23)))) break;
        if (last) final_norm_phase(p);
        else modulate_phase(p, l + 1, 0, MT, p.out, xc);
    } break;
    }
}

__device__ __forceinline__ unsigned xcc_id() { return (unsigned)__builtin_amdgcn_s_getreg((3 << 11) | 20) & 0x7u; }
__device__ __forceinline__ void seam_barrier(unsigned* words  , unsigned x, unsigned nx, unsigned nact) {
    __syncthreads();
    if (threadIdx.x == 0) {
        __builtin_amdgcn_fence(__ATOMIC_RELEASE, "agent");
        const unsigned old = __hip_atomic_fetch_add(words + 32 * x, 1u, __ATOMIC_RELAXED, __HIP_MEMORY_SCOPE_AGENT);
        if (old + 1u == nx) __hip_atomic_fetch_add(words + 256, 1u, __ATOMIC_RELAXED, __HIP_MEMORY_SCOPE_AGENT);
        while (__hip_atomic_load(words + 256, __ATOMIC_RELAXED, __HIP_MEMORY_SCOPE_AGENT) < nact) __builtin_amdgcn_s_sleep(1);
        __builtin_amdgcn_fence(__ATOMIC_ACQUIRE, "agent");
    }
    __syncthreads();
}
__global__ void __launch_bounds__(512) mk_forward(Params p) {
    unsigned* const barw = (unsigned*)(p.ws + OFF_BAR);
    const unsigned xcc = (unsigned)__builtin_amdgcn_readfirstlane((int)xcc_id());
    unsigned nx = 0u, nact = 0u;
    if (p.ph_hi - p.ph_lo > 1 && threadIdx.x == 0) __hip_atomic_fetch_add(barw + 32 * xcc, 1u, __ATOMIC_RELAXED, __HIP_MEMORY_SCOPE_AGENT);
#define MK_PHASE(k) if (p.ph_lo <= (k) && (k) < p.ph_hi) { if ((k) > p.ph_lo) { \
        if ((k) == 1) { cg::this_grid().sync(); \
            for (unsigned q = 0; q < 8u; ++q) { const unsigned cq = __hip_atomic_load(barw + 32 * q, __ATOMIC_RELAXED, __HIP_MEMORY_SCOPE_AGENT); nact += (cq != 0u); if (q == xcc) nx = cq; } \
            nx = (unsigned)__builtin_amdgcn_readfirstlane((int)nx); nact = (unsigned)__builtin_amdgcn_readfirstlane((int)nact); } \
        else seam_barrier(barw + 512 * (k), xcc, nx, nact); } run_phase(p, (k), g_lds); }
    MK_PHASE(0) MK_PHASE(1)
    MK_PHASE(2) MK_PHASE(3) MK_PHASE(4) MK_PHASE(5) MK_PHASE(6) MK_PHASE(7) MK_PHASE(8) MK_PHASE(9) MK_PHASE(10) MK_PHASE(11) MK_PHASE(12) MK_PHASE(13) MK_PHASE(14)
    MK_PHASE(15) MK_PHASE(16) MK_PHASE(17) MK_PHASE(18) MK_PHASE(19) MK_PHASE(20) MK_PHASE(21)
#undef MK_PHASE
}

extern "C" void kernel_launch(void* const* d_in, const int* in_sizes, int n_in, void* d_out, int out_size, void* d_ws, size_t ws_size, hipStream_t stream) {
    static int grid = 0;
    if (grid == 0) {
        if (n_in != N_IN || out_size != ML * D || ws_size < WS_END2) { fprintf(stderr, "kernel_launch: unexpected shapes (n_in %d out %d ws %zu need %zu)\n", n_in, out_size, ws_size, (size_t)WS_END); grid = -1; return; }
        int dev = 0, cus = 0, per_cu = 0;
        hipGetDevice(&dev);
        hipDeviceGetAttribute(&cus, hipDeviceAttributeMultiprocessorCount, dev);
        if (hipFuncSetAttribute((const void*)mk_forward, hipFuncAttributeMaxDynamicSharedMemorySize, LDS_BYTES) != hipSuccess) { fprintf(stderr, "kernel_launch: hipFuncSetAttribute failed\n"); grid = -1; return; }
        if (hipOccupancyMaxActiveBlocksPerMultiprocessor(&per_cu, (const void*)mk_forward, 512, LDS_BYTES) != hipSuccess || per_cu < 1) { fprintf(stderr, "kernel_launch: occupancy query says %d\n", per_cu); per_cu = 1; }
        (void)hipGetLastError();
        grid = cus * 1;
    }
    if (grid < 0) return;
    Params p{};
    for (int i = 0; i < N_IN; ++i) p.in[i] = (const float*)d_in[i];
    p.out = (float*)d_out; p.ws = (unsigned char*)d_ws;
#if MK_MULTI_LAUNCH
    for (int ph = 0; ph < NPHASE; ++ph) {
        p.ph_lo = ph; p.ph_hi = ph + 1;
        hipLaunchKernelGGL(mk_forward, dim3(grid), dim3(512), LDS_BYTES, stream, p);
    }
#else
    p.ph_lo = 0; p.ph_hi = NPHASE;
    if (hipMemsetAsync((char*)d_ws + OFF_BAR, 0, 65536, stream) != hipSuccess) { fprintf(stderr, "kernel_launch: memset of the barrier words failed\n"); return; }
    void* args[] = {&p};
    hipError_t e = hipLaunchCooperativeKernel((const void*)mk_forward, dim3(grid), dim3(512), args, LDS_BYTES, stream);
    if (e != hipSuccess) fprintf(stderr, "cooperative launch failed: %s (grid %d)\n", hipGetErrorString(e), grid);
#endif
}
```
